# Optimizing an MI355X kernel written in HIP

```python
import math
import jax
import jax.numpy as jnp
from jax import lax
import numpy as np

D_MODEL = 4096
BATCH = 1
SEQ = 16384
DEPTH = 4

W_GROUP = D_MODEL // 4
D_MIX = 4 * W_GROUP

HY_W = W_GROUP
HY_ORDER = 2
HY_BANDS = 16
HY_EMB = 2 * HY_BANDS + 1
HY_FILTER_WIDTH = 64
HY_INNER = 2
HY_SIN_W = 1.0
HY_TARGET = 1e-2
HY_SHORT_PCT = 0.3
HY_LONG_PCT = 1.5

RET_H = 4
RET_DV = W_GROUP // RET_H
RET_DK = RET_DV // 2
RET_CHUNK = 128

ATT_DH = 128
ATT_H = W_GROUP // ATT_DH
DIL_PAIRS = ((128, 1), (512, 4), (2048, 16))

ML_H = 4
ML_DV = W_GROUP // ML_H
ML_DK = ML_DV // 2
ML_CHUNK = 64
ML_GATES = 2 * 2 * ML_H

FFN_HIDDEN = ((-((-8 * D_MODEL) // 3) + 255) // 256) * 256

IN_SPLITS = (3 * HY_W,
             RET_H * RET_DK, RET_H * RET_DK, RET_H * RET_DV, RET_H * RET_DV,
             ATT_H * ATT_DH, ATT_H * ATT_DH, ATT_H * ATT_DH,
             ML_H * ML_DK, ML_H * ML_DK, ML_H * ML_DV, ML_H * ML_DV, ML_GATES)
D_IN = sum(IN_SPLITS)
NEG = -1e30
EPS = 1e-6

kernel_name = 'hybrid_bidir_parallel_heads_encoder'


def _split_points():
    pts, acc = [], 0
    for s in IN_SPLITS[:-1]:
        acc += s
        pts.append(acc)
    return pts


def rms_norm(x):
    xf = x.astype(jnp.float32)
    return (xf * lax.rsqrt(jnp.mean(xf * xf, -1, keepdims=True) + EPS)).astype(x.dtype)


def head_rms(x, gain=None):
    xf = x.astype(jnp.float32)
    y = xf * lax.rsqrt(jnp.mean(xf * xf, -1, keepdims=True) + EPS)
    return y if gain is None else y * gain.astype(jnp.float32)


def centred_conv3(u, w):
    up = jnp.pad(u, ((0, 0), (1, 1), (0, 0)))
    return up[:, :-2] * w[0] + up[:, 1:-1] * w[1] + up[:, 2:] * w[2]


def hyena_filters(L, w1, b1, w2, b2, w3):
    f32 = jnp.float32
    pos = jnp.arange(L, dtype=f32)
    t = jnp.linspace(0.0, 1.0, L, dtype=f32)
    ang = (2.0 * math.pi / L) * pos
    freqs = jnp.linspace(1e-4, HY_BANDS - 1, HY_BANDS, dtype=f32)
    z = jnp.concatenate([t[:, None], jnp.cos(ang[:, None] * freqs), -jnp.sin(ang[:, None] * freqs)], -1)
    h = jnp.sin(HY_SIN_W * (z @ w1.astype(f32) + b1.astype(f32)))
    for i in range(HY_INNER):
        h = jnp.sin(HY_SIN_W * (h @ w2[i].astype(f32) + b2[i].astype(f32)))
    h = (h @ w3.astype(f32)).reshape(L, HY_ORDER, 2, HY_W)
    max_decay = math.log(HY_TARGET) / HY_SHORT_PCT
    min_decay = math.log(HY_TARGET) / HY_LONG_PCT
    deltas = jnp.abs(jnp.linspace(min_decay, max_decay, HY_W, dtype=f32))
    h = h * jnp.exp(-t[:, None] * deltas)[:, None, None, :]
    fwd, bwd = h[:, :, 0], h[:, :, 1]
    full = jnp.concatenate([fwd, jnp.zeros((1, HY_ORDER, HY_W), f32), jnp.flip(bwd[1:], 0)], 0)
    full = full / jnp.sum(jnp.abs(full), 0, keepdims=True)
    return jnp.fft.rfft(full, axis=0)


def hyena_mixer(u, short_w, w1, b1, w2, b2, w3, bias):
    B, L, _ = u.shape
    u = centred_conv3(u, short_w)
    v, x1, x2 = jnp.split(u.astype(jnp.float32), 3, -1)
    kf = hyena_filters(L, w1, b1, w2, b2, w3)
    z = v
    for o, gate in enumerate((x1, x2)):
        zc = jnp.fft.irfft(jnp.fft.rfft(z, n=2 * L, axis=1) * kf[:, o], n=2 * L, axis=1)[:, :L]
        z = gate * (zc + bias[o].astype(jnp.float32) * z)
    return z


def retention_dir(q, k, v, log_gamma):
    B, H, L, dk = q.shape
    dv = v.shape[-1]
    C = RET_CHUNK
    N = L // C
    q = q.reshape(B, H, N, C, dk)
    k = k.reshape(B, H, N, C, dk)
    v = v.reshape(B, H, N, C, dv)
    pos = jnp.arange(C, dtype=jnp.float32)
    lg = log_gamma[:, None]
    diff = pos[:, None] - pos[None, :]
    intra_decay = jnp.exp(jnp.where(diff >= 0, lg[:, :, None] * diff, -jnp.inf))
    scores = jnp.einsum('bhnid,bhnjd->bhnij', q, k) * intra_decay[None, :, None]
    y = jnp.einsum('bhnij,bhnje->bhnie', scores, v)
    k_w = jnp.exp(lg * (C - 1 - pos))
    q_w = jnp.exp(lg * (pos + 1))
    kv = jnp.einsum('bhncd,bhnce->nbhde', k * k_w[None, :, None, :, None], v)
    chunk_decay = jnp.exp(log_gamma * C)[None, :, None, None]

    def step(state, kv_n):
        return state * chunk_decay + kv_n, state

    _, s_prev = lax.scan(step, jnp.zeros((B, H, dk, dv), jnp.float32), kv)
    y = y + jnp.einsum('bhncd,nbhde->bhnce', q * q_w[None, :, None, :, None], s_prev)
    return y.reshape(B, H, L, dv)


def retention_mixer(q, k, v, g, decay_logit):
    B, L, _ = q.shape
    heads = lambda a, d: a.reshape(B, L, RET_H, d).transpose(0, 2, 1, 3).astype(jnp.float32)
    q = heads(q, RET_DK)
    k = heads(k, RET_DK) * (RET_DK ** -0.5)
    v = heads(v, RET_DV)
    lg = jax.nn.log_sigmoid(decay_logit.astype(jnp.float32))
    flip = lambda a: jnp.flip(a, axis=2)
    y = retention_dir(q, k, v, lg[0]) + flip(retention_dir(flip(q), flip(k), flip(v), lg[1]))
    y = head_rms(y)
    y = y.transpose(0, 2, 1, 3).reshape(B, L, RET_H * RET_DV)
    return jax.nn.silu(g.astype(jnp.float32)) * y


def dilated_branch(q, k, v, window, dilation, slopes):
    B, L, H, Dh = q.shape
    steps = window // (2 * dilation)
    blk = steps
    n = L // dilation
    nb = -(-n // blk)
    pad = nb * blk - n
    strided = lambda a: a.reshape(B, n, dilation, H, Dh)
    qb = jnp.pad(strided(q), ((0, 0), (0, pad), (0, 0), (0, 0), (0, 0))).reshape(B, nb, blk, dilation, H, Dh)

    def band(a):
        ap = jnp.pad(strided(a), ((0, 0), (blk, pad + blk), (0, 0), (0, 0), (0, 0)))
        ap = ap.reshape(B, nb + 2, blk, dilation, H, Dh)
        return jnp.concatenate([ap[:, :-2], ap[:, 1:-1], ap[:, 2:]], axis=2)

    kb, vb = band(k), band(v)
    s = jnp.einsum('bnqrhd,bnkrhd->bnrhqk', qb, kb)
    qi = jnp.arange(blk)
    ki = jnp.arange(3 * blk)
    off = ki[None, :] - blk - qi[:, None]
    kpos = jnp.arange(nb)[:, None, None] * blk + ki[None, None, :] - blk
    valid = (jnp.abs(off) <= steps)[None] & (kpos >= 0) & (kpos < n)
    dist = (jnp.abs(off) * dilation).astype(jnp.float32)
    s = s - slopes[:, None, None] * dist
    s = jnp.where(valid[None, :, None, None], s, NEG)
    m = jnp.max(s, -1, keepdims=True)
    p = jnp.exp(s - m)
    den = jnp.sum(p, -1, keepdims=True)
    o = jnp.einsum('bnrhqk,bnkrhd->bnqrhd', p / den, vb)
    lse = jnp.transpose((m + jnp.log(den))[..., 0], (0, 1, 4, 2, 3))
    o = o.reshape(B, nb * blk, dilation, H, Dh)[:, :n].reshape(B, L, H, Dh)
    lse = lse.reshape(B, nb * blk, dilation, H)[:, :n].reshape(B, L, H)
    return o, lse


def dilated_attention(q, k, v, qk_gain):
    B, L, _ = q.shape
    slopes = 2.0 ** (-8.0 * jnp.arange(1, ATT_H + 1, dtype=jnp.float32) / ATT_H)
    q = head_rms(q.reshape(B, L, ATT_H, ATT_DH), qk_gain[0]) * (ATT_DH ** -0.5)
    k = head_rms(k.reshape(B, L, ATT_H, ATT_DH), qk_gain[1])
    v = v.reshape(B, L, ATT_H, ATT_DH).astype(jnp.float32)
    outs, lses = [], []
    for window, dilation in DIL_PAIRS:
        o, lse = dilated_branch(q, k, v, window, dilation, slopes)
        outs.append(o)
        lses.append(lse)
    w = jax.nn.softmax(jnp.stack(lses, 0), axis=0)
    o = jnp.sum(w[..., None] * jnp.stack(outs, 0), 0)
    return o.reshape(B, L, ATT_H * ATT_DH)


def mlstm_dir(q, k, v, ig, lf):
    B, H, L, dk = q.shape
    dv = v.shape[-1]
    C = ML_CHUNK
    N = L // C
    q = q.reshape(B, H, N, C, dk)
    k = k.reshape(B, H, N, C, dk)
    v = v.reshape(B, H, N, C, dv)
    ig = ig.reshape(B, H, N, C)
    b = jnp.cumsum(lf.reshape(B, H, N, C), -1)
    b_last = b[..., -1]
    a = b_last[..., None] - b + ig
    m_loc = jnp.max(a, -1)
    wa = jnp.exp(a - m_loc[..., None])
    kv = jnp.einsum('bhncd,bhnce->nbhde', k * wa[..., None], v)
    ksum = jnp.transpose(jnp.sum(k * wa[..., None], 3), (2, 0, 1, 3))

    def step(carry, xs):
        c_s, n_s, m_s = carry
        kv_n, k_n, mloc_n, blast_n = xs
        m_new = jnp.maximum(blast_n + m_s, mloc_n)
        sp = jnp.exp(blast_n + m_s - m_new)
        sc = jnp.exp(mloc_n - m_new)
        c_new = sp[..., None, None] * c_s + sc[..., None, None] * kv_n
        n_new = sp[..., None] * n_s + sc[..., None] * k_n
        return (c_new, n_new, m_new), (c_s, n_s, m_s)

    init = (jnp.zeros((B, H, dk, dv), jnp.float32), jnp.zeros((B, H, dk), jnp.float32),
            jnp.zeros((B, H), jnp.float32))
    _, (c_prev, n_prev, m_prev) = lax.scan(
        step, init, (kv, ksum, jnp.transpose(m_loc, (2, 0, 1)), jnp.transpose(b_last, (2, 0, 1))))
    inter_log = b + jnp.transpose(m_prev, (1, 2, 0))[..., None]
    idx = jnp.arange(C)
    lower = idx[:, None] >= idx[None, :]
    dlog = jnp.where(lower, b[..., :, None] - b[..., None, :] + ig[..., None, :], -jnp.inf)
    m_t = jnp.maximum(inter_log, jnp.max(dlog, -1))
    s = jnp.einsum('bhnid,bhnjd->bhnij', q, k) * jnp.exp(dlog - m_t[..., None])
    wi = jnp.exp(inter_log - m_t)
    num = jnp.einsum('bhnij,bhnje->bhnie', s, v) + wi[..., None] * jnp.einsum('bhncd,nbhde->bhnce', q, c_prev)
    den = jnp.sum(s, -1) + wi * jnp.einsum('bhncd,nbhd->bhnc', q, n_prev)
    h = num / jnp.maximum(jnp.abs(den), jnp.exp(-m_t))[..., None]
    return h.reshape(B, H, L, dv)


def mlstm_mixer(q, k, v, o, gates, gate_bias, norm_gain):
    B, L, _ = q.shape
    heads = lambda a, d: a.reshape(B, L, ML_H, d).transpose(0, 2, 1, 3).astype(jnp.float32)
    q = heads(q, ML_DK)
    k = heads(k, ML_DK) * (ML_DK ** -0.5)
    v = heads(v, ML_DV)
    g = (gates.astype(jnp.float32) + gate_bias.astype(jnp.float32)).reshape(B, L, 2, 2, ML_H)
    g = jnp.transpose(g, (2, 3, 0, 4, 1))
    ig = g[:, 0]
    lf = jax.nn.log_sigmoid(g[:, 1])
    flip = lambda a: jnp.flip(a, axis=2)
    h = mlstm_dir(q, k, v, ig[0], lf[0]) + flip(mlstm_dir(flip(q), flip(k), flip(v), flip(ig[1]), flip(lf[1])))
    h = head_rms(h, norm_gain.reshape(ML_H, 1, ML_DV))
    h = h.transpose(0, 2, 1, 3).reshape(B, L, ML_H * ML_DV)
    return jax.nn.sigmoid(o.astype(jnp.float32)) * h


def setup_inputs(seed: int = 0) -> dict:
    key = jax.random.key(seed)
    ks = jax.random.split(key, 21)
    f32 = jnp.float32
    nrm = lambda kk, shape, s: jax.random.normal(kk, shape, f32) * s
    x = nrm(ks[0], (BATCH, SEQ, D_MODEL), 1.0)
    c = nrm(ks[1], (BATCH, D_MODEL), 1.0)
    ada_w = nrm(ks[2], (D_MODEL, 6 * D_MODEL), 0.2 * D_MODEL ** -0.5)
    ada_b = nrm(ks[3], (6 * D_MODEL,), 0.02)
    ada_table = nrm(ks[4], (DEPTH, 6, D_MODEL), 0.1)
    w_in = nrm(ks[5], (DEPTH, D_MODEL, D_IN), D_MODEL ** -0.5)
    w_out = nrm(ks[6], (DEPTH, D_MIX, D_MODEL), D_MIX ** -0.5)
    hy_short = nrm(ks[7], (DEPTH, 3, 3 * HY_W), 3 ** -0.5)
    hy_w1 = nrm(ks[8], (DEPTH, HY_EMB, HY_FILTER_WIDTH), HY_EMB ** -0.5)
    hy_b1 = nrm(ks[9], (DEPTH, HY_FILTER_WIDTH), 0.1)
    hy_w2 = nrm(ks[10], (DEPTH, HY_INNER, HY_FILTER_WIDTH, HY_FILTER_WIDTH), HY_FILTER_WIDTH ** -0.5)
    hy_b2 = nrm(ks[11], (DEPTH, HY_INNER, HY_FILTER_WIDTH), 0.1)
    hy_w3 = nrm(ks[12], (DEPTH, HY_FILTER_WIDTH, HY_ORDER * 2 * HY_W), HY_FILTER_WIDTH ** -0.5)
    hy_bias = nrm(ks[13], (DEPTH, HY_ORDER, HY_W), 1.0)
    ret_base = jnp.log(2.0 ** (5.0 + jnp.arange(RET_H, dtype=f32)) - 1.0)
    ret_decay = ret_base + nrm(ks[14], (DEPTH, 2, RET_H), 0.05)
    att_qk_gain = 1.0 + nrm(ks[15], (DEPTH, 2, ATT_DH), 0.02)
    gate_base = jnp.stack([jnp.zeros((ML_H,), f32), jnp.linspace(3.0, 6.0, ML_H, dtype=f32)])
    ml_gate_bias = (gate_base[None, None] + nrm(ks[16], (DEPTH, 2, 2, ML_H), 0.1)).reshape(DEPTH, ML_GATES)
    ml_norm_gain = 1.0 + nrm(ks[17], (DEPTH, ML_H * ML_DV), 0.02)
    ffn_w1 = nrm(ks[18], (DEPTH, D_MODEL, FFN_HIDDEN), D_MODEL ** -0.5)
    ffn_w3 = nrm(ks[19], (DEPTH, D_MODEL, FFN_HIDDEN), D_MODEL ** -0.5)
    ffn_w2 = nrm(ks[20], (DEPTH, FFN_HIDDEN, D_MODEL), FFN_HIDDEN ** -0.5)
    return {'x': x, 'c': c, 'ada_w': ada_w, 'ada_b': ada_b, 'ada_table': ada_table,
            'w_in': w_in, 'w_out': w_out, 'hy_short': hy_short, 'hy_w1': hy_w1, 'hy_b1': hy_b1,
            'hy_w2': hy_w2, 'hy_b2': hy_b2, 'hy_w3': hy_w3, 'hy_bias': hy_bias,
            'ret_decay': ret_decay, 'att_qk_gain': att_qk_gain, 'ml_gate_bias': ml_gate_bias,
            'ml_norm_gain': ml_norm_gain, 'ffn_w1': ffn_w1, 'ffn_w3': ffn_w3, 'ffn_w2': ffn_w2}


def reference(x, c, ada_w, ada_b, ada_table, w_in, w_out, hy_short, hy_w1, hy_b1, hy_w2, hy_b2,
              hy_w3, hy_bias, ret_decay, att_qk_gain, ml_gate_bias, ml_norm_gain,
              ffn_w1, ffn_w3, ffn_w2):
    split_pts = _split_points()
    mod_shared = jax.nn.silu(c) @ ada_w + ada_b
    for l in range(DEPTH):
        mod = (mod_shared + ada_table[l].reshape(-1))[:, None, :]
        sh1, sc1, g1, sh2, sc2, g2 = jnp.split(mod, 6, -1)
        h = rms_norm(x) * (1 + sc1) + sh1
        proj = h @ w_in[l]
        (hy_in, r_q, r_k, r_v, r_g, a_q, a_k, a_v,
         m_q, m_k, m_v, m_o, m_g) = jnp.split(proj, split_pts, -1)
        y_a = hyena_mixer(hy_in, hy_short[l], hy_w1[l], hy_b1[l], hy_w2[l], hy_b2[l], hy_w3[l], hy_bias[l])
        y_b = retention_mixer(r_q, r_k, r_v, r_g, ret_decay[l])
        y_c = dilated_attention(a_q, a_k, a_v, att_qk_gain[l])
        y_d = mlstm_mixer(m_q, m_k, m_v, m_o, m_g, ml_gate_bias[l], ml_norm_gain[l])
        y = jnp.concatenate([y_a, y_b, y_c, y_d], -1).astype(x.dtype)
        x = x + g1 * (y @ w_out[l])
        h = rms_norm(x) * (1 + sc2) + sh2
        x = x + g2 * ((jax.nn.silu(h @ ffn_w1[l]) * (h @ ffn_w3[l])) @ ffn_w2[l])
    return x
```

```cpp
#ifndef HIPEMU
#include <hip/hip_runtime.h>
#endif
#include <cstdio>
#include <cstdint>
#include <cstring>
#include <cmath>

#ifndef HIPEMU
#define LAS __attribute__((address_space(3)))
#define GAS __attribute__((address_space(1)))
#else
#define LAS
#define GAS
#endif
#define DI __device__ __forceinline__

typedef unsigned short bf16_t;
typedef short bf16x8 __attribute__((ext_vector_type(8)));
typedef short s16x4 __attribute__((ext_vector_type(4)));
typedef float f32x4 __attribute__((ext_vector_type(4)));
typedef float f32x2 __attribute__((ext_vector_type(2)));
typedef unsigned u32x4 __attribute__((ext_vector_type(4)));
typedef unsigned u32x2 __attribute__((ext_vector_type(2)));
typedef LAS unsigned char* ldsp;

#ifdef EMU_SEQ
constexpr int SEQ = EMU_SEQ;
#else
constexpr int SEQ = 16384;
#endif
constexpr int DM = 4096, NPROJ = 9216, NHY = 3072, FFN = 11008, DIN = 12304;
constexpr int NCR = SEQ / 128;
constexpr int NCM = SEQ / 64;
constexpr int KFP = SEQ + 8;
constexpr int LOG4 = (SEQ == 16384) ? 7 : (SEQ == 4096) ? 6 : (SEQ == 1024) ? 5 : (SEQ == 256) ? 4 : -1;
static_assert(LOG4 > 0, "SEQ must be a power of 4");
constexpr float EPS = 1e-6f;
constexpr int PC_RQ = 0, PC_RK = 512, PC_RV = 1024, PC_RG = 2048, PC_AQ = 3072, PC_AK = 4096, PC_AV = 5120, PC_MQ = 6144, PC_MK = 6656, PC_MV = 7168, PC_MO = 8192;
enum { I_X = 0, I_C, I_ADAW, I_ADAB, I_ADAT, I_WIN, I_WOUT, I_HYS, I_HYW1, I_HYB1, I_HYW2, I_HYB2, I_HYW3, I_HYBIAS, I_RDEC, I_AGAIN, I_MGB, I_MNG, I_W1, I_W3, I_W2 };

constexpr size_t al256(size_t x) { return (x + 255) & ~(size_t)255; }
constexpr size_t WS_BAR = 0;
constexpr size_t WS_MOD = 16384;
constexpr size_t WS_G = WS_MOD + al256((size_t)4 * 24576 * 4);
constexpr size_t WS_WTG = WS_G + al256((size_t)SEQ * 16 * 4);
constexpr size_t WS_WTIN = WS_WTG + al256((size_t)16 * 4096 * 2);
constexpr size_t WS_WTOUT = WS_WTIN + al256((size_t)12288 * 4096 * 2);
constexpr size_t WS_WT13 = WS_WTOUT + al256((size_t)4096 * 4096 * 2);
constexpr size_t WS_WT2 = WS_WT13 + al256((size_t)22016 * 4096 * 2);
constexpr size_t WS_H = WS_WT2 + al256((size_t)4096 * 11008 * 2);
constexpr size_t WS_PROJ = WS_H + al256((size_t)SEQ * 4096 * 2);
constexpr size_t WS_UT = WS_PROJ + al256((size_t)SEQ * NPROJ * 2);
constexpr size_t WS_Y = WS_UT + al256((size_t)NHY * SEQ * 2);
constexpr size_t WS_ACT = WS_Y + al256((size_t)SEQ * 4096 * 2);
constexpr size_t WS_FILT = WS_ACT + al256((size_t)SEQ * FFN * 2);
constexpr size_t WS_KF = WS_FILT + al256((size_t)4096 * SEQ * 4);
constexpr size_t WS_Z1T = WS_KF + al256((size_t)2048 * KFP * 8);
constexpr size_t WS_Z2T = WS_Z1T + al256((size_t)1024 * SEQ * 4);
constexpr size_t WS_RKV = WS_Z2T + al256((size_t)1024 * SEQ * 4);
constexpr size_t WS_RST = WS_RKV + al256((size_t)8 * NCR * 32768 * 4);
constexpr size_t WS_OB = WS_RST + al256((size_t)8 * NCR * 32768 * 2);
constexpr size_t WS_LSE = WS_OB + al256((size_t)3 * SEQ * 1024 * 2);
constexpr size_t WS_MKV = WS_LSE + al256((size_t)3 * SEQ * 8 * 4);
constexpr size_t WS_MCT = WS_MKV + al256((size_t)8 * NCM * 32768 * 4);
constexpr size_t WS_KSUM = WS_MCT + al256((size_t)8 * NCM * 32768 * 2);
constexpr size_t WS_NPREV = WS_KSUM + al256((size_t)8 * NCM * 128 * 4);
constexpr size_t WS_MLOC = WS_NPREV + al256((size_t)8 * NCM * 128 * 4);
constexpr size_t WS_BLAST = WS_MLOC + al256((size_t)8 * NCM * 4);
constexpr size_t WS_MPREV = WS_BLAST + al256((size_t)8 * NCM * 4);
constexpr size_t WS_HDIR = WS_MPREV + al256((size_t)8 * NCM * 4);
constexpr size_t WS_RY = WS_HDIR + al256((size_t)2 * SEQ * 1024 * 4);
constexpr size_t WS_WSET2 = WS_RY + al256((size_t)SEQ * 1024 * 4);
constexpr size_t WS_WSET_BYTES = WS_H - WS_WTG;
constexpr size_t WS_END = WS_WSET2 + WS_WSET_BYTES;
constexpr size_t wset_off(int l) { return (l & 1) ? (WS_WSET2 - WS_WTG) : 0; }

constexpr int LDS_BYTES = 147456;
constexpr int LDS_BARW = LDS_BYTES - 16;
constexpr int LDS_PTRS = LDS_BARW - 256;

struct Params { const float* in[21]; float* out; unsigned char* ws; int ph_lo, ph_hi, lay_lo, lay_hi, use_bar, pad; };

DI bf16_t f2bf(float f) { unsigned u = __builtin_bit_cast(unsigned, f); u += 0x7FFFu + ((u >> 16) & 1u); return (bf16_t)(u >> 16); }
DI float bf2f(unsigned short b) { return __builtin_bit_cast(float, ((unsigned)b) << 16); }
DI unsigned pk2(float lo, float hi) {
#ifdef HIPEMU
    return (unsigned)f2bf(lo) | ((unsigned)f2bf(hi) << 16);
#else
    unsigned r; asm volatile("v_cvt_pk_bf16_f32 %0, %1, %2" : "=v"(r) : "v"(lo), "v"(hi)); return r;
#endif
}
DI f32x4 mfma16(bf16x8 a, bf16x8 b, f32x4 c) {
#ifdef HIPEMU
    return emu_mfma16(a, b, c);
#else
    return __builtin_amdgcn_mfma_f32_16x16x32_bf16(a, b, c, 0, 0, 0);
#endif
}
DI bf16x8 tr_read8(ldsp lds, unsigned off_a, unsigned off_b) {
#ifdef HIPEMU
    s16x4 lo = emu_tr_read(lds, off_a), hi = emu_tr_read(lds, off_b);
#else
    s16x4 lo, hi; const unsigned base = (unsigned)(uintptr_t)lds;
    asm volatile("ds_read_b64_tr_b16 %0, %2\n\tds_read_b64_tr_b16 %1, %3\n\ts_waitcnt lgkmcnt(0)" : "=&v"(lo), "=&v"(hi) : "v"(base + off_a), "v"(base + off_b) : "memory");
#endif
    return __builtin_shufflevector(lo, hi, 0, 1, 2, 3, 4, 5, 6, 7);
}
DI bf16x8 tr_frag(ldsp lds, unsigned tile_off, int pitch, int r0a, int r0b, int c0, int lr) {
    const int q = lr >> 2, pp = lr & 3;
    return tr_read8(lds, tile_off + (unsigned)((r0a + q) * pitch + (c0 + 4 * pp) * 2), tile_off + (unsigned)((r0b + q) * pitch + (c0 + 4 * pp) * 2));
}
struct TrF { s16x4 lo, hi; };
DI void tr_issue(ldsp lds, unsigned tile_off, int pitch, int r0a, int r0b, int c0, int lr, TrF& f) {
    const int q = lr >> 2, pp = lr & 3;
    const unsigned off_a = tile_off + (unsigned)((r0a + q) * pitch + (c0 + 4 * pp) * 2), off_b = tile_off + (unsigned)((r0b + q) * pitch + (c0 + 4 * pp) * 2);
#ifdef HIPEMU
    f.lo = emu_tr_read(lds, off_a); f.hi = emu_tr_read(lds, off_b);
#else
    const unsigned base = (unsigned)(uintptr_t)lds;
    asm volatile("ds_read_b64_tr_b16 %0, %2\n\tds_read_b64_tr_b16 %1, %3" : "=&v"(f.lo), "=&v"(f.hi) : "v"(base + off_a), "v"(base + off_b) : "memory");
#endif
}
DI void tr_wait2(TrF& a, TrF& b) {
#ifndef HIPEMU
    asm volatile("s_waitcnt lgkmcnt(0)" : "+v"(a.lo), "+v"(a.hi), "+v"(b.lo), "+v"(b.hi) :: "memory");
#endif
}
DI void tr_wait1(TrF& a) {
#ifndef HIPEMU
    asm volatile("s_waitcnt lgkmcnt(0)" : "+v"(a.lo), "+v"(a.hi) :: "memory");
#endif
}
DI bf16x8 tr_val(const TrF& f) { return __builtin_shufflevector(f.lo, f.hi, 0, 1, 2, 3, 4, 5, 6, 7); }
DI bf16x8 lds_row8(ldsp lds, unsigned off) { return *(const LAS bf16x8*)(lds + off); }
DI bf16x8 pack8(const f32x4& a, const f32x4& b) { u32x4 w; w.x = pk2(a[0], a[1]); w.y = pk2(a[2], a[3]); w.z = pk2(b[0], b[1]); w.w = pk2(b[2], b[3]); return __builtin_bit_cast(bf16x8, w); }
DI float wave_sum(float v) {
#pragma unroll
    for (int m = 32; m >= 1; m >>= 1) v += __shfl_xor(v, m);
    return v;
}
DI float wave_max(float v) {
#pragma unroll
    for (int m = 32; m >= 1; m >>= 1) v = fmaxf(v, __shfl_xor(v, m));
    return v;
}
DI float ld_xcu(const float* p) {
#ifdef HIPEMU
    return *p;
#else
    return __builtin_bit_cast(float, __hip_atomic_load((const unsigned*)p, __ATOMIC_RELAXED, __HIP_MEMORY_SCOPE_AGENT));
#endif
}
DI f32x2 ld_xcu2(const f32x2* p) {
#ifdef HIPEMU
    return *p;
#else
    return __builtin_bit_cast(f32x2, __hip_atomic_load((const unsigned long long*)p, __ATOMIC_RELAXED, __HIP_MEMORY_SCOPE_AGENT));
#endif
}
DI float fexp(float x) {
#ifdef HIPEMU
    return expf(x);
#else
    return __builtin_amdgcn_exp2f(x * 1.4426950408889634f);
#endif
}
DI float frcp(float x) {
#ifdef HIPEMU
    return 1.f / x;
#else
    return __builtin_amdgcn_rcpf(x);
#endif
}
DI float logsig(float x) { return x < 0.f ? x - log1pf(expf(x)) : -log1pf(expf(-x)); }
DI float sigm(float x) { return frcp(1.f + fexp(-x)); }
DI float dot4(const f32x4& a, const f32x4& b) { return a[0] * b[0] + a[1] * b[1] + a[2] * b[2] + a[3] * b[3]; }
DI f32x2 cmul(f32x2 a, f32x2 b) { f32x2 r; r.x = a.x * b.x - a.y * b.y; r.y = a.x * b.y + a.y * b.x; return r; }
DI f32x2 cmulc(f32x2 a, f32x2 b) { f32x2 r; r.x = a.x * b.x + a.y * b.y; r.y = a.y * b.x - a.x * b.y; return r; }
DI f32x2 cconj(f32x2 a) { f32x2 r; r.x = a.x; r.y = -a.y; return r; }
DI unsigned rev4(unsigned k) { const unsigned x = __builtin_bitreverse32(k) >> (32 - 2 * LOG4); return ((x & 0x55555555u) << 1) | ((x >> 1) & 0x55555555u); }

DI int opaque_tid() { int t = (int)threadIdx.x;
#ifndef HIPEMU
    asm volatile("" : "+v"(t));
#endif
    return t; }
#define TID (opaque_tid())
#ifdef HIPEMU
#define WAVE_SYNC() emu_wave_sync()
#else
#define WAVE_SYNC() __builtin_amdgcn_wave_barrier()
#endif
DI unsigned long long lds_ptr_bits(ldsp lds, int i) {
    const LAS unsigned* q = (const LAS unsigned*)(lds + LDS_PTRS + 8 * i); unsigned lo = q[0], hi = q[1];
#ifndef HIPEMU
    lo = __builtin_amdgcn_readfirstlane(lo); hi = __builtin_amdgcn_readfirstlane(hi);
#endif
    return ((unsigned long long)hi << 32) | lo;
}
#define INP(i) ((const float*)(GAS const float*)lds_ptr_bits(lds, (i)))
#define OUTP() ((float*)(GAS float*)lds_ptr_bits(lds, 21))
#define WSP() ((unsigned char*)(GAS unsigned char*)lds_ptr_bits(lds, 22))
DI unsigned char* opaque_ws(unsigned char* w) {
#ifndef HIPEMU
    asm volatile("" : "+s"(w));
#endif
    return w; }
#ifndef HIPEMU
#define MEMFENCE() asm volatile("" ::: "memory")
#else
#define MEMFENCE() do { } while (0)
#endif

DI void phase_mod(ldsp lds) {
    unsigned char* const ws_ = WSP();
    const float* c = INP(I_C); const float* ada_w = INP(I_ADAW); const float* ada_b = INP(I_ADAB); const float* ada_t = INP(I_ADAT);
    float* mod = (float*)(ws_ + WS_MOD);
    LAS float* sc = (LAS float*)lds; LAS float* red = sc + 4096;
    const int tid = TID;
    for (int i = tid; i < 4096; i += 512) { const float v = c[i]; sc[i] = v / (1.f + expf(-v)); }
    __syncthreads();
    for (int cb = blockIdx.x; cb < 256; cb += gridDim.x) {
        const int cv = tid % 24, ks = tid / 24;
        if (ks < 21) {
            f32x4 acc = {0.f, 0.f, 0.f, 0.f};
            for (int k = ks; k < 4096; k += 21) { const f32x4 w = *(const f32x4*)(ada_w + (size_t)k * 24576 + cb * 96 + 4 * cv); acc += w * sc[k]; }
#pragma unroll
            for (int j = 0; j < 4; ++j) red[ks * 96 + 4 * cv + j] = acc[j];
        }
        __syncthreads();
        if (tid < 96) {
            float s = 0.f;
            for (int k = 0; k < 21; ++k) s += red[k * 96 + tid];
            const int j = cb * 96 + tid; s += ada_b[j];
            for (int l = 0; l < 4; ++l) mod[l * 24576 + j] = s + ada_t[l * 24576 + j];
        }
        __syncthreads();
    }
}

template <class RowMap>
DI void wconv_tile(const float* src, int ldn, int K, int kt, int nt4, bf16_t* dst, RowMap rm, ldsp lds, int tid) {
    LAS float* T = (LAS float*)lds;
    const int k0 = kt * 64, n0 = nt4 * 256;
    f32x4 v[8];
#pragma unroll
    for (int i = 0; i < 8; ++i) { const int idx = tid + 512 * i, k = idx >> 6, n4 = idx & 63; v[i] = __builtin_nontemporal_load((const f32x4*)(src + (size_t)(k0 + k) * ldn + n0 + 4 * n4)); }
#pragma unroll
    for (int i = 0; i < 8; ++i) { const int idx = tid + 512 * i, k = idx >> 6, n4 = idx & 63;
#pragma unroll
        for (int j = 0; j < 4; ++j) T[(4 * n4 + j) * 65 + k] = v[i][j]; }
    __syncthreads();
#pragma unroll
    for (int i = 0; i < 4; ++i) {
        const int ch = tid + 512 * i, n = ch >> 3, kc = ch & 7; u32x4 o;
        o.x = pk2(T[n * 65 + 8 * kc + 0], T[n * 65 + 8 * kc + 1]); o.y = pk2(T[n * 65 + 8 * kc + 2], T[n * 65 + 8 * kc + 3]);
        o.z = pk2(T[n * 65 + 8 * kc + 4], T[n * 65 + 8 * kc + 5]); o.w = pk2(T[n * 65 + 8 * kc + 6], T[n * 65 + 8 * kc + 7]);
        *(u32x4*)(dst + (size_t)rm(n0 + n) * K + k0 + 8 * kc) = o;
    }
    __syncthreads();
}
DI void phase_wconv(int l, ldsp lds) {
    unsigned char* const ws_ = WSP();
    const float* w_in = INP(I_WIN) + (size_t)l * 4096 * DIN; const float* w_out = INP(I_WOUT) + (size_t)l * 4096 * 4096;
    const float* w1 = INP(I_W1) + (size_t)l * 4096 * FFN; const float* w3 = INP(I_W3) + (size_t)l * 4096 * FFN; const float* w2 = INP(I_W2) + (size_t)l * FFN * 4096;
    unsigned char* const wb_ = ws_ + wset_off(l);
    bf16_t* wt_in = (bf16_t*)(wb_ + WS_WTIN); bf16_t* wt_out = (bf16_t*)(wb_ + WS_WTOUT); bf16_t* wt13 = (bf16_t*)(wb_ + WS_WT13); bf16_t* wt2 = (bf16_t*)(wb_ + WS_WT2);
    bf16_t* wtg = (bf16_t*)(wb_ + WS_WTG);
    const int tid = TID;
    constexpr int T_IN = 64 * 48, T_OUT = 64 * 16, T_1 = 64 * 43, T_2 = 172 * 16, T_ALL = T_IN + T_OUT + 2 * T_1 + T_2;
    for (int t = blockIdx.x; t < T_ALL; t += gridDim.x) {
        if (t < T_IN) wconv_tile(w_in, DIN, 4096, t / 48, t % 48, wt_in, [](int n) { return n; }, lds, tid);
        else if (t < T_IN + T_OUT) { const int q = t - T_IN; wconv_tile(w_out, 4096, 4096, q / 16, q % 16, wt_out, [](int n) { return n; }, lds, tid); }
        else if (t < T_IN + T_OUT + T_1) { const int q = t - T_IN - T_OUT; wconv_tile(w1, FFN, 4096, q / 43, q % 43, wt13, [](int n) { return (n >> 7) * 256 + (n & 127); }, lds, tid); }
        else if (t < T_IN + T_OUT + 2 * T_1) { const int q = t - T_IN - T_OUT - T_1; wconv_tile(w3, FFN, 4096, q / 43, q % 43, wt13, [](int n) { return (n >> 7) * 256 + 128 + (n & 127); }, lds, tid); }
        else { const int q = t - T_IN - T_OUT - 2 * T_1; wconv_tile(w2, 4096, FFN, q / 16, q % 16, wt2, [](int n) { return n; }, lds, tid); }
    }
    for (int idx = blockIdx.x * 512 + tid; idx < 65536; idx += gridDim.x * 512) { const int k = idx >> 4, n = idx & 15; wtg[n * 4096 + k] = f2bf(w_in[(size_t)k * DIN + 12288 + n]); }
}

DI void phase_norm(ldsp lds, const float* xin, int l, int which) {
    unsigned char* const ws_ = WSP();
    const float* mod = (const float*)(ws_ + WS_MOD) + l * 24576; const float* sh = mod + which * 12288; const float* scv = mod + 4096 + which * 12288;
    bf16_t* H = (bf16_t*)(ws_ + WS_H);
    const int tid_ = TID; const int lane = tid_ & 63, wave = tid_ >> 6;
    for (int row = (blockIdx.x * 8 + wave) * 2; row < SEQ; row += gridDim.x * 16) {
        const float* xr = xin + (size_t)row * 4096; f32x4 v[2][16]; float ss0 = 0.f, ss1 = 0.f;
#pragma unroll
        for (int i = 0; i < 16; ++i) { v[0][i] = *(const f32x4*)(xr + 4 * (lane + 64 * i)); v[1][i] = *(const f32x4*)(xr + 4096 + 4 * (lane + 64 * i)); }
#pragma unroll
        for (int i = 0; i < 16; ++i) { ss0 += dot4(v[0][i], v[0][i]); ss1 += dot4(v[1][i], v[1][i]); }
        ss0 = wave_sum(ss0); ss1 = wave_sum(ss1);
        const float r0 = rsqrtf(ss0 * (1.f / 4096.f) + EPS), r1 = rsqrtf(ss1 * (1.f / 4096.f) + EPS);
#pragma unroll
        for (int i = 0; i < 16; ++i) {
            const int cc = 4 * (lane + 64 * i); const f32x4 s1 = *(const f32x4*)(scv + cc) + 1.f, s0 = *(const f32x4*)(sh + cc);
            const f32x4 o0 = v[0][i] * r0 * s1 + s0, o1 = v[1][i] * r1 * s1 + s0; u32x2 w0, w1; w0.x = pk2(o0[0], o0[1]); w0.y = pk2(o0[2], o0[3]); w1.x = pk2(o1[0], o1[1]); w1.y = pk2(o1[2], o1[3]);
            *(u32x2*)(H + (size_t)row * 4096 + cc) = w0; *(u32x2*)(H + (size_t)(row + 1) * 4096 + cc) = w1;
            if ((i & 3) == 3) MEMFENCE();
        }
    }
}

DI void phase_gates(ldsp lds, int l) {
    unsigned char* const ws_ = WSP();
    const bf16_t* H = (const bf16_t*)(ws_ + WS_H); const bf16_t* WG = (const bf16_t*)(ws_ + wset_off(l) + WS_WTG); float* G = (float*)(ws_ + WS_G);
    LAS float* red = (LAS float*)lds;
    const int tid = TID, lane = tid & 63, wave = tid >> 6, lr = lane & 15, lg = lane >> 4;
    for (int tile = blockIdx.x; tile < SEQ / 16; tile += gridDim.x) {
        f32x4 acc = {0.f, 0.f, 0.f, 0.f};
        const bf16_t* arow = H + (size_t)(tile * 16 + lr) * 4096 + wave * 512 + 8 * lg; const bf16_t* brow = WG + (size_t)lr * 4096 + wave * 512 + 8 * lg;
#pragma unroll 4
        for (int ks = 0; ks < 16; ++ks) { const bf16x8 a = *(const bf16x8*)(arow + 32 * ks); const bf16x8 b = *(const bf16x8*)(brow + 32 * ks); acc = mfma16(a, b, acc); }
#pragma unroll
        for (int r = 0; r < 4; ++r) red[wave * 256 + (4 * lg + r) * 16 + lr] = acc[r];
        __syncthreads();
        if (tid < 256) { float s = 0.f; for (int w = 0; w < 8; ++w) s += red[w * 256 + tid]; G[(size_t)tile * 256 + tid] = s; }
        __syncthreads();
    }
}

DI void phase_hy_filt(int l, ldsp lds) {
    unsigned char* const ws_ = WSP();
    const float* w1 = INP(I_HYW1) + l * 33 * 64; const float* b1 = INP(I_HYB1) + l * 64; const float* w2 = INP(I_HYW2) + l * 2 * 4096; const float* b2 = INP(I_HYB2) + l * 128;
    const float* w3 = INP(I_HYW3) + (size_t)l * 64 * 4096; float* FILT = (float*)(ws_ + WS_FILT);
    LAS float* z = (LAS float*)lds; LAS float* ha = z + 64 * 36; LAS float* hb = ha + 4096;
    const int tid = TID;
    const float min_decay = -4.605170185988091f / 1.5f, max_decay = -4.605170185988091f / 0.3f;
    for (int tt = blockIdx.x; tt < SEQ / 64; tt += gridDim.x) {
        const int tau0 = tt * 64;
        for (int idx = tid; idx < 64 * 33; idx += 512) {
            const int r = idx / 33, f = idx % 33, tau = tau0 + r; float val;
            if (f == 0) val = (float)tau / (float)(SEQ - 1);
            else { const int b = (f - 1) & 15; const float fr = 1e-4f + (float)b * ((15.f - 1e-4f) / 15.f); const float a = ((6.283185307179586f / (float)SEQ) * (float)tau) * fr; val = (f <= 16) ? cosf(a) : -sinf(a); }
            z[r * 36 + f] = val;
        }
        __syncthreads();
        for (int idx = tid; idx < 4096; idx += 512) { const int r = idx >> 6, o = idx & 63; float s = b1[o]; for (int f = 0; f < 33; ++f) s += z[r * 36 + f] * w1[f * 64 + o]; ha[r * 64 + o] = sinf(s); }
        __syncthreads();
        for (int idx = tid; idx < 4096; idx += 512) { const int r = idx >> 6, o = idx & 63; float s = b2[o]; for (int i = 0; i < 64; ++i) s += ha[r * 64 + i] * w2[i * 64 + o]; hb[r * 64 + o] = sinf(s); }
        __syncthreads();
        for (int idx = tid; idx < 4096; idx += 512) { const int r = idx >> 6, o = idx & 63; float s = b2[64 + o]; for (int i = 0; i < 64; ++i) s += hb[r * 64 + i] * w2[4096 + i * 64 + o]; ha[r * 64 + o] = sinf(s); }
        __syncthreads();
        {
            const int lane = tid & 63, wave = tid >> 6, lr = lane & 15, lg = lane >> 4;
            bf16x8 ahi[4][2], alo[4][2];
#pragma unroll
            for (int tt = 0; tt < 4; ++tt)
#pragma unroll
                for (int ks = 0; ks < 2; ++ks) {
                    const f32x4 x0 = *(const LAS f32x4*)(ha + (16 * tt + lr) * 64 + 32 * ks + 8 * lg), x1 = *(const LAS f32x4*)(ha + (16 * tt + lr) * 64 + 32 * ks + 8 * lg + 4);
                    f32x4 h0, h1, l0, l1;
#pragma unroll
                    for (int e = 0; e < 4; ++e) { h0[e] = bf2f(f2bf(x0[e])); h1[e] = bf2f(f2bf(x1[e])); l0[e] = x0[e] - h0[e]; l1[e] = x1[e] - h1[e]; }
                    ahi[tt][ks] = pack8(h0, h1); alo[tt][ks] = pack8(l0, l1);
                }
            f32x4 wn[2][2];
#pragma unroll
            for (int ks = 0; ks < 2; ++ks)
#pragma unroll
                for (int e = 0; e < 4; ++e) { wn[ks][0][e] = w3[(size_t)(32 * ks + 8 * lg + e) * 4096 + 16 * wave + lr]; wn[ks][1][e] = w3[(size_t)(32 * ks + 8 * lg + 4 + e) * 4096 + 16 * wave + lr]; }
#pragma unroll 1
            for (int ct = wave; ct < 256; ct += 8) {
                const int j = 16 * ct + lr, c = j & 1023;
                bf16x8 bhi[2], blo[2];
#pragma unroll
                for (int ks = 0; ks < 2; ++ks) {
                    const f32x4 x0 = wn[ks][0], x1 = wn[ks][1]; f32x4 h0, h1, l0, l1;
#pragma unroll
                    for (int e = 0; e < 4; ++e) { h0[e] = bf2f(f2bf(x0[e])); h1[e] = bf2f(f2bf(x1[e])); l0[e] = x0[e] - h0[e]; l1[e] = x1[e] - h1[e]; }
                    bhi[ks] = pack8(h0, h1); blo[ks] = pack8(l0, l1);
                }
                { const int jn = 16 * ((ct + 8 < 256) ? ct + 8 : ct) + lr;
#pragma unroll
                  for (int ks = 0; ks < 2; ++ks)
#pragma unroll
                      for (int e = 0; e < 4; ++e) { wn[ks][0][e] = w3[(size_t)(32 * ks + 8 * lg + e) * 4096 + jn]; wn[ks][1][e] = w3[(size_t)(32 * ks + 8 * lg + 4 + e) * 4096 + jn]; } }
                const float delta = fabsf(min_decay + (float)c * ((max_decay - min_decay) / 1023.f));
                LAS float* tw_ = hb + 4096 + wave * 1088;
#pragma unroll
                for (int tt = 0; tt < 4; ++tt) {
                    f32x4 acc = {0.f, 0.f, 0.f, 0.f};
#pragma unroll
                    for (int ks = 0; ks < 2; ++ks) { acc = mfma16(ahi[tt][ks], bhi[ks], acc); acc = mfma16(ahi[tt][ks], blo[ks], acc); acc = mfma16(alo[tt][ks], bhi[ks], acc); }
                    f32x4 o;
#pragma unroll
                    for (int r = 0; r < 4; ++r) { const float t = (float)(tau0 + 16 * tt + 4 * lg + r) / (float)(SEQ - 1); o[r] = acc[r] * fexp(-t * delta); }
                    *(LAS f32x4*)(tw_ + lr * 68 + 16 * tt + 4 * lg) = o;
                }
                WAVE_SYNC();
#pragma unroll
                for (int jj = 0; jj < 4; ++jj) {
                    const int col = 4 * jj + (lane >> 4), q4 = lane & 15;
                    const f32x4 o = *(const LAS f32x4*)(tw_ + col * 68 + 4 * q4);
                    *(f32x4*)(FILT + (size_t)(16 * ct + col) * SEQ + tau0 + 4 * q4) = o;
                }
                WAVE_SYNC();
            }
        }
        __syncthreads();
    }
}

constexpr int FFT_PADN = SEQ + (SEQ >> 6) * 4;
constexpr int FFT_X = 0, FFT_T1 = FFT_PADN * 8, FFT_T2 = FFT_T1 + 1024, FFT_SCR = FFT_T2 + 1024;
static_assert(FFT_SCR + 256 <= LDS_PTRS, "fft lds");
DI int fpad(int i) { return i + ((i >> 6) << 2); }
DI void fft_tables(ldsp lds) {
    LAS f32x2* T1 = (LAS f32x2*)(lds + FFT_T1); LAS f32x2* T2 = (LAS f32x2*)(lds + FFT_T2);
    const int tid = TID;
    if (tid < 128) { const double a = -6.283185307179586476925 * (double)((tid * 128) % SEQ) / (double)SEQ; f32x2 v; v.x = (float)cos(a); v.y = (float)sin(a); T1[tid] = v; }
    else if (tid < 256) { const double a = -6.283185307179586476925 * (double)(tid - 128) / (double)SEQ; f32x2 v; v.x = (float)cos(a); v.y = (float)sin(a); T2[tid - 128] = v; }
    __syncthreads();
}
DI f32x2 fft_tw(ldsp lds, int ti) { const LAS f32x2* T1 = (const LAS f32x2*)(lds + FFT_T1); const LAS f32x2* T2 = (const LAS f32x2*)(lds + FFT_T2); return cmul(T1[ti >> 7], T2[ti & 127]); }
DI void r4_fwd(f32x2& x0, f32x2& x1, f32x2& x2, f32x2& x3) {
    const f32x2 t0 = x0 + x2, t1 = x0 - x2, t2 = x1 + x3, d = x1 - x3; f32x2 t3; t3.x = d.y; t3.y = -d.x;
    x0 = t0 + t2; x1 = t1 + t3; x2 = t0 - t2; x3 = t1 - t3;
}
DI void r4_inv(f32x2& x0, f32x2& x1, f32x2& x2, f32x2& x3) {
    const f32x2 t0 = x0 + x2, t1 = x0 - x2, t2 = x1 + x3, d = x1 - x3; f32x2 t3; t3.x = -d.y; t3.y = d.x;
    x0 = t0 + t2; x1 = t1 + t3; x2 = t0 - t2; x3 = t1 - t3;
}
DI f32x2 w16c(int a) { f32x2 r; r.x = (a == 0) ? 1.f : (a == 1) ? 0.92387953251128674f : (a == 2) ? 0.70710678118654752f : 0.38268343236508977f;
    r.y = (a == 0) ? 0.f : (a == 1) ? -0.38268343236508977f : (a == 2) ? -0.70710678118654752f : -0.92387953251128674f; return r; }
template <int M, bool INV> DI void fft_r16(ldsp lds, int tid) {
    LAS f32x2* X = (LAS f32x2*)(lds + FFT_X);
    constexpr int Q4 = M / 16, QQ = M / 4;
    for (int u = tid; u < SEQ / 16; u += 512) {
        const int jp = u & (Q4 - 1), b = (u / Q4) * M + jp;
        constexpr int PA = (Q4 >= 64) ? (Q4 / 64) * 68 : Q4, PC = (QQ >= 64) ? (QQ / 64) * 68 : QQ;
        constexpr bool LIN = (M >= 1024 || M <= 64);
        LAS f32x2* Xb = X + fpad(b);
        f32x2 e[4][4];
#pragma unroll
        for (int c = 0; c < 4; ++c)
#pragma unroll
            for (int a = 0; a < 4; ++a) e[c][a] = LIN ? Xb[a * PA + c * PC] : X[fpad(b + a * Q4 + c * QQ)];
        const f32x2 w0 = fft_tw(lds, jp * (SEQ / M)); const f32x2 wb = fft_tw(lds, jp * (4 * (SEQ / M)));
        const f32x2 wb2 = cmul(wb, wb), wb3 = cmul(wb2, wb);
        if (!INV) {
#pragma unroll
            for (int a = 0; a < 4; ++a) {
                r4_fwd(e[0][a], e[1][a], e[2][a], e[3][a]);
                const f32x2 wa = cmul(w0, w16c(a)), wa2 = cmul(wa, wa), wa3 = cmul(wa2, wa);
                e[1][a] = cmul(e[1][a], wa); e[2][a] = cmul(e[2][a], wa2); e[3][a] = cmul(e[3][a], wa3);
            }
#pragma unroll
            for (int c = 0; c < 4; ++c) { r4_fwd(e[c][0], e[c][1], e[c][2], e[c][3]); e[c][1] = cmul(e[c][1], wb); e[c][2] = cmul(e[c][2], wb2); e[c][3] = cmul(e[c][3], wb3); }
        } else {
#pragma unroll
            for (int c = 0; c < 4; ++c) { e[c][1] = cmulc(e[c][1], wb); e[c][2] = cmulc(e[c][2], wb2); e[c][3] = cmulc(e[c][3], wb3); r4_inv(e[c][0], e[c][1], e[c][2], e[c][3]); }
#pragma unroll
            for (int a = 0; a < 4; ++a) {
                const f32x2 wa = cmul(w0, w16c(a)), wa2 = cmul(wa, wa), wa3 = cmul(wa2, wa);
                e[1][a] = cmulc(e[1][a], wa); e[2][a] = cmulc(e[2][a], wa2); e[3][a] = cmulc(e[3][a], wa3);
                r4_inv(e[0][a], e[1][a], e[2][a], e[3][a]);
            }
        }
#pragma unroll
        for (int c = 0; c < 4; ++c)
#pragma unroll
            for (int a = 0; a < 4; ++a) { if (LIN) Xb[a * PA + c * PC] = e[c][a]; else X[fpad(b + a * Q4 + c * QQ)] = e[c][a]; }
    }
    __syncthreads();
}
template <bool INV> DI void fft_r4_last(ldsp lds, int tid) {
    LAS f32x2* X = (LAS f32x2*)(lds + FFT_X);
    for (int u = tid; u < SEQ / 4; u += 512) {
        LAS f32x4* q = (LAS f32x4*)(X + fpad(4 * u)); const f32x4 lo = q[0], hi = q[1];
        f32x2 x0, x1, x2, x3; x0.x = lo[0]; x0.y = lo[1]; x1.x = lo[2]; x1.y = lo[3]; x2.x = hi[0]; x2.y = hi[1]; x3.x = hi[2]; x3.y = hi[3];
        if (!INV) r4_fwd(x0, x1, x2, x3); else r4_inv(x0, x1, x2, x3);
        f32x4 o0, o1; o0[0] = x0.x; o0[1] = x0.y; o0[2] = x1.x; o0[3] = x1.y; o1[0] = x2.x; o1[1] = x2.y; o1[2] = x3.x; o1[3] = x3.y; q[0] = o0; q[1] = o1;
    }
    __syncthreads();
}
DI void fft_dif(ldsp lds, int tid) {
    if constexpr (LOG4 >= 2) fft_r16<SEQ, false>(lds, tid);
    if constexpr (LOG4 >= 4) fft_r16<SEQ / 16, false>(lds, tid);
    if constexpr (LOG4 >= 6) fft_r16<SEQ / 256, false>(lds, tid);
    if constexpr (LOG4 & 1) fft_r4_last<false>(lds, tid);
}
DI void fft_dit_inv(ldsp lds, int tid) {
    if constexpr (LOG4 & 1) fft_r4_last<true>(lds, tid);
    if constexpr (LOG4 >= 6) fft_r16<SEQ / 256, true>(lds, tid);
    if constexpr (LOG4 >= 4) fft_r16<SEQ / 16, true>(lds, tid);
    if constexpr (LOG4 >= 2) fft_r16<SEQ, true>(lds, tid);
}
DI f32x2 fft_halfroot(ldsp lds, int k) { f32x2 w = fft_tw(lds, k >> 1); if (k & 1) { f32x2 h; h.x = (float)cos(3.14159265358979323846 / (double)SEQ); h.y = -(float)sin(3.14159265358979323846 / (double)SEQ); w = cmul(w, h); } return w; }

DI void phase_hy_fftf(ldsp lds) {
    unsigned char* const ws_ = WSP();
    const float* FILT = (const float*)(ws_ + WS_FILT); f32x2* KF = (f32x2*)(ws_ + WS_KF);
    LAS f32x2* X = (LAS f32x2*)(lds + FFT_X); LAS float* scr = (LAS float*)(lds + FFT_SCR);
    const int tid = TID, lane = tid & 63, wave = tid >> 6;
    fft_tables(lds);
    for (int u = blockIdx.x; u < 2048; u += gridDim.x) {
        const int o = u >> 10, c = u & 1023;
        const float* fwd = FILT + (size_t)(o * 2048 + c) * SEQ; const float* bwd = FILT + (size_t)(o * 2048 + 1024 + c) * SEQ;
        float asum = 0.f;
        {
            constexpr int NVF = (SEQ / 4 + 511) / 512;
            f32x4 lo[NVF], hi[NVF]; float a0[NVF];
#pragma unroll
            for (int jv = 0; jv < NVF; ++jv) {
                const int v = tid + 512 * jv, n = 8 * v; lo[jv] = (f32x4){0.f, 0.f, 0.f, 0.f}; hi[jv] = lo[jv]; a0[jv] = 0.f;
                if (v < SEQ / 4) {
                    if (n < SEQ) { lo[jv] = *(const f32x4*)(fwd + n); hi[jv] = *(const f32x4*)(fwd + n + 4); }
                    else { const float* blk = bwd + (2 * SEQ - n - 8); lo[jv] = *(const f32x4*)blk; hi[jv] = *(const f32x4*)(blk + 4); a0[jv] = (n == SEQ) ? 0.f : bwd[2 * SEQ - n]; }
                }
            }
#pragma unroll
            for (int jv = 0; jv < NVF; ++jv) {
                const int v = tid + 512 * jv, n = 8 * v;
                if (v < SEQ / 4) {
                    f32x4 l2 = lo[jv], h2 = hi[jv];
                    if (n >= SEQ) { const f32x4 b0 = lo[jv], b1 = hi[jv]; l2[0] = a0[jv]; l2[1] = b1[3]; l2[2] = b1[2]; l2[3] = b1[1]; h2[0] = b1[0]; h2[1] = b0[3]; h2[2] = b0[2]; h2[3] = b0[1]; }
                    LAS f32x4* q = (LAS f32x4*)(X + fpad(4 * v)); q[0] = l2; q[1] = h2;
                    asum += fabsf(l2[0]) + fabsf(l2[1]) + fabsf(l2[2]) + fabsf(l2[3]) + fabsf(h2[0]) + fabsf(h2[1]) + fabsf(h2[2]) + fabsf(h2[3]);
                }
            }
        }
        asum = wave_sum(asum);
        if (lane == 0) scr[wave] = asum;
        __syncthreads();
        float tot = 0.f;
        for (int w = 0; w < 8; ++w) tot += scr[w];
        const float inv = 1.f / tot;
        fft_dif(lds, tid);
        f32x4* kfp = (f32x4*)(KF + (size_t)u * KFP);
        for (int j = tid; j < SEQ / 2; j += 512) {
            const int p = 4 * (j >> 1) + (j & 1), k = (int)rev4((unsigned)p); f32x4 o;
            if (k == 0) { const f32x2 c0 = X[0]; o[0] = (c0.x + c0.y) * inv; o[1] = 0.f; o[2] = (c0.x - c0.y) * inv; o[3] = 0.f; }
            else {
                const int k2 = SEQ - k; const f32x2 ck = X[fpad(p)], ck2 = X[fpad(rev4(k2))];
                f32x2 E, O; E.x = 0.5f * (ck.x + ck2.x); E.y = 0.5f * (ck.y - ck2.y);
                const float dx = ck.x - ck2.x, dy = ck.y + ck2.y; O.x = 0.5f * dy; O.y = -0.5f * dx;
                const f32x2 wO = cmul(fft_halfroot(lds, k), O);
                const f32x2 ak = E + wO, ak2 = cconj(E - wO);
                o[0] = ak.x * inv; o[1] = ak.y * inv; o[2] = ak2.x * inv; o[3] = ak2.y * inv;
            }
            kfp[j] = o;
        }
        if (tid == 0) { const f32x2 ck = X[fpad(rev4(SEQ / 2))]; f32x4 o; o[0] = ck.x * inv; o[1] = -ck.y * inv; o[2] = 0.f; o[3] = 0.f; kfp[SEQ / 2] = o; }
        __syncthreads();
    }
}

DI void hy_conv3_vec(const bf16_t* ur, const float* hs, int ch, int v, float (&out)[8]) {
    const float w0 = hs[ch], w1 = hs[3072 + ch], w2 = hs[6144 + ch];
    const bf16x8 xv = *(const bf16x8*)(ur + 8 * v);
    const float xp = (v > 0) ? bf2f(ur[8 * v - 1]) : 0.f, xn = (8 * v + 8 < SEQ) ? bf2f(ur[8 * v + 8]) : 0.f;
    float x[10]; x[0] = xp; x[9] = xn;
#pragma unroll
    for (int i = 0; i < 8; ++i) x[i + 1] = bf2f((unsigned short)xv[i]);
#pragma unroll
    for (int i = 0; i < 8; ++i) out[i] = w0 * x[i] + w1 * x[i + 1] + w2 * x[i + 2];
}
DI void hy_kfload4(const f32x4* kfp, int jbase, f32x4 (&fp)[4]) {
#pragma unroll
    for (int i = 0; i < 4; ++i) { const int j = jbase + 512 * i; fp[i] = kfp[j < SEQ / 2 ? j : 0]; }
}
DI void hy_pointwise4(ldsp lds, int jbase, const f32x4 (&fp)[4]) {
    LAS f32x2* X = (LAS f32x2*)(lds + FFT_X);
#pragma unroll
    for (int i = 0; i < 4; ++i) {
        const int j = jbase + 512 * i; if (j >= SEQ / 2) continue;
        const int p = 4 * (j >> 1) + (j & 1), k = (int)rev4((unsigned)p);
        f32x2 kfk, kfk2; kfk.x = fp[i][0]; kfk.y = fp[i][1]; kfk2.x = fp[i][2]; kfk2.y = fp[i][3];
        if (k == 0) {
            const f32x2 c0 = X[0]; const float a0 = c0.x + c0.y, aL = c0.x - c0.y;
            const f32x2 y0 = kfk * a0, yL = kfk2 * aL;
            f32x2 s, d; s.x = 0.5f * (y0.x + yL.x); s.y = 0.5f * (y0.y - yL.y); d.x = 0.5f * (y0.x - yL.x); d.y = 0.5f * (y0.y + yL.y);
            f32x2 r; r.x = s.x - d.y; r.y = s.y + d.x; X[0] = r;
        } else {
            const int k2 = SEQ - k; const int r1 = fpad(p), r2 = fpad(rev4(k2)); const f32x2 ck = X[r1], ck2 = X[r2];
            f32x2 E, O; E.x = 0.5f * (ck.x + ck2.x); E.y = 0.5f * (ck.y - ck2.y);
            const float dx = ck.x - ck2.x, dy = ck.y + ck2.y; O.x = 0.5f * dy; O.y = -0.5f * dx;
            const f32x2 w = fft_halfroot(lds, k); const f32x2 wO = cmul(w, O);
            const f32x2 yk = cmul(E + wO, kfk), yk2 = cmul(cconj(E - wO), kfk2);
            f32x2 s, d; s.x = 0.5f * (yk.x + yk2.x); s.y = 0.5f * (yk.y - yk2.y); d.x = 0.5f * (yk.x - yk2.x); d.y = 0.5f * (yk.y + yk2.y);
            f32x2 t = cmulc(d, w); f32x2 r; r.x = s.x - t.y; r.y = s.y + t.x; X[r1] = r;
            f32x2 s2 = cconj(s); f32x2 d2; d2.x = -d.x; d2.y = d.y;
            f32x2 t2 = cmul(d2, w); r.x = s2.x + t2.y; r.y = s2.y - t2.x; X[r2] = r;
        }
    }
}
DI void phase_hy_conv(int l, ldsp lds) {
    unsigned char* const ws_ = WSP();
    const bf16_t* UT = (const bf16_t*)(ws_ + WS_UT); const f32x2* KF = (const f32x2*)(ws_ + WS_KF); bf16_t* Z2T = (bf16_t*)(ws_ + WS_Z2T);
    const float* hs = INP(I_HYS) + l * 3 * 3072; const float* hbias = INP(I_HYBIAS) + l * 2048;
    LAS f32x2* X = (LAS f32x2*)(lds + FFT_X);
    const int tid = TID;
    constexpr int NV = (SEQ / 8 + 511) / 512;
    fft_tables(lds);
    for (int c = blockIdx.x; c < 1024; c += gridDim.x) {
        float z[NV][8];
#pragma unroll
        for (int j = 0; j < NV; ++j) { if (tid + 512 * j < SEQ / 8) hy_conv3_vec(UT + (size_t)c * SEQ, hs, c, tid + 512 * j, z[j]); }
#pragma unroll 1
        for (int o = 0; o < 2; ++o) {
#pragma unroll
            for (int j = 0; j < NV; ++j) {
                const int m0 = 4 * (tid + 512 * j); if (tid + 512 * j >= SEQ / 8) continue;
                LAS f32x4* q = (LAS f32x4*)(X + fpad(m0)); f32x4 a, b; a[0] = z[j][0]; a[1] = z[j][1]; a[2] = z[j][2]; a[3] = z[j][3]; b[0] = z[j][4]; b[1] = z[j][5]; b[2] = z[j][6]; b[3] = z[j][7];
                q[0] = a; q[1] = b;
                LAS f32x4* q2 = (LAS f32x4*)(X + fpad(SEQ / 2 + m0)); q2[0] = (f32x4){0.f, 0.f, 0.f, 0.f}; q2[1] = (f32x4){0.f, 0.f, 0.f, 0.f};
            }
            const f32x4* kfp = (const f32x4*)(KF + (size_t)(o * 1024 + c) * KFP);
            __syncthreads();
            fft_dif(lds, tid);
            if (tid == 0) { const int r = fpad(rev4(SEQ / 2)); const f32x2 yk = cmul(cconj(X[r]), ld_xcu2((const f32x2*)(kfp + SEQ / 2))); X[r] = cconj(yk); }
            {
                constexpr int NKI = (SEQ / 2 + 511) / 512, NG = (NKI + 3) / 4;
                f32x4 fp0[4], fp1[4];
                hy_kfload4(kfp, tid, fp0);
#pragma unroll 1
                for (int g = 0; g < NG; g += 2) {
                    if (g + 1 < NG) hy_kfload4(kfp, tid + 2048 * (g + 1), fp1);
                    hy_pointwise4(lds, tid + 2048 * g, fp0);
                    if (g + 2 < NG) hy_kfload4(kfp, tid + 2048 * (g + 2), fp0);
                    if (g + 1 < NG) hy_pointwise4(lds, tid + 2048 * (g + 1), fp1);
                }
            }
            __syncthreads();
            fft_dit_inv(lds, tid);
            const float bias = hbias[o * 1024 + c]; const float invn = 1.f / (float)SEQ;
            const bf16_t* ug = UT + (size_t)(1024 * (o + 1) + c) * SEQ;
#pragma unroll
            for (int j = 0; j < NV; ++j) {
                const int v = tid + 512 * j; if (v >= SEQ / 8) continue; const LAS f32x4* q = (const LAS f32x4*)(X + fpad(4 * v)); const f32x4 a = q[0], b = q[1];
                float g[8]; hy_conv3_vec(ug, hs, 1024 * (o + 1) + c, v, g);
                z[j][0] = g[0] * (a[0] * invn + bias * z[j][0]); z[j][1] = g[1] * (a[1] * invn + bias * z[j][1]); z[j][2] = g[2] * (a[2] * invn + bias * z[j][2]); z[j][3] = g[3] * (a[3] * invn + bias * z[j][3]);
                z[j][4] = g[4] * (b[0] * invn + bias * z[j][4]); z[j][5] = g[5] * (b[1] * invn + bias * z[j][5]); z[j][6] = g[6] * (b[2] * invn + bias * z[j][6]); z[j][7] = g[7] * (b[3] * invn + bias * z[j][7]);
                if (o == 1) { u32x4 w; w.x = pk2(z[j][0], z[j][1]); w.y = pk2(z[j][2], z[j][3]); w.z = pk2(z[j][4], z[j][5]); w.w = pk2(z[j][6], z[j][7]); *(u32x4*)(Z2T + (size_t)c * SEQ + 8 * v) = w; }
            }
        }
        __syncthreads();
    }
}
DI void phase_hy_out(ldsp lds) {
    unsigned char* const ws_ = WSP();
    const bf16_t* Z2T = (const bf16_t*)(ws_ + WS_Z2T); bf16_t* Y = (bf16_t*)(ws_ + WS_Y);
    LAS unsigned short* T = (LAS unsigned short*)lds; const int tid = TID;
    for (int t = blockIdx.x; t < 16 * (SEQ / 64); t += gridDim.x) {
        const int c0 = (t & 15) * 64, t0 = (t >> 4) * 64;
        { const int r = tid >> 3, q8 = tid & 7; const bf16x8 v = *(const bf16x8*)(Z2T + (size_t)(c0 + r) * SEQ + t0 + 8 * q8);
#pragma unroll
          for (int j = 0; j < 8; ++j) T[(8 * q8 + j) * 72 + r] = (unsigned short)v[j]; }
        __syncthreads();
        { const int tt = tid >> 3, cc = tid & 7; *(u32x4*)(Y + (size_t)(t0 + tt) * 4096 + c0 + 8 * cc) = *(const LAS u32x4*)(T + tt * 72 + 8 * cc); }
        __syncthreads();
    }
}

constexpr float RSQ128 = 0.08838834764831845f;
DI void phase_ret_kv(int l, ldsp lds) {
    unsigned char* const ws_ = WSP();
    constexpr int PK = 272, PV = 528, KF_OFF = 0, KB_OFF = 128 * PK, V_OFF = 2 * 128 * PK;
    static_assert(V_OFF + 128 * PV <= LDS_PTRS, "lds");
    const bf16_t* PROJ = (const bf16_t*)(ws_ + WS_PROJ); float* KVT = (float*)(ws_ + WS_RKV); const float* dec = INP(I_RDEC) + l * 8;
    const int tid = TID, lane = tid & 63, w = tid >> 6, lr = lane & 15, lg = lane >> 4;
    for (int u = blockIdx.x; u < 4 * NCR; u += gridDim.x) {
        const int h = u / NCR, n = u % NCR, t0 = n * 128;
        const float lgf = logsig(dec[h]), lgb = logsig(dec[4 + h]);
#pragma unroll
        for (int i = 0; i < 4; ++i) {
            const int c = tid + 512 * i, r = c >> 4, cc = c & 15;
            const bf16x8 kv = *(const bf16x8*)(PROJ + (size_t)(t0 + r) * NPROJ + PC_RK + h * 128 + 8 * cc);
            const float sf = RSQ128 * fexp(lgf * (float)(127 - r)), sb = RSQ128 * fexp(lgb * (float)r);
            u32x4 of, ob;
#pragma unroll
            for (int j = 0; j < 4; ++j) { const float a = bf2f((unsigned short)kv[2 * j]), b = bf2f((unsigned short)kv[2 * j + 1]); of[j] = pk2(a * sf, b * sf); ob[j] = pk2(a * sb, b * sb); }
            *(LAS u32x4*)(lds + KF_OFF + r * PK + 16 * cc) = of; *(LAS u32x4*)(lds + KB_OFF + r * PK + 16 * cc) = ob;
        }
#pragma unroll
        for (int i = 0; i < 8; ++i) { const int c = tid + 512 * i, r = c >> 5, cc = c & 31; *(LAS u32x4*)(lds + V_OFF + r * PV + 16 * cc) = *(const u32x4*)(PROJ + (size_t)(t0 + r) * NPROJ + PC_RV + h * 256 + 8 * cc); }
        __syncthreads();
#pragma unroll 1
        for (int dir = 0; dir < 2; ++dir) {
            const unsigned koff = dir ? KB_OFF : KF_OFF;
            f32x4 acc[2][8];
#pragma unroll
            for (int a = 0; a < 2; ++a)
#pragma unroll
                for (int b = 0; b < 8; ++b) acc[a][b] = (f32x4){0.f, 0.f, 0.f, 0.f};
#pragma unroll 1
            for (int ks = 0; ks < 4; ++ks) {
                TrF avf[2], bvf[8];
#pragma unroll
                for (int e2 = 0; e2 < 2; ++e2) tr_issue(lds, V_OFF, PV, 32 * ks + 8 * lg, 32 * ks + 8 * lg + 4, 16 * (2 * w + e2), lr, avf[e2]);
#pragma unroll
                for (int dt = 0; dt < 8; ++dt) tr_issue(lds, koff, PK, 32 * ks + 8 * lg, 32 * ks + 8 * lg + 4, 16 * dt, lr, bvf[dt]);
                tr_wait2(avf[0], avf[1]); tr_wait2(bvf[0], bvf[1]); tr_wait2(bvf[2], bvf[3]); tr_wait2(bvf[4], bvf[5]); tr_wait2(bvf[6], bvf[7]);
#pragma unroll
                for (int dt = 0; dt < 8; ++dt)
#pragma unroll
                    for (int e2 = 0; e2 < 2; ++e2) acc[e2][dt] = mfma16(tr_val(bvf[dt]), tr_val(avf[e2]), acc[e2][dt]);
            }
            float* dst = KVT + (size_t)((dir * 4 + h) * NCR + n) * 32768;
#pragma unroll
            for (int e2 = 0; e2 < 2; ++e2)
#pragma unroll
                for (int dt = 0; dt < 8; ++dt) *(f32x4*)(dst + (16 * (2 * w + e2) + lr) * 128 + 16 * dt + 4 * lg) = acc[e2][dt];
        }
        __syncthreads();
    }
}
DI void phase_ret_scan(ldsp lds, int l) {
    unsigned char* const ws_ = WSP();
    const float* KVT = (const float*)(ws_ + WS_RKV); bf16_t* ST = (bf16_t*)(ws_ + WS_RST); const float* dec = INP(I_RDEC) + l * 8;
    static_assert(NCR % 8 == 0, "scan unroll");
    for (int g = blockIdx.x * 512 + TID; g < 8 * 32768; g += gridDim.x * 512) {
        const int dh = g >> 15, ed = g & 32767, dir = dh >> 2;
        const float G = expf(logsig(dec[dh]) * 128.f); float st = 0.f;
        const float* src = KVT + (size_t)dh * NCR * 32768 + ed; bf16_t* dst = ST + (size_t)dh * NCR * 32768 + ed;
#pragma unroll 1
        for (int nb = 0; nb < NCR; nb += 8) {
            const int n0 = dir ? (NCR - 8 - nb) : nb; float v[8];
#pragma unroll
            for (int j = 0; j < 8; ++j) v[j] = src[(size_t)(n0 + j) * 32768];
            if (dir == 0) {
#pragma unroll
                for (int j = 0; j < 8; ++j) { dst[(size_t)(n0 + j) * 32768] = f2bf(st); st = st * G + v[j]; }
            } else {
#pragma unroll
                for (int j = 7; j >= 0; --j) { dst[(size_t)(n0 + j) * 32768] = f2bf(st); st = st * G + v[j]; }
            }
        }
    }
}
DI void phase_ret_out(int l, ldsp lds) {
    unsigned char* const ws_ = WSP();
    constexpr int PK = 272, PV = 528, K_OFF = 0, V_OFF = 128 * PK;
    const bf16_t* PROJ = (const bf16_t*)(ws_ + WS_PROJ); const bf16_t* ST = (const bf16_t*)(ws_ + WS_RST); bf16_t* Y = (bf16_t*)(ws_ + WS_Y); const float* dec = INP(I_RDEC) + l * 8;
    const int tid = TID, lane = tid & 63, w = tid >> 6, lr = lane & 15, lg = lane >> 4;
    for (int u = blockIdx.x; u < 4 * NCR; u += gridDim.x) {
        const int h = u / NCR, n = u % NCR, t0 = n * 128;
        const float lgf = logsig(dec[h]), lgb = logsig(dec[4 + h]);
        const int i = 16 * w + lr; const size_t tok = (size_t)(t0 + i);
        bf16x8 qf[4];
#pragma unroll
        for (int ks = 0; ks < 4; ++ks) qf[ks] = *(const bf16x8*)(PROJ + tok * NPROJ + PC_RQ + h * 128 + 32 * ks + 8 * lg);
#pragma unroll
        for (int i = 0; i < 4; ++i) {
            const int c = tid + 512 * i, r = c >> 4, cc = c & 15;
            const bf16x8 kv = *(const bf16x8*)(PROJ + (size_t)(t0 + r) * NPROJ + PC_RK + h * 128 + 8 * cc); u32x4 o;
#pragma unroll
            for (int j = 0; j < 4; ++j) o[j] = pk2(bf2f((unsigned short)kv[2 * j]) * RSQ128, bf2f((unsigned short)kv[2 * j + 1]) * RSQ128);
            *(LAS u32x4*)(lds + K_OFF + r * PK + 16 * cc) = o;
        }
#pragma unroll
        for (int i = 0; i < 8; ++i) { const int c = tid + 512 * i, r = c >> 5, cc = c & 31; *(LAS u32x4*)(lds + V_OFF + r * PV + 16 * cc) = *(const u32x4*)(PROJ + (size_t)(t0 + r) * NPROJ + PC_RV + h * 256 + 8 * cc); }
        __syncthreads();
        f32x4 s[8];
#pragma unroll
        for (int jt = 0; jt < 8; ++jt) {
            s[jt] = (f32x4){0.f, 0.f, 0.f, 0.f};
#pragma unroll
            for (int ks = 0; ks < 4; ++ks) s[jt] = mfma16(lds_row8(lds, K_OFF + (16 * jt + lr) * PK + (32 * ks + 8 * lg) * 2), qf[ks], s[jt]);
#pragma unroll
            for (int r = 0; r < 4; ++r) { const int dm = i - (16 * jt + 4 * lg + r); float d = 0.f; if (dm >= 0) d += fexp(lgf * (float)dm); if (dm <= 0) d += fexp(lgb * (float)(-dm)); s[jt][r] *= d; }
        }
        bf16x8 pf[4];
#pragma unroll
        for (int kk = 0; kk < 4; ++kk) pf[kk] = pack8(s[2 * kk], s[2 * kk + 1]);
        const float wqf = fexp(lgf * (float)(i + 1)), wqb = fexp(lgb * (float)(128 - i));
        const bf16_t* stf = ST + (size_t)((0 * 4 + h) * NCR + n) * 32768; const bf16_t* stb = ST + (size_t)((4 + h) * NCR + n) * 32768;
        float* ry = (float*)(ws_ + WS_RY) + tok * 1024 + h * 256 + 4 * lg; float ss = 0.f;
#define RET_LD(et_, SF, SB) do { _Pragma("unroll") for (int ks = 0; ks < 4; ++ks) { SF[ks] = *(const bf16x8*)(stf + (16 * (et_) + lr) * 128 + 32 * ks + 8 * lg); SB[ks] = *(const bf16x8*)(stb + (16 * (et_) + lr) * 128 + 32 * ks + 8 * lg); } } while (0)
#define RET_ET(et_, SF, SB) do { f32x4 a1 = {0.f, 0.f, 0.f, 0.f}, af = a1, ab = a1; TrF vf[4]; \
            _Pragma("unroll") for (int kk = 0; kk < 4; ++kk) tr_issue(lds, V_OFF, PV, 32 * kk + 4 * lg, 32 * kk + 16 + 4 * lg, 16 * (et_), lr, vf[kk]); \
            tr_wait2(vf[0], vf[1]); tr_wait2(vf[2], vf[3]); \
            _Pragma("unroll") for (int kk = 0; kk < 4; ++kk) a1 = mfma16(tr_val(vf[kk]), pf[kk], a1); \
            _Pragma("unroll") for (int ks = 0; ks < 4; ++ks) { af = mfma16(SF[ks], qf[ks], af); ab = mfma16(SB[ks], qf[ks], ab); } \
            const f32x4 yv = a1 + af * wqf + ab * wqb; ss += dot4(yv, yv); *(f32x4*)(ry + 16 * (et_)) = yv; } while (0)
        {
            bf16x8 sfC[4], sbC[4];
            RET_LD(0, sfC, sbC);
#pragma unroll 1
            for (int et = 0; et < 16; ++et) {
                bf16x8 sfN[4], sbN[4]; const int en = (et + 1 < 16) ? et + 1 : et;
                RET_LD(en, sfN, sbN);
                RET_ET(et, sfC, sbC);
#pragma unroll
                for (int ks = 0; ks < 4; ++ks) { sfC[ks] = sfN[ks]; sbC[ks] = sbN[ks]; }
            }
        }
#undef RET_LD
#undef RET_ET
        ss += __shfl_xor(ss, 16); ss += __shfl_xor(ss, 32);
        const float rstd = rsqrtf(ss * (1.f / 256.f) + EPS);
#pragma unroll 1
        for (int et = 0; et < 16; ++et) {
            const int e0 = 16 * et + 4 * lg; const f32x4 yv = *(const f32x4*)(ry + 16 * et);
            const s16x4 gv = *(const s16x4*)(PROJ + tok * NPROJ + PC_RG + h * 256 + e0); float o[4];
#pragma unroll
            for (int r = 0; r < 4; ++r) { const float gg = bf2f((unsigned short)gv[r]); o[r] = yv[r] * rstd * (gg * frcp(1.f + fexp(-gg))); }
            u32x2 ww; ww.x = pk2(o[0], o[1]); ww.y = pk2(o[2], o[3]); *(u32x2*)(Y + tok * 4096 + 1024 + h * 256 + e0) = ww;
        }
        __syncthreads();
    }
}

DI void phase_att(int l, ldsp lds) {
    unsigned char* const ws_ = WSP();
    constexpr int PK = 272, K_OFF = 0, V_OFF = 256 * PK, NB = SEQ / 128;
    static_assert(2 * 256 * PK <= LDS_PTRS, "lds");
    const bf16_t* PROJ = (const bf16_t*)(ws_ + WS_PROJ); bf16_t* OB = (bf16_t*)(ws_ + WS_OB); float* LSE = (float*)(ws_ + WS_LSE);
    const float* gq = INP(I_AGAIN) + l * 256; const float* gk = gq + 128;
    const int tid = TID, lane = tid & 63, w = tid >> 6, lr = lane & 15, lg = lane >> 4;
    bf16x8 kvr[8]; u32x4 vvr[8];
    float gkr[8];
#pragma unroll
    for (int j = 0; j < 8; ++j) gkr[j] = gk[8 * (tid & 15) + j];
#define ATT_LOAD(uu) do { const int br_ = (uu) / (8 * NB), rem_ = (uu) % (8 * NB), h_ = rem_ / NB, ub_ = rem_ % NB; \
        const int dil_ = (br_ == 0) ? 1 : (br_ == 1) ? 4 : 16; const int n_ = SEQ / dil_, nblk_ = n_ / 128, rho_ = ub_ / nblk_, p0_ = (ub_ % nblk_) * 128; \
        _Pragma("unroll") for (int i = 0; i < 8; ++i) { const int c = tid + 512 * i, r = c >> 4, cc = c & 15; const int pp = p0_ - 64 + r; const bool valid = (pp >= 0) && (pp < n_); \
            const size_t tk = (size_t)(valid ? pp * dil_ + rho_ : 0); \
            kvr[i] = *(const bf16x8*)(PROJ + tk * NPROJ + PC_AK + h_ * 128 + 8 * cc); vvr[i] = *(const u32x4*)(PROJ + tk * NPROJ + PC_AV + h_ * 128 + 8 * cc); } } while (0)
    if ((int)blockIdx.x < 3 * 8 * NB) ATT_LOAD((int)blockIdx.x);
    for (int u = blockIdx.x; u < 3 * 8 * NB; u += gridDim.x) {
        const int br = u / (8 * NB), rem = u % (8 * NB), h = rem / NB, ub = rem % NB;
        const int dil = (br == 0) ? 1 : (br == 1) ? 4 : 16; const int n = SEQ / dil, nblk = n / 128, rho = ub / nblk, p0 = (ub % nblk) * 128;
        const float slope = exp2f(-(float)(h + 1)) * (float)dil;
        const int qi = 16 * w + lr; const size_t tq = (size_t)((p0 + qi) * dil + rho);
        bf16x8 qr[4];
#pragma unroll
        for (int ks = 0; ks < 4; ++ks) qr[ks] = *(const bf16x8*)(PROJ + tq * NPROJ + PC_AQ + h * 128 + 32 * ks + 8 * lg);
#pragma unroll
        for (int i = 0; i < 8; ++i) {
            const int c = tid + 512 * i, r = c >> 4, cc = c & 15; const int pp = p0 - 64 + r; const bool valid = (pp >= 0) && (pp < n);
            const bf16x8 kv = kvr[i]; u32x4 vv = vvr[i];
            float x[8]; float ss = 0.f;
#pragma unroll
            for (int j = 0; j < 8; ++j) { x[j] = valid ? bf2f((unsigned short)kv[j]) : 0.f; ss += x[j] * x[j]; }
            ss += __shfl_xor(ss, 1); ss += __shfl_xor(ss, 2); ss += __shfl_xor(ss, 4); ss += __shfl_xor(ss, 8);
            const float rstd = rsqrtf(ss * (1.f / 128.f) + EPS); u32x4 o;
#pragma unroll
            for (int j = 0; j < 4; ++j) o[j] = pk2(x[2 * j] * rstd * gkr[2 * j], x[2 * j + 1] * rstd * gkr[2 * j + 1]);
            if (!valid) vv = (u32x4){0u, 0u, 0u, 0u};
            *(LAS u32x4*)(lds + K_OFF + r * PK + 16 * cc) = o; *(LAS u32x4*)(lds + V_OFF + r * PK + 16 * cc) = vv;
            MEMFENCE();
        }
        __syncthreads();
        bf16x8 qf[4];
        {
            float ss = 0.f;
#pragma unroll
            for (int ks = 0; ks < 4; ++ks) {
#pragma unroll
                for (int j = 0; j < 8; ++j) { const float v = bf2f((unsigned short)qr[ks][j]); ss += v * v; } }
            ss += __shfl_xor(ss, 16); ss += __shfl_xor(ss, 32);
            const float rstd = rsqrtf(ss * (1.f / 128.f) + EPS) * RSQ128;
#pragma unroll
            for (int ks = 0; ks < 4; ++ks) { u32x4 o;
#pragma unroll
                for (int j = 0; j < 4; ++j) { const int d = 32 * ks + 8 * lg + 2 * j; o[j] = pk2(bf2f((unsigned short)qr[ks][2 * j]) * rstd * gq[d], bf2f((unsigned short)qr[ks][2 * j + 1]) * rstd * gq[d + 1]); }
                qf[ks] = __builtin_bit_cast(bf16x8, o); }
        }
        if (u + (int)gridDim.x < 3 * 8 * NB) ATT_LOAD(u + (int)gridDim.x);
        const float dlane = (float)(4 * lg - lr); const int kl = 16 * w + 4 * lg;
        const int klo = (p0 == 0) ? 64 : 0; const unsigned kspan = (unsigned)(((p0 + 128 == n) ? 192 : 256) - klo);
        f32x4 s[10]; float mx = -1e30f;
#pragma unroll
        for (int t = 0; t < 9; ++t) {
            s[t] = (f32x4){0.f, 0.f, 0.f, 0.f};
#pragma unroll
            for (int ks = 0; ks < 4; ++ks) s[t] = mfma16(lds_row8(lds, K_OFF + (16 * (w + t) + lr) * PK + (32 * ks + 8 * lg) * 2), qf[ks], s[t]);
#pragma unroll
            for (int r = 0; r < 4; ++r) {
                const float aof = fabsf((float)(16 * t + r - 64) + dlane);
                const bool valid = (aof <= 64.f) && ((unsigned)(16 * t + r + kl - klo) < kspan);
                const float sv = valid ? s[t][r] - slope * aof : -1e30f; s[t][r] = sv; mx = fmaxf(mx, sv);
            }
            MEMFENCE();
        }
        s[9] = (f32x4){0.f, 0.f, 0.f, 0.f};
        mx = fmaxf(mx, __shfl_xor(mx, 16)); mx = fmaxf(mx, __shfl_xor(mx, 32));
        float lsum = 0.f;
#pragma unroll
        for (int t = 0; t < 9; ++t)
#pragma unroll
            for (int r = 0; r < 4; ++r) { const float sv = s[t][r]; const float e = fexp(sv - mx); s[t][r] = e; lsum += e; }
        lsum += __shfl_xor(lsum, 16); lsum += __shfl_xor(lsum, 32);
        bf16x8 pf[5];
#pragma unroll
        for (int kk = 0; kk < 5; ++kk) pf[kk] = pack8(s[2 * kk], s[2 * kk + 1]);
        const float inv = 1.f / lsum;
        bf16_t* orow = OB + ((size_t)br * SEQ + tq) * 1024 + h * 128;
#pragma unroll 1
        for (int et = 0; et < 8; ++et) {
            f32x4 o = {0.f, 0.f, 0.f, 0.f};
            TrF vf[5];
#pragma unroll
            for (int kk = 0; kk < 5; ++kk) { const int ra = 16 * (w + 2 * kk) + 4 * lg, rb = (kk < 4) ? ra + 16 : ra; tr_issue(lds, V_OFF, PK, ra, rb, 16 * et, lr, vf[kk]); }
            tr_wait2(vf[0], vf[1]); tr_wait2(vf[2], vf[3]); tr_wait1(vf[4]);
#pragma unroll
            for (int kk = 0; kk < 5; ++kk) o = mfma16(tr_val(vf[kk]), pf[kk], o);
            u32x2 ww; ww.x = pk2(o[0] * inv, o[1] * inv); ww.y = pk2(o[2] * inv, o[3] * inv); *(u32x2*)(orow + 16 * et + 4 * lg) = ww;
        }
        if (lg == 0) LSE[((size_t)br * SEQ + tq) * 8 + h] = mx + logf(lsum);
        __syncthreads();
    }
#undef ATT_LOAD
}
DI void phase_att_merge(ldsp lds) {
    unsigned char* const ws_ = WSP();
    const bf16_t* OB = (const bf16_t*)(ws_ + WS_OB); const float* LSE = (const float*)(ws_ + WS_LSE); bf16_t* Y = (bf16_t*)(ws_ + WS_Y);
    for (int g = blockIdx.x * 512 + TID; g < SEQ * 128; g += gridDim.x * 512) {
        const int tok = g >> 7, h = (g >> 4) & 7, e8 = g & 15;
        const float l0 = LSE[((size_t)0 * SEQ + tok) * 8 + h], l1 = LSE[((size_t)1 * SEQ + tok) * 8 + h], l2 = LSE[((size_t)2 * SEQ + tok) * 8 + h];
        const float m = fmaxf(l0, fmaxf(l1, l2)); float w0 = fexp(l0 - m), w1 = fexp(l1 - m), w2 = fexp(l2 - m); const float inv = frcp(w0 + w1 + w2); w0 *= inv; w1 *= inv; w2 *= inv;
        const bf16x8 a = *(const bf16x8*)(OB + ((size_t)0 * SEQ + tok) * 1024 + h * 128 + 8 * e8), b = *(const bf16x8*)(OB + ((size_t)1 * SEQ + tok) * 1024 + h * 128 + 8 * e8), c = *(const bf16x8*)(OB + ((size_t)2 * SEQ + tok) * 1024 + h * 128 + 8 * e8);
        float o[8];
#pragma unroll
        for (int j = 0; j < 8; ++j) o[j] = w0 * bf2f((unsigned short)a[j]) + w1 * bf2f((unsigned short)b[j]) + w2 * bf2f((unsigned short)c[j]);
        u32x4 ww; ww.x = pk2(o[0], o[1]); ww.y = pk2(o[2], o[3]); ww.z = pk2(o[4], o[5]); ww.w = pk2(o[6], o[7]);
        *(u32x4*)(Y + (size_t)tok * 4096 + 2048 + h * 128 + 8 * e8) = ww;
    }
}

DI int ml_tok(int dir, int n, int i) { return dir ? SEQ - 1 - (64 * n + i) : 64 * n + i; }
DI void ml_gate_row(const float* G, const float* gb, int dir, int h, int n, int lane, float& ig, float& b) {
    const size_t tk = (size_t)ml_tok(dir, n, lane);
    ig = G[tk * 16 + dir * 8 + h] + gb[dir * 8 + h];
    const float lf = logsig(G[tk * 16 + dir * 8 + 4 + h] + gb[dir * 8 + 4 + h]);
    b = lf;
#pragma unroll
    for (int d = 1; d < 64; d <<= 1) { const float o = __shfl_up(b, d); if (lane >= d) b += o; }
}
DI void phase_ml_kv(int l, ldsp lds) {
    unsigned char* const ws_ = WSP();
    constexpr int PK = 272, PV = 528, KW_OFF = 0, V_OFF = 64 * PK, WA_OFF = V_OFF + 64 * PV;
    const bf16_t* PROJ = (const bf16_t*)(ws_ + WS_PROJ); const float* G = (const float*)(ws_ + WS_G); const float* gb = INP(I_MGB) + l * 16;
    float* KVT = (float*)(ws_ + WS_MKV); float* KSUM = (float*)(ws_ + WS_KSUM); float* MLOC = (float*)(ws_ + WS_MLOC); float* BLAST = (float*)(ws_ + WS_BLAST);
    LAS float* waL = (LAS float*)(lds + WA_OFF);
    const int tid = TID, lane = tid & 63, w = tid >> 6, lr = lane & 15, lg = lane >> 4;
    for (int u = blockIdx.x; u < 8 * NCM; u += gridDim.x) {
        const int dh = u / NCM, n = u % NCM, dir = dh >> 2, h = dh & 3;
        bf16x8 kreg[2]; u32x4 vreg[4];
#pragma unroll
        for (int i = 0; i < 2; ++i) { const int c = tid + 512 * i, r = c >> 4, cc = c & 15; const size_t tk = (size_t)ml_tok(dir, n, r); kreg[i] = *(const bf16x8*)(PROJ + tk * NPROJ + PC_MK + h * 128 + 8 * cc); }
#pragma unroll
        for (int i = 0; i < 4; ++i) { const int c = tid + 512 * i, r = c >> 5, cc = c & 31; const size_t tk = (size_t)ml_tok(dir, n, r); vreg[i] = *(const u32x4*)(PROJ + tk * NPROJ + PC_MV + h * 256 + 8 * cc); }
        if (w == 0) {
            float ig, b; ml_gate_row(G, gb, dir, h, n, lane, ig, b);
            const float blast = __shfl(b, 63); const float a = blast - b + ig; const float mloc = wave_max(a);
            waL[lane] = expf(a - mloc);
            if (lane == 0) { MLOC[dh * NCM + n] = mloc; BLAST[dh * NCM + n] = blast; }
        }
        __syncthreads();
#pragma unroll
        for (int i = 0; i < 2; ++i) {
            const int c = tid + 512 * i, r = c >> 4, cc = c & 15;
            const bf16x8 kv = kreg[i]; const float sc = RSQ128 * waL[r]; u32x4 o;
#pragma unroll
            for (int j = 0; j < 4; ++j) o[j] = pk2(bf2f((unsigned short)kv[2 * j]) * sc, bf2f((unsigned short)kv[2 * j + 1]) * sc);
            *(LAS u32x4*)(lds + KW_OFF + r * PK + 16 * cc) = o;
        }
#pragma unroll
        for (int i = 0; i < 4; ++i) { const int c = tid + 512 * i, r = c >> 5, cc = c & 31; *(LAS u32x4*)(lds + V_OFF + r * PV + 16 * cc) = vreg[i]; }
        __syncthreads();
        f32x4 acc[2][8];
#pragma unroll
        for (int a = 0; a < 2; ++a)
#pragma unroll
            for (int b = 0; b < 8; ++b) acc[a][b] = (f32x4){0.f, 0.f, 0.f, 0.f};
#pragma unroll 1
        for (int ks = 0; ks < 2; ++ks) {
            TrF avf[2], bvf[8];
#pragma unroll
            for (int e2 = 0; e2 < 2; ++e2) tr_issue(lds, V_OFF, PV, 32 * ks + 8 * lg, 32 * ks + 8 * lg + 4, 16 * (2 * w + e2), lr, avf[e2]);
#pragma unroll
            for (int dt = 0; dt < 8; ++dt) tr_issue(lds, KW_OFF, PK, 32 * ks + 8 * lg, 32 * ks + 8 * lg + 4, 16 * dt, lr, bvf[dt]);
            tr_wait2(avf[0], avf[1]); tr_wait2(bvf[0], bvf[1]); tr_wait2(bvf[2], bvf[3]); tr_wait2(bvf[4], bvf[5]); tr_wait2(bvf[6], bvf[7]);
#pragma unroll
            for (int dt = 0; dt < 8; ++dt)
#pragma unroll
                for (int e2 = 0; e2 < 2; ++e2) acc[e2][dt] = mfma16(tr_val(bvf[dt]), tr_val(avf[e2]), acc[e2][dt]);
        }
        float* dst = KVT + (size_t)(dh * NCM + n) * 32768;
#pragma unroll
        for (int e2 = 0; e2 < 2; ++e2)
#pragma unroll
            for (int dt = 0; dt < 8; ++dt) *(f32x4*)(dst + (16 * (2 * w + e2) + lr) * 128 + 16 * dt + 4 * lg) = acc[e2][dt];
        if (tid < 128) { float s = 0.f; for (int r = 0; r < 64; ++r) s += bf2f(*(const LAS unsigned short*)(lds + KW_OFF + r * PK + 2 * tid)); KSUM[(size_t)(dh * NCM + n) * 128 + tid] = s; }
        __syncthreads();
    }
}
DI void phase_ml_scan(ldsp lds) {
    unsigned char* const ws_ = WSP();
    const float* KVT = (const float*)(ws_ + WS_MKV); bf16_t* CT = (bf16_t*)(ws_ + WS_MCT); const float* KSUM = (const float*)(ws_ + WS_KSUM); float* NPREV = (float*)(ws_ + WS_NPREV);
    const float* MLOC = (const float*)(ws_ + WS_MLOC); const float* BLAST = (const float*)(ws_ + WS_BLAST); float* MPREV = (float*)(ws_ + WS_MPREV);
    LAS float* sp = (LAS float*)lds; LAS float* sc = sp + NCM;
    const int tid = TID;
    for (int wi = blockIdx.x; wi < 256; wi += gridDim.x) {
        const int dh = wi >> 5, slice = wi & 31;
        for (int n = tid; n < NCM; n += 512) { sp[n] = MLOC[dh * NCM + n]; sc[n] = BLAST[dh * NCM + n]; }
        __syncthreads();
        if (tid == 0) {
            float m = 0.f;
            for (int n = 0; n < NCM; ++n) {
                const float mloc = sp[n], bl = sc[n];
                if (slice == 0) MPREV[dh * NCM + n] = m;
                const float mn = fmaxf(bl + m, mloc); sp[n] = expf(bl + m - mn); sc[n] = expf(mloc - mn); m = mn;
            }
        }
        __syncthreads();
        {
            const int ed = slice * 1024 + tid; float c0 = 0.f, c1 = 0.f;
            const float* src = KVT + (size_t)dh * NCM * 32768 + ed; bf16_t* dst = CT + (size_t)dh * NCM * 32768 + ed;
#pragma unroll 1
            for (int n0 = 0; n0 < NCM; n0 += 8) {
                float v0[8], v1[8];
#pragma unroll
                for (int j = 0; j < 8; ++j) { v0[j] = src[(size_t)(n0 + j) * 32768]; v1[j] = src[(size_t)(n0 + j) * 32768 + 512]; }
#pragma unroll
                for (int j = 0; j < 8; ++j) { const float a = sp[n0 + j], b = sc[n0 + j]; dst[(size_t)(n0 + j) * 32768] = f2bf(c0); dst[(size_t)(n0 + j) * 32768 + 512] = f2bf(c1); c0 = a * c0 + b * v0[j]; c1 = a * c1 + b * v1[j]; }
            }
        }
        if (slice == 0 && tid < 128) { float v = 0.f; for (int n = 0; n < NCM; ++n) { NPREV[(size_t)(dh * NCM + n) * 128 + tid] = v; v = sp[n] * v + sc[n] * KSUM[(size_t)(dh * NCM + n) * 128 + tid]; } }
        __syncthreads();
    }
}
DI void phase_ml_out(int l, ldsp lds) {
    unsigned char* const ws_ = WSP();
    constexpr int PK = 272, PV = 528, K_OFF = 0, V_OFF = 64 * PK, F_OFF = V_OFF + 64 * PV, HF_OFF = F_OFF + 2048, SS_OFF = HF_OFF + 64 * 256 * 4;
    static_assert(SS_OFF + 512 <= LDS_PTRS, "lds");
    const bf16_t* PROJ = (const bf16_t*)(ws_ + WS_PROJ); const float* G = (const float*)(ws_ + WS_G); const float* gb = INP(I_MGB) + l * 16;
    const bf16_t* CT = (const bf16_t*)(ws_ + WS_MCT); const float* NPREV = (const float*)(ws_ + WS_NPREV); const float* MPREV = (const float*)(ws_ + WS_MPREV);
    bf16_t* Y = (bf16_t*)(ws_ + WS_Y); const float* ng = INP(I_MNG) + l * 1024;
    LAS float* U = (LAS float*)(lds + F_OFF); LAS float* BM = U + 64; LAS float* WI = BM + 64; LAS float* EMT = WI + 64; LAS float* NP = EMT + 64;
    LAS float* HF = (LAS float*)(lds + HF_OFF); LAS float* SS = (LAS float*)(lds + SS_OFF);
    const int tid = TID, lane = tid & 63, w = tid >> 6, lr = lane & 15, lg = lane >> 4;
    const int qs = w & 3, eh = w >> 2, i = 16 * qs + lr;
    for (int u = blockIdx.x; u < 4 * NCM; u += gridDim.x) {
        const int h = u / NCM, nt = u % NCM;
#pragma unroll 1
        for (int dir = 0; dir < 2; ++dir) {
            const int dh = dir * 4 + h, n = dir ? NCM - 1 - nt : nt;
            bf16x8 kreg[2]; u32x4 vreg[4]; bf16x8 qf[4];
#pragma unroll
            for (int ii = 0; ii < 2; ++ii) { const int c = tid + 512 * ii, r = c >> 4, cc = c & 15; const size_t tk = (size_t)ml_tok(dir, n, r); kreg[ii] = *(const bf16x8*)(PROJ + tk * NPROJ + PC_MK + h * 128 + 8 * cc); }
#pragma unroll
            for (int ii = 0; ii < 4; ++ii) { const int c = tid + 512 * ii, r = c >> 5, cc = c & 31; const size_t tk = (size_t)ml_tok(dir, n, r); vreg[ii] = *(const u32x4*)(PROJ + tk * NPROJ + PC_MV + h * 256 + 8 * cc); }
            const size_t tq = (size_t)ml_tok(dir, n, i);
#pragma unroll
            for (int ks = 0; ks < 4; ++ks) qf[ks] = *(const bf16x8*)(PROJ + tq * NPROJ + PC_MQ + h * 128 + 32 * ks + 8 * lg);
            const bf16_t* ct = CT + (size_t)(dh * NCM + n) * 32768;
            bf16x8 cfall[4][4];
#pragma unroll
            for (int e8 = 0; e8 < 4; ++e8)
#pragma unroll
                for (int ks = 0; ks < 4; ++ks) cfall[e8][ks] = *(const bf16x8*)(ct + (16 * (8 * eh + e8) + lr) * 128 + 32 * ks + 8 * lg);
            if (w == 0) {
                float ig, b; ml_gate_row(G, gb, dir, h, n, lane, ig, b);
                const float uu = ig - b; float pm = uu;
#pragma unroll
                for (int d = 1; d < 64; d <<= 1) { const float o = __shfl_up(pm, d); if (lane >= d) pm = fmaxf(pm, o); }
                const float mprev = ld_xcu(MPREV + dh * NCM + n); const float mt = b + fmaxf(mprev, pm);
                U[lane] = uu; BM[lane] = b - mt; WI[lane] = expf(b + mprev - mt); EMT[lane] = expf(-mt);
            }
            if (tid >= 64 && tid < 192) NP[tid - 64] = NPREV[(size_t)(dh * NCM + n) * 128 + tid - 64];
#pragma unroll
            for (int ii = 0; ii < 2; ++ii) {
                const int c = tid + 512 * ii, r = c >> 4, cc = c & 15; const bf16x8 kv = kreg[ii]; u32x4 o;
#pragma unroll
                for (int j = 0; j < 4; ++j) o[j] = pk2(bf2f((unsigned short)kv[2 * j]) * RSQ128, bf2f((unsigned short)kv[2 * j + 1]) * RSQ128);
                *(LAS u32x4*)(lds + K_OFF + r * PK + 16 * cc) = o;
            }
#pragma unroll
            for (int ii = 0; ii < 4; ++ii) { const int c = tid + 512 * ii, r = c >> 5, cc = c & 31; *(LAS u32x4*)(lds + V_OFF + r * PV + 16 * cc) = vreg[ii]; }
            __syncthreads();
            float qn = 0.f;
#pragma unroll
            for (int ks = 0; ks < 4; ++ks)
#pragma unroll
                for (int j = 0; j < 8; ++j) qn += bf2f((unsigned short)qf[ks][j]) * NP[32 * ks + 8 * lg + j];
            qn += __shfl_xor(qn, 16); qn += __shfl_xor(qn, 32);
            const float bmi = BM[i], wii = WI[i];
            f32x4 s[4]; float dsum = 0.f;
#pragma unroll
            for (int jt = 0; jt < 4; ++jt) {
                s[jt] = (f32x4){0.f, 0.f, 0.f, 0.f};
                if (jt <= qs) {
#pragma unroll
                    for (int ks = 0; ks < 4; ++ks) s[jt] = mfma16(lds_row8(lds, K_OFF + (16 * jt + lr) * PK + (32 * ks + 8 * lg) * 2), qf[ks], s[jt]);
#pragma unroll
                    for (int r = 0; r < 4; ++r) { const int j = 16 * jt + 4 * lg + r; const float v = (j <= i) ? s[jt][r] * fexp(U[j] + bmi) : 0.f; s[jt][r] = v; dsum += v; }
                }
            }
            dsum += __shfl_xor(dsum, 16); dsum += __shfl_xor(dsum, 32);
            const float den = dsum + wii * qn; const float rden = 1.f / fmaxf(fabsf(den), EMT[i]);
            bf16x8 pf[2];
#pragma unroll
            for (int kk = 0; kk < 2; ++kk) pf[kk] = pack8(s[2 * kk], s[2 * kk + 1]);
            f32x4 tot[8]; float ssq = 0.f;
#pragma unroll
            for (int e8 = 0; e8 < 8; ++e8) {
                const int et = 8 * eh + e8; f32x4 a1 = {0.f, 0.f, 0.f, 0.f}, a2 = a1;
                TrF vf[2];
#pragma unroll
                for (int kk = 0; kk < 2; ++kk) tr_issue(lds, V_OFF, PV, 32 * kk + 4 * lg, 32 * kk + 16 + 4 * lg, 16 * et, lr, vf[kk]);
                tr_wait2(vf[0], vf[1]);
#pragma unroll
                for (int kk = 0; kk < 2; ++kk) a1 = mfma16(tr_val(vf[kk]), pf[kk], a1);
#pragma unroll
                for (int ks = 0; ks < 4; ++ks) a2 = mfma16(cfall[e8 & 3][ks], qf[ks], a2);
                if (e8 < 4) {
#pragma unroll
                    for (int ks = 0; ks < 4; ++ks) cfall[e8][ks] = *(const bf16x8*)(ct + (16 * (et + 4) + lr) * 128 + 32 * ks + 8 * lg);
                }
                const f32x4 hv = (a1 + a2 * wii) * rden;
                if (dir == 0) { *(LAS f32x4*)(HF + i * 256 + 16 * et + 4 * lg) = hv; tot[e8] = hv; }
                else { const f32x4 hf = *(const LAS f32x4*)(HF + (63 - i) * 256 + 16 * et + 4 * lg); tot[e8] = hv + hf; ssq += dot4(tot[e8], tot[e8]); }
                MEMFENCE();
            }
            if (dir == 1) {
                ssq += __shfl_xor(ssq, 16); ssq += __shfl_xor(ssq, 32);
                if (lg == 0) SS[i * 2 + eh] = ssq;
            }
            __syncthreads();
            if (dir == 1) {
                const float rstd = rsqrtf((SS[i * 2] + SS[i * 2 + 1]) * (1.f / 256.f) + EPS);
                const size_t tok = (size_t)(64 * nt + 63 - i);
#pragma unroll
                for (int e8 = 0; e8 < 8; ++e8) {
                    const int e0 = 16 * (8 * eh + e8) + 4 * lg;
                    const f32x4 gn = *(const f32x4*)(ng + h * 256 + e0); const s16x4 ov = *(const s16x4*)(PROJ + tok * NPROJ + PC_MO + h * 256 + e0); float o[4];
#pragma unroll
                    for (int r = 0; r < 4; ++r) o[r] = sigm(bf2f((unsigned short)ov[r])) * tot[e8][r] * rstd * gn[r];
                    u32x2 ww; ww.x = pk2(o[0], o[1]); ww.y = pk2(o[2], o[3]); *(u32x2*)(Y + tok * 4096 + 3072 + h * 256 + e0) = ww;
                }
            }
        }
    }
}

#ifndef HIPEMU
namespace pg8 {
constexpr int BM = 256, BK = 64, HALF = 128, HTB = HALF * BK * 2, STAGE_BYTES = 8 * HTB, NXCD = 8, WGM = 8;
__host__ __device__ __forceinline__ int lds_byte(int r, int c) { const int st = (r >> 4) * 2 + (c >> 5), rr = r & 15, cc = c & 31, ob = rr * 64 + cc * 2; return st * 1024 + (ob ^ (((ob >> 9) & 1) << 5)); }
__host__ __device__ __forceinline__ void stage_rc(int b, int& R, int& C) { const int st = b / 1024, sb = b % 1024, swz = sb ^ (((sb >> 9) & 1) << 5); R = (st >> 1) * 16 + swz / 64; C = (st & 1) * 32 + (swz % 64) / 2; }
__host__ __device__ __forceinline__ int perm32(int rho) { const int n = rho >> 4, i = rho & 15; return 8 * (i >> 2) + 4 * n + (i & 3); }
struct Unit { int pm, pn; };
struct Gemm { const bf16_t* A; const bf16_t* Bt; int M, N, K; };
struct StaticOrder {
    int nM, nN, nwg, G, c;
    __host__ __device__ void init(int M, int N, int G_, int c_) { nM = M / BM; nN = N / BM; nwg = nM * nN; G = G_; c = c_; }
    __host__ __device__ bool next(int i, Unit& u) const {
        const long L = (long)i * G + c; if (L >= nwg) return false;
        int wgid = (int)L; { const int q = nwg / NXCD, r = nwg % NXCD, xcd = wgid % NXCD, off = wgid / NXCD; wgid = (xcd < r ? xcd * (q + 1) : r * (q + 1) + (xcd - r) * q) + off; }
        const int nig = WGM * nN, gid = wgid / nig, fm = gid * WGM, gsz = (nM - fm) < WGM ? (nM - fm) : WGM;
        u.pm = fm + ((wgid % nig) % gsz); u.pn = (wgid % nig) / gsz; return true;
    }
    __device__ __forceinline__ void a_ready(const Unit&) const {}
    __device__ __forceinline__ void done(const Unit&) const {}
};
struct EpiStoreBf16 {
    static constexpr bool PERM = true, AFTER_DRAIN = false;
    bf16_t* O; int ldc;
    __device__ __forceinline__ void operator()(const f32x4 (&acc)[2][2][4][2], const Unit& u, int wr, int wc, int fr, int fq) const {
        const int row0 = u.pm * BM + wr * 64 + fr, col0 = u.pn * BM + wc * 32 + 8 * fq;
#pragma unroll
        for (int ai = 0; ai < 2; ++ai)
#pragma unroll
            for (int m = 0; m < 4; ++m) { bf16_t* rowp = O + (size_t)(row0 + ai * HALF + m * 16) * ldc + col0;
#pragma unroll
                for (int bj = 0; bj < 2; ++bj) { const f32x4 v0 = acc[ai][bj][m][0], v1 = acc[ai][bj][m][1];
                    u32x4 w; w.x = pk2(v0[0], v0[1]); w.y = pk2(v0[2], v0[3]); w.z = pk2(v1[0], v1[1]); w.w = pk2(v1[2], v1[3]);
                    *(u32x4*)(rowp + bj * HALF) = w; } }
    }
};
struct EpiSwiGLU {
    static constexpr bool PERM = true, AFTER_DRAIN = false;
    bf16_t* O; int ldc;
    __device__ __forceinline__ void operator()(const f32x4 (&acc)[2][2][4][2], const Unit& u, int wr, int wc, int fr, int fq) const {
        const int row0 = u.pm * BM + wr * 64 + fr, col0 = u.pn * HALF + wc * 32 + 8 * fq;
#pragma unroll
        for (int ai = 0; ai < 2; ++ai)
#pragma unroll
            for (int m = 0; m < 4; ++m) { bf16_t* rowp = O + (size_t)(row0 + ai * HALF + m * 16) * ldc + col0; float o[8];
#pragma unroll
                for (int n = 0; n < 2; ++n)
#pragma unroll
                    for (int j = 0; j < 4; ++j) { const float a = acc[ai][0][m][n][j], b = acc[ai][1][m][n][j]; o[4 * n + j] = a * __builtin_amdgcn_rcpf(1.f + __builtin_amdgcn_exp2f(a * -1.4426950408889634f)) * b; }
                u32x4 w; w.x = pk2(o[0], o[1]); w.y = pk2(o[2], o[3]); w.z = pk2(o[4], o[5]); w.w = pk2(o[6], o[7]);
                *(u32x4*)rowp = w; }
    }
};
struct EpiResid {
    static constexpr bool PERM = false, AFTER_DRAIN = false;
    const float* xin; float* xout; const float* gate; int ldc;
    __device__ __forceinline__ void operator()(const f32x4 (&acc)[2][2][4][2], const Unit& u, int wr, int wc, int fr, int fq) const {
        const int row0 = u.pm * BM + wr * 64 + fr, col0 = u.pn * BM + wc * 32 + 4 * fq;
        f32x4 gv[2][2];
#pragma unroll
        for (int bj = 0; bj < 2; ++bj)
#pragma unroll
            for (int n = 0; n < 2; ++n) gv[bj][n] = *(const f32x4*)(gate + col0 + bj * HALF + n * 16);
#pragma unroll
        for (int ai = 0; ai < 2; ++ai)
#pragma unroll
            for (int m2 = 0; m2 < 2; ++m2) { f32x4 xi[2][2][2];
#pragma unroll
                for (int mm = 0; mm < 2; ++mm)
#pragma unroll
                    for (int bj = 0; bj < 2; ++bj)
#pragma unroll
                        for (int n = 0; n < 2; ++n) xi[mm][bj][n] = *(const f32x4*)(xin + (size_t)(row0 + ai * HALF + (2 * m2 + mm) * 16) * ldc + col0 + bj * HALF + n * 16);
                asm volatile("s_waitcnt vmcnt(0)" ::: "memory");
#pragma unroll
                for (int mm = 0; mm < 2; ++mm)
#pragma unroll
                    for (int bj = 0; bj < 2; ++bj)
#pragma unroll
                        for (int n = 0; n < 2; ++n) *(f32x4*)(xout + (size_t)(row0 + ai * HALF + (2 * m2 + mm) * 16) * ldc + col0 + bj * HALF + n * 16) = xi[mm][bj][n] + gv[bj][n] * acc[ai][bj][2 * m2 + mm][n]; }
    }
};
template <class Epi, class Sched, bool ALIGN_EPI = false, bool SP2 = false>
__device__ __forceinline__ void gemm_phase(ldsp lds, const Gemm g, const Sched& S, const Epi& E) {
    const int tid = threadIdx.x, wid = __builtin_amdgcn_readfirstlane(tid >> 6), lane = tid & 63, wr = wid >> 2, wc = wid & 3, fr = lane & 15, fq = lane >> 4;
    const int K = g.K, nt = K / BK;
    unsigned voffA[2], voffB[2];
#pragma unroll
    for (int i = 0; i < 2; ++i) { int R, C; stage_rc(tid * 16 + i * 8192, R, C); const int Rb = Epi::PERM ? ((R & ~31) + perm32(R & 31)) : R;
        voffA[i] = (unsigned)(R * K + C) * 2u; voffB[i] = (unsigned)(Rb * K + C) * 2u; }
    const size_t kstep = (size_t)(BK * 2);
    const size_t hstep = (size_t)HALF * K * 2;
    const size_t tstep = 2 * hstep;
    const unsigned ldsw = (unsigned)wid * 1024u;
    const int aoff = lds_byte(wr * 64 + fr, fq * 8), boff = lds_byte(wc * 32 + fr, fq * 8);
#define PG8_SA(b, h) (((b) * 2 + (h)) * HTB)
#define PG8_SB(b, h) ((4 + (b) * 2 + (h)) * HTB)
#define PG8_STAGE(bufoff, gbase, voff) do { _Pragma("unroll") for (int _i = 0; _i < 2; ++_i) \
        __builtin_amdgcn_global_load_lds((const unsigned*)((const char*)(gbase) + (voff)[_i]), (LAS unsigned*)(lds + (bufoff) + ldsw + _i * 8192), 16, 0, 0); } while (0)
#define PG8_LDA(dst, b, h) do { _Pragma("unroll") for (int m = 0; m < 4; ++m) _Pragma("unroll") for (int k = 0; k < 2; ++k) dst[m][k] = *(const LAS bf16x8*)(lds + PG8_SA(b, h) + aoff + m * 2048 + k * 1024); } while (0)
#define PG8_LDB(dst, b, h) do { _Pragma("unroll") for (int n = 0; n < 2; ++n) _Pragma("unroll") for (int k = 0; k < 2; ++k) dst[n][k] = *(const LAS bf16x8*)(lds + PG8_SB(b, h) + boff + n * 2048 + k * 1024); } while (0)
#define PG8_MMA(ai, bj, At, Bt) do { __builtin_amdgcn_s_setprio(1); _Pragma("unroll") for (int m = 0; m < 4; ++m) _Pragma("unroll") for (int n = 0; n < 2; ++n) _Pragma("unroll") for (int k = 0; k < 2; ++k) \
        acc[ai][bj][m][n] = __builtin_amdgcn_mfma_f32_16x16x32_bf16(Bt[n][k], At[m][k], acc[ai][bj][m][n], 0, 0, 0); __builtin_amdgcn_s_setprio(0); } while (0)
#define PG8_WAIT_V(n) asm volatile("s_waitcnt vmcnt(" #n ")" ::: "memory")
#define PG8_WAIT_L(n) asm volatile("s_waitcnt lgkmcnt(" #n ")" ::: "memory")
#define PG8_BAR __builtin_amdgcn_s_barrier()
#define PG8_SCHED __builtin_amdgcn_sched_barrier(0)
    Unit cur, nxt; int ui = 0;
    if (!S.next(0, cur)) return;
    f32x4 acc[2][2][4][2];
#pragma unroll
    for (int a = 0; a < 2; ++a)
#pragma unroll
        for (int b = 0; b < 2; ++b)
#pragma unroll
            for (int m = 0; m < 4; ++m)
#pragma unroll
                for (int n = 0; n < 2; ++n) acc[a][b][m][n] = (f32x4){0.f, 0.f, 0.f, 0.f};
    bf16x8 At[4][2], B0[2][2], B1[2][2];
    const char* cA = (const char*)g.A + (size_t)cur.pm * tstep; const char* cB = (const char*)g.Bt + (size_t)cur.pn * tstep;
    S.a_ready(cur);
    if constexpr (SP2) {
        PG8_STAGE(PG8_SB(0, 0), cB, voffB); PG8_STAGE(PG8_SB(0, 1), cB + hstep, voffB); PG8_STAGE(PG8_SA(0, 0), cA, voffA); PG8_STAGE(PG8_SA(0, 1), cA + hstep, voffA);
        if (wr == 1) PG8_BAR;
        PG8_WAIT_V(2); PG8_BAR;
        PG8_STAGE(PG8_SB(1, 0), cB + kstep, voffB); PG8_STAGE(PG8_SA(1, 0), cA + kstep, voffA); PG8_STAGE(PG8_SB(1, 1), cB + hstep + kstep, voffB);
        PG8_WAIT_V(6); PG8_BAR;
    } else {
        PG8_STAGE(PG8_SB(0, 0), cB, voffB); PG8_STAGE(PG8_SA(0, 0), cA, voffA); PG8_STAGE(PG8_SB(0, 1), cB + hstep, voffB); PG8_STAGE(PG8_SA(0, 1), cA + hstep, voffA);
        if (wr == 1) PG8_BAR;
        PG8_WAIT_V(4); PG8_BAR;
        PG8_STAGE(PG8_SB(1, 0), cB + kstep, voffB); PG8_STAGE(PG8_SA(1, 0), cA + kstep, voffA); PG8_STAGE(PG8_SB(1, 1), cB + hstep + kstep, voffB);
        PG8_WAIT_V(6); PG8_BAR;
    }
    for (;;) {
        const bool has_next = S.next(ui + 1, nxt);
        const char* nA = has_next ? (const char*)g.A + (size_t)nxt.pm * tstep : cA; const char* nB = has_next ? (const char*)g.Bt + (size_t)nxt.pn * tstep : cB;
        for (int t = 0; t < nt; t += 2) {
            const bool last = (t == nt - 2);
            const char* a1 = cA + (size_t)(t + 1) * kstep;
            const char* a2 = last ? nA : cA + (size_t)(t + 2) * kstep; const char* b2 = last ? nB : cB + (size_t)(t + 2) * kstep;
            const char* a3 = a2 + kstep; const char* b3 = b2 + kstep;
            if (last && has_next) S.a_ready(nxt);
            if constexpr (SP2) {
            PG8_LDB(B0, 0, 0); PG8_LDB(B1, 0, 1); PG8_SCHED; PG8_LDA(At, 0, 0); PG8_STAGE(PG8_SA(1, 1), a1 + hstep, voffA);
            PG8_WAIT_V(8); PG8_WAIT_L(0); PG8_BAR; PG8_MMA(0, 0, At, B0); PG8_MMA(0, 1, At, B1); PG8_BAR; PG8_SCHED;
            PG8_LDA(At, 0, 1); PG8_STAGE(PG8_SB(0, 0), b2, voffB); PG8_STAGE(PG8_SB(0, 1), b2 + hstep, voffB); PG8_STAGE(PG8_SA(0, 0), a2, voffA);
            PG8_WAIT_V(8); PG8_WAIT_L(0); PG8_BAR; PG8_MMA(1, 0, At, B0); PG8_MMA(1, 1, At, B1); PG8_BAR; PG8_SCHED;
            PG8_LDB(B0, 1, 0); PG8_LDB(B1, 1, 1); PG8_SCHED; PG8_LDA(At, 1, 0); PG8_STAGE(PG8_SA(0, 1), a2 + hstep, voffA);
            PG8_WAIT_V(8); PG8_WAIT_L(0); PG8_BAR; PG8_MMA(0, 0, At, B0); PG8_MMA(0, 1, At, B1); PG8_BAR; PG8_SCHED;
            PG8_LDA(At, 1, 1); PG8_STAGE(PG8_SB(1, 0), b3, voffB); PG8_STAGE(PG8_SB(1, 1), b3 + hstep, voffB); PG8_STAGE(PG8_SA(1, 0), a3, voffA);
            PG8_WAIT_V(8); PG8_WAIT_L(0); PG8_BAR; PG8_MMA(1, 0, At, B0); PG8_MMA(1, 1, At, B1); PG8_BAR; PG8_SCHED;
            } else {
            PG8_LDB(B0, 0, 0); PG8_SCHED; PG8_LDA(At, 0, 0); PG8_STAGE(PG8_SA(1, 1), a1 + hstep, voffA);
            PG8_WAIT_L(8); PG8_BAR; PG8_WAIT_L(0); PG8_MMA(0, 0, At, B0); PG8_BAR; PG8_SCHED;
            PG8_LDB(B1, 0, 1); PG8_STAGE(PG8_SB(0, 0), b2, voffB);
            PG8_BAR; PG8_WAIT_L(0); PG8_MMA(0, 1, At, B1); PG8_BAR;
            PG8_LDA(At, 0, 1); PG8_STAGE(PG8_SA(0, 0), a2, voffA);
            PG8_BAR; PG8_WAIT_L(0); PG8_MMA(1, 0, At, B0); PG8_BAR; PG8_SCHED;
            PG8_STAGE(PG8_SB(0, 1), b2 + hstep, voffB);
            PG8_WAIT_V(6); PG8_BAR; PG8_MMA(1, 1, At, B1); PG8_BAR;
            PG8_LDB(B0, 1, 0); PG8_SCHED; PG8_LDA(At, 1, 0); PG8_STAGE(PG8_SA(0, 1), a2 + hstep, voffA);
            PG8_WAIT_L(8); PG8_BAR; PG8_WAIT_L(0); PG8_MMA(0, 0, At, B0); PG8_BAR; PG8_SCHED;
            PG8_LDB(B1, 1, 1); PG8_STAGE(PG8_SB(1, 0), b3, voffB);
            PG8_BAR; PG8_WAIT_L(0); PG8_MMA(0, 1, At, B1); PG8_BAR;
            PG8_LDA(At, 1, 1); PG8_STAGE(PG8_SA(1, 0), a3, voffA);
            PG8_BAR; PG8_WAIT_L(0); PG8_MMA(1, 0, At, B0); PG8_BAR; PG8_SCHED;
            PG8_STAGE(PG8_SB(1, 1), b3 + hstep, voffB);
            PG8_WAIT_V(6); PG8_BAR; PG8_MMA(1, 1, At, B1); PG8_BAR;
            }
        }
        if constexpr (ALIGN_EPI) { if (wr == 0) PG8_BAR; }
        if constexpr (!Epi::AFTER_DRAIN) { E(acc, cur, wr, wc, fr, fq); S.done(cur); }
        if (!has_next) break;
#pragma unroll
        for (int a = 0; a < 2; ++a)
#pragma unroll
            for (int b = 0; b < 2; ++b)
#pragma unroll
                for (int m = 0; m < 4; ++m)
#pragma unroll
                    for (int n = 0; n < 2; ++n) acc[a][b][m][n] = (f32x4){0.f, 0.f, 0.f, 0.f};
        cur = nxt; cA = nA; cB = nB; ++ui;
        if constexpr (ALIGN_EPI) { if (wr == 1) PG8_BAR; }
    }
    PG8_WAIT_V(0);
    if constexpr (!ALIGN_EPI) { if (wr == 0) PG8_BAR; }
    PG8_BAR;
    if constexpr (Epi::AFTER_DRAIN) { E.fused(acc, cur, wr, wc, fr, fq, lds, wid, lane); S.done(cur); }
#undef PG8_SA
#undef PG8_SB
#undef PG8_STAGE
#undef PG8_LDA
#undef PG8_LDB
#undef PG8_MMA
#undef PG8_WAIT_V
#undef PG8_WAIT_L
#undef PG8_BAR
#undef PG8_SCHED
}
}

#define XB_TMO      128
#define XB_XCNT(j)  (256  + 64 * (j))
#define XB_XSUB(j)  (1280 + 64 * (j))
#define XB_XGEN(j)  (2304 + 64 * (j))
#define XB_TOP      3328
#define XB_TOPGEN   3392
#define XCD_BAR_WORDS 3456
#define XB_SPIN_CAP (1u << 22)
__device__ __forceinline__ unsigned xb_ld(unsigned* p)              { return __hip_atomic_load(p, __ATOMIC_RELAXED, __HIP_MEMORY_SCOPE_AGENT); }
__device__ __forceinline__ unsigned xb_add(unsigned* p, unsigned v) { return __hip_atomic_fetch_add(p, v, __ATOMIC_RELAXED, __HIP_MEMORY_SCOPE_AGENT); }
__device__ __forceinline__ unsigned xb_xcc_id() { return (unsigned)__builtin_amdgcn_s_getreg((3 << 11) | 20) & 0xFu; }
#define XB_SPIN(cond, bar) do { unsigned _sp = 0; while (cond) { __builtin_amdgcn_s_sleep(1); \
    if ((++_sp & 255u) == 0u) { if (xb_ld(&(bar)[XB_TMO])) break; if (_sp > XB_SPIN_CAP) { atomicAdd(&(bar)[XB_TMO], 1u); break; } } } } while (0)
struct XcdBarrier { unsigned* bar; unsigned x; volatile LAS unsigned* st; };
__device__ __forceinline__ XcdBarrier xcd_barrier_post(unsigned* bar, volatile LAS unsigned* st) {
    XcdBarrier b; b.bar = bar; b.x = xb_xcc_id(); b.st = st;
    if (threadIdx.x == 0) (void)xb_add(&bar[XB_XCNT(b.x)], 1u);
    return b;
}
__device__ __forceinline__ void xcd_barrier_complete(unsigned* bar, unsigned x, unsigned& nloc, unsigned& nx) {
    const unsigned G = gridDim.x * gridDim.y * gridDim.z;
    unsigned sum, cnt, mine, sp = 0u;
    for (;;) {
        sum = 0u; cnt = 0u; mine = 0u;
#pragma unroll
        for (unsigned j = 0; j < 16; ++j) { const unsigned c = xb_ld(&bar[XB_XCNT(j)]); sum += c; cnt += (c > 0u) ? 1u : 0u; mine = (j == x) ? c : mine; }
        if (sum == G) break;
        __builtin_amdgcn_s_sleep(1);
        if ((++sp & 255u) == 0u) { if (xb_ld(&bar[XB_TMO])) break; if (sp > XB_SPIN_CAP) { atomicAdd(&bar[XB_TMO], 1u); break; } }
    }
    nloc = mine > 0u ? mine : 1u; nx = cnt > 0u ? cnt : 1u;
}
__device__ __forceinline__ void xcd_barrier(const XcdBarrier& b) {
    asm volatile("s_waitcnt vmcnt(0)" ::: "memory");
    __syncthreads();
    if (threadIdx.x == 0) {
        unsigned* bar = b.bar;
        __builtin_amdgcn_s_waitcnt(0);
        unsigned nloc = b.st[0], nx = b.st[1];
        if (nloc == 0u) { xcd_barrier_complete(bar, b.x, nloc, nx); b.st[0] = nloc; b.st[1] = nx; }
        const unsigned old = xb_add(&bar[XB_XSUB(b.x)], 1u);
        const unsigned gen = old / nloc;
        if (old + 1u == (gen + 1u) * nloc) {
            __builtin_amdgcn_fence(__ATOMIC_RELEASE, "agent");
            asm volatile("s_waitcnt vmcnt(0)" ::: "memory");
            const unsigned og = xb_add(&bar[XB_TOP], 1u);
            const unsigned tg = og / nx;
            if (og + 1u == (tg + 1u) * nx) xb_add(&bar[XB_TOPGEN], 1u);
            else XB_SPIN(xb_ld(&bar[XB_TOPGEN]) == tg, bar);
            __builtin_amdgcn_fence(__ATOMIC_ACQUIRE, "agent");
            xb_add(&bar[XB_XGEN(b.x)], 1u);
            asm volatile("s_waitcnt vmcnt(0)" ::: "memory");
        } else {
            XB_SPIN(xb_ld(&bar[XB_XGEN(b.x)]) == gen, bar);
            __builtin_amdgcn_fence(__ATOMIC_ACQUIRE, "agent");
            asm volatile("s_waitcnt vmcnt(0)" ::: "memory");
        }
    }
    __syncthreads();
}
#endif

constexpr int NPHASE = 11;
#ifndef GEMM_SP2
#define GEMM_SP2 true
#endif
#ifndef GEMM_ALIGN
#define GEMM_ALIGN true
#endif
#ifndef ONLY_MASK
#define ONLY_MASK 0xFFFFFFFFull
#endif
#define EN(k) if constexpr ((((unsigned long long)(ONLY_MASK)) >> (k)) & 1ull)
#ifndef HIPEMU
typedef XcdBarrier BarT;
#define SYNC() do { if (p.use_bar) xcd_barrier(bar); } while (0)
#else
typedef int BarT;
#define SYNC() do { } while (0)
#endif
#define IN(k) (p.ph_lo <= (k) && (k) < p.ph_hi)
template <int l> DI void layer_body(const Params& p, ldsp lds, const BarT& bar) {
        unsigned char* const ws_ = WSP();
        const float* xin = (l == 0) ? INP(I_X) : OUTP();
        if (IN(0)) {
#ifndef HIPEMU
            EN(0) { if (l == 0) { phase_mod(lds); SYNC(); } }
            const bool alt_first = ((blockIdx.x >> 3) & 1) != 0;
            if (alt_first) { if constexpr (l == 0) { EN(2) phase_hy_filt(l, lds); } else { EN(7) phase_hy_fftf(lds); } }
            if constexpr (l == 0) { EN(1) phase_wconv(l, lds); }
            EN(3) phase_norm(lds, xin, l, 0);
            if (!alt_first) { if constexpr (l == 0) { EN(2) phase_hy_filt(l, lds); } else { EN(7) phase_hy_fftf(lds); } }
#else
            EN(2) phase_hy_filt(l, lds);
#endif
            SYNC();
        }
#ifndef HIPEMU
        if (IN(2)) {
            EN(4) phase_gates(lds, l);
            EN(5) { pg8::Gemm g{(const bf16_t*)(ws_ + wset_off(l) + WS_WTIN), (const bf16_t*)(ws_ + WS_H), NHY, SEQ, 4096}; pg8::StaticOrder S; S.init(NHY, SEQ, gridDim.x, blockIdx.x);
              pg8::EpiStoreBf16 E{(bf16_t*)(ws_ + WS_UT), SEQ}; pg8::gemm_phase<decltype(E), pg8::StaticOrder, GEMM_ALIGN, GEMM_SP2>(lds, g, S, E); }
            EN(6) { pg8::Gemm g{(const bf16_t*)(ws_ + WS_H), (const bf16_t*)(ws_ + wset_off(l) + WS_WTIN) + (size_t)NHY * 4096, SEQ, NPROJ, 4096}; pg8::StaticOrder S; S.init(SEQ, NPROJ, gridDim.x, blockIdx.x);
              pg8::EpiStoreBf16 E{(bf16_t*)(ws_ + WS_PROJ), NPROJ}; pg8::gemm_phase<decltype(E), pg8::StaticOrder, GEMM_ALIGN, GEMM_SP2>(lds, g, S, E); }
            SYNC();
        }
#endif
        if (IN(3)) {
#ifndef HIPEMU
            const bool wc_first = ((blockIdx.x >> 3) & 1) != 0;
            if (wc_first) { if constexpr (l < 3) { EN(1) phase_wconv(l + 1, lds); } }
#endif
            if constexpr (l == 0) { EN(7) phase_hy_fftf(lds); } EN(8) phase_ret_kv(l, lds); EN(9) phase_ml_kv(l, lds); EN(10) phase_att(l, lds);
#ifndef HIPEMU
            if (!wc_first) { if constexpr (l < 3) { EN(1) phase_wconv(l + 1, lds); } }
#endif
            SYNC(); }
        if (IN(4)) {
            const bool conv_first = ((blockIdx.x >> 3) & 1) != 0;
            if (conv_first) { EN(14) phase_hy_conv(l, lds); }
            EN(11) phase_ret_scan(lds, l); EN(12) phase_ml_scan(lds); EN(13) phase_att_merge(lds);
            if (!conv_first) { EN(14) phase_hy_conv(l, lds); }
            SYNC(); }
        if (IN(5)) { EN(15) phase_ret_out(l, lds); EN(16) phase_ml_out(l, lds); EN(17) phase_hy_out(lds); SYNC(); }
#ifndef HIPEMU
        if (IN(7)) EN(19) {
            pg8::Gemm g{(const bf16_t*)(ws_ + WS_Y), (const bf16_t*)(ws_ + wset_off(l) + WS_WTOUT), SEQ, 4096, 4096}; pg8::StaticOrder S; S.init(SEQ, 4096, gridDim.x, blockIdx.x);
            pg8::EpiResid E{xin, OUTP(), (const float*)(ws_ + WS_MOD) + l * 24576 + 8192, 4096}; pg8::gemm_phase<decltype(E), pg8::StaticOrder, GEMM_ALIGN, GEMM_SP2>(lds, g, S, E);
            SYNC();
        }
        if (IN(8)) {
            const bool alt_first = ((blockIdx.x >> 3) & 1) != 0;
            if (alt_first) { if constexpr (l < 3) { EN(2) phase_hy_filt(l + 1, lds); } }
            EN(20) phase_norm(lds, OUTP(), l, 1);
            if (!alt_first) { if constexpr (l < 3) { EN(2) phase_hy_filt(l + 1, lds); } }
            SYNC(); }
        if (IN(9)) EN(21) {
            pg8::Gemm g{(const bf16_t*)(ws_ + WS_H), (const bf16_t*)(ws_ + wset_off(l) + WS_WT13), SEQ, 2 * FFN, 4096}; pg8::StaticOrder S; S.init(SEQ, 2 * FFN, gridDim.x, blockIdx.x);
            pg8::EpiSwiGLU E{(bf16_t*)(ws_ + WS_ACT), FFN}; pg8::gemm_phase<decltype(E), pg8::StaticOrder, GEMM_ALIGN, GEMM_SP2>(lds, g, S, E);
            SYNC();
        }
        if (IN(10)) EN(22) {
            pg8::Gemm g{(const bf16_t*)(ws_ + WS_ACT), (const bf16_t*)(ws_ + wset_off(l) + WS_WT2), SEQ, 4096, FFN}; pg8::StaticOrder S; S.init(SEQ, 4096, gridDim.x, blockIdx.x);
            pg8::EpiResid E{OUTP(), OUTP(), (const float*)(ws_ + WS_MOD) + l * 24576 + 20480, 4096}; pg8::gemm_phase<decltype(E), pg8::StaticOrder, GEMM_ALIGN, GEMM_SP2>(lds, g, S, E);
            SYNC();
        }
#endif
}
__global__ void __launch_bounds__(512, 2) mega(Params p) {
#ifndef HIPEMU
    extern __shared__ __attribute__((aligned(16))) unsigned char lds_raw[];
    ldsp lds = (ldsp)lds_raw;
    XcdBarrier bar; bar.bar = (unsigned*)(p.ws + WS_BAR); bar.x = 0; bar.st = nullptr;
    if (p.use_bar) {
        if (threadIdx.x == 0) { *(volatile LAS unsigned*)(lds + LDS_BARW) = 0u; *(volatile LAS unsigned*)(lds + LDS_BARW + 4) = 0u; }
        __syncthreads();
        bar = xcd_barrier_post((unsigned*)(p.ws + WS_BAR), (volatile LAS unsigned*)(lds + LDS_BARW));
    }
#else
    ldsp lds = emu_lds(); BarT bar = 0;
#endif
    if (threadIdx.x == 0) {
        LAS unsigned long long* pt = (LAS unsigned long long*)(lds + LDS_PTRS);
        pt[0] = (unsigned long long)p.in[0]; pt[1] = (unsigned long long)p.in[1]; pt[2] = (unsigned long long)p.in[2]; pt[3] = (unsigned long long)p.in[3]; pt[4] = (unsigned long long)p.in[4];
        pt[5] = (unsigned long long)p.in[5]; pt[6] = (unsigned long long)p.in[6]; pt[7] = (unsigned long long)p.in[7]; pt[8] = (unsigned long long)p.in[8]; pt[9] = (unsigned long long)p.in[9];
        pt[10] = (unsigned long long)p.in[10]; pt[11] = (unsigned long long)p.in[11]; pt[12] = (unsigned long long)p.in[12]; pt[13] = (unsigned long long)p.in[13]; pt[14] = (unsigned long long)p.in[14];
        pt[15] = (unsigned long long)p.in[15]; pt[16] = (unsigned long long)p.in[16]; pt[17] = (unsigned long long)p.in[17]; pt[18] = (unsigned long long)p.in[18]; pt[19] = (unsigned long long)p.in[19];
        pt[20] = (unsigned long long)p.in[20]; pt[21] = (unsigned long long)p.out; pt[22] = (unsigned long long)p.ws;
    }
    __syncthreads();
    if (0 >= p.lay_lo && 0 < p.lay_hi) layer_body<0>(p, lds, bar);
    if (1 >= p.lay_lo && 1 < p.lay_hi) layer_body<1>(p, lds, bar);
    if (2 >= p.lay_lo && 2 < p.lay_hi) layer_body<2>(p, lds, bar);
    if (3 >= p.lay_lo && 3 < p.lay_hi) layer_body<3>(p, lds, bar);
}
#undef IN
#undef SYNC


#ifndef HIPEMU
#ifndef MK_ONE_LAUNCH
#define MK_ONE_LAUNCH 1
#endif
extern "C" void kernel_launch(void* const* d_in, const int* in_sizes, int n_in, void* d_out, int out_size, void* d_ws, size_t ws_size, hipStream_t stream) {
    static int grid = 0;
    if (grid == 0) {
        if (n_in != 21 || out_size != SEQ * DM || ws_size < WS_END) { fprintf(stderr, "kernel_launch: unexpected shapes (n_in %d out %d ws %zu need %zu)\n", n_in, out_size, ws_size, (size_t)WS_END); grid = -1; return; }
        int dev = 0, cus = 0, per_cu = 0;
        if (hipGetDevice(&dev) != hipSuccess || hipDeviceGetAttribute(&cus, hipDeviceAttributeMultiprocessorCount, dev) != hipSuccess) { grid = -1; return; }
        if (hipFuncSetAttribute((const void*)mega, hipFuncAttributeMaxDynamicSharedMemorySize, LDS_BYTES) != hipSuccess) { fprintf(stderr, "kernel_launch: hipFuncSetAttribute failed\n"); grid = -1; return; }
        if (hipOccupancyMaxActiveBlocksPerMultiprocessor(&per_cu, (const void*)mega, 512, LDS_BYTES) != hipSuccess || per_cu < 1) { fprintf(stderr, "kernel_launch: occupancy query says %d\n", per_cu); (void)hipGetLastError(); }
        grid = cus;
    }
    if (grid < 0) return;
    Params p; memset(&p, 0, sizeof(p));
    for (int i = 0; i < 21; ++i) p.in[i] = (const float*)d_in[i];
    p.out = (float*)d_out; p.ws = (unsigned char*)d_ws;
#if MK_ONE_LAUNCH
    (void)hipMemsetAsync((char*)d_ws + WS_BAR, 0, 16384, stream);
    p.ph_lo = 0; p.ph_hi = NPHASE; p.lay_lo = 0; p.lay_hi = 4; p.use_bar = 1;
    hipLaunchKernelGGL(mega, dim3(grid), dim3(512), LDS_BYTES, stream, p);
#else
    for (int l = 0; l < 4; ++l)
        for (int ph = 0; ph < NPHASE; ++ph) { p.ph_lo = ph; p.ph_hi = ph + 1; p.lay_lo = l; p.lay_hi = l + 1; p.use_bar = 0; hipLaunchKernelGGL(mega, dim3(grid), dim3(512), LDS_BYTES, stream, p); }
#endif
}
#endif
```

```cpp
#ifndef HIPEMU
#include <hip/hip_runtime.h>
#endif
#include <cstdio>
#include <cstdint>
#include <cstring>
#include <cmath>

#ifndef HIPEMU
#define LAS __attribute__((address_space(3)))
#define GAS __attribute__((address_space(1)))
#else
#define LAS
#define GAS
#endif
#define DI __device__ __forceinline__

typedef unsigned short bf16_t;
typedef short bf16x8 __attribute__((ext_vector_type(8)));
typedef short s16x4 __attribute__((ext_vector_type(4)));
typedef float f32x4 __attribute__((ext_vector_type(4)));
typedef float f32x2 __attribute__((ext_vector_type(2)));
typedef unsigned u32x4 __attribute__((ext_vector_type(4)));
typedef unsigned u32x2 __attribute__((ext_vector_type(2)));
typedef LAS unsigned char* ldsp;

#ifdef EMU_SEQ
constexpr int SEQ = EMU_SEQ;
#else
constexpr int SEQ = 16384;
#endif
constexpr int DM = 4096, NPROJ = 9216, NHY = 3072, FFN = 11008, DIN = 12304;
constexpr int NCR = SEQ / 128;
constexpr int NCM = SEQ / 64;
constexpr int KFP = SEQ + 8;
constexpr int LOG4 = (SEQ == 16384) ? 7 : (SEQ == 4096) ? 6 : (SEQ == 1024) ? 5 : (SEQ == 256) ? 4 : -1;
static_assert(LOG4 > 0, "SEQ must be a power of 4");
constexpr float EPS = 1e-6f;
constexpr int PC_RQ = 0, PC_RK = 512, PC_RV = 1024, PC_RG = 2048, PC_AQ = 3072, PC_AK = 4096, PC_AV = 5120, PC_MQ = 6144, PC_MK = 6656, PC_MV = 7168, PC_MO = 8192;
enum { I_X = 0, I_C, I_ADAW, I_ADAB, I_ADAT, I_WIN, I_WOUT, I_HYS, I_HYW1, I_HYB1, I_HYW2, I_HYB2, I_HYW3, I_HYBIAS, I_RDEC, I_AGAIN, I_MGB, I_MNG, I_W1, I_W3, I_W2 };

constexpr size_t al256(size_t x) { return (x + 255) & ~(size_t)255; }
constexpr size_t WS_BAR = 0;
constexpr size_t WS_MOD = 16384;
constexpr size_t WS_G = WS_MOD + al256((size_t)4 * 24576 * 4);
constexpr size_t WS_WTG = WS_G + al256((size_t)SEQ * 16 * 4);
constexpr size_t WS_WTIN = WS_WTG + al256((size_t)16 * 4096 * 2);
constexpr size_t WS_WTOUT = WS_WTIN + al256((size_t)12288 * 4096 * 2);
constexpr size_t WS_WT13 = WS_WTOUT + al256((size_t)4096 * 4096 * 2);
constexpr size_t WS_WT2 = WS_WT13 + al256((size_t)22016 * 4096 * 2);
constexpr size_t WS_H = WS_WT2 + al256((size_t)4096 * 11008 * 2);
constexpr size_t WS_PROJ = WS_H + al256((size_t)SEQ * 4096 * 2);
constexpr size_t WS_UT = WS_PROJ + al256((size_t)SEQ * NPROJ * 2);
constexpr size_t WS_Y = WS_UT + al256((size_t)NHY * SEQ * 2);
constexpr size_t WS_ACT = WS_Y + al256((size_t)SEQ * 4096 * 2);
constexpr size_t WS_FILT = WS_ACT + al256((size_t)SEQ * FFN * 2);
constexpr size_t WS_KF = WS_FILT + al256((size_t)4096 * SEQ * 4);
constexpr size_t WS_Z1T = WS_KF + al256((size_t)2048 * KFP * 8);
constexpr size_t WS_Z2T = WS_Z1T + al256((size_t)1024 * SEQ * 4);
constexpr size_t WS_RKV = WS_Z2T + al256((size_t)1024 * SEQ * 4);
constexpr size_t WS_RST = WS_RKV + al256((size_t)8 * NCR * 32768 * 4);
constexpr size_t WS_OB = WS_RST + al256((size_t)8 * NCR * 32768 * 2);
constexpr size_t WS_LSE = WS_OB + al256((size_t)3 * SEQ * 1024 * 2);
constexpr size_t WS_MKV = WS_LSE + al256((size_t)3 * SEQ * 8 * 4);
constexpr size_t WS_MCT = WS_MKV + al256((size_t)8 * NCM * 32768 * 4);
constexpr size_t WS_KSUM = WS_MCT + al256((size_t)8 * NCM * 32768 * 2);
constexpr size_t WS_NPREV = WS_KSUM + al256((size_t)8 * NCM * 128 * 4);
constexpr size_t WS_MLOC = WS_NPREV + al256((size_t)8 * NCM * 128 * 4);
constexpr size_t WS_BLAST = WS_MLOC + al256((size_t)8 * NCM * 4);
constexpr size_t WS_MPREV = WS_BLAST + al256((size_t)8 * NCM * 4);
constexpr size_t WS_HDIR = WS_MPREV + al256((size_t)8 * NCM * 4);
constexpr size_t WS_RY = WS_HDIR + al256((size_t)2 * SEQ * 1024 * 4);
constexpr size_t WS_WSET2 = WS_RY + al256((size_t)SEQ * 1024 * 4);
constexpr size_t WS_WSET_BYTES = WS_H - WS_WTG;
constexpr size_t WS_END = WS_WSET2 + WS_WSET_BYTES;
constexpr size_t wset_off(int l) { return (l & 1) ? (WS_WSET2 - WS_WTG) : 0; }

constexpr int LDS_BYTES = 147456;
constexpr int LDS_BARW = LDS_BYTES - 16;
constexpr int LDS_PTRS = LDS_BARW - 256;

struct Params { const float* in[21]; float* out; unsigned char* ws; int ph_lo, ph_hi, lay_lo, lay_hi, use_bar, pad; };

DI bf16_t f2bf(float f) { unsigned u = __builtin_bit_cast(unsigned, f); u += 0x7FFFu + ((u >> 16) & 1u); return (bf16_t)(u >> 16); }
DI float bf2f(unsigned short b) { return __builtin_bit_cast(float, ((unsigned)b) << 16); }
DI unsigned pk2(float lo, float hi) {
#ifdef HIPEMU
    return (unsigned)f2bf(lo) | ((unsigned)f2bf(hi) << 16);
#else
    unsigned r; asm volatile("v_cvt_pk_bf16_f32 %0, %1, %2" : "=v"(r) : "v"(lo), "v"(hi)); return r;
#endif
}
DI f32x4 mfma16(bf16x8 a, bf16x8 b, f32x4 c) {
#ifdef HIPEMU
    return emu_mfma16(a, b, c);
#else
    return __builtin_amdgcn_mfma_f32_16x16x32_bf16(a, b, c, 0, 0, 0);
#endif
}
DI bf16x8 tr_read8(ldsp lds, unsigned off_a, unsigned off_b) {
#ifdef HIPEMU
    s16x4 lo = emu_tr_read(lds, off_a), hi = emu_tr_read(lds, off_b);
#else
    s16x4 lo, hi; const unsigned base = (unsigned)(uintptr_t)lds;
    asm volatile("ds_read_b64_tr_b16 %0, %2\n\tds_read_b64_tr_b16 %1, %3\n\ts_waitcnt lgkmcnt(0)" : "=&v"(lo), "=&v"(hi) : "v"(base + off_a), "v"(base + off_b) : "memory");
#endif
    return __builtin_shufflevector(lo, hi, 0, 1, 2, 3, 4, 5, 6, 7);
}
DI bf16x8 tr_frag(ldsp lds, unsigned tile_off, int pitch, int r0a, int r0b, int c0, int lr) {
    const int q = lr >> 2, pp = lr & 3;
    return tr_read8(lds, tile_off + (unsigned)((r0a + q) * pitch + (c0 + 4 * pp) * 2), tile_off + (unsigned)((r0b + q) * pitch + (c0 + 4 * pp) * 2));
}
struct TrF { s16x4 lo, hi; };
DI void tr_issue(ldsp lds, unsigned tile_off, int pitch, int r0a, int r0b, int c0, int lr, TrF& f) {
    const int q = lr >> 2, pp = lr & 3;
    const unsigned off_a = tile_off + (unsigned)((r0a + q) * pitch + (c0 + 4 * pp) * 2), off_b = tile_off + (unsigned)((r0b + q) * pitch + (c0 + 4 * pp) * 2);
#ifdef HIPEMU
    f.lo = emu_tr_read(lds, off_a); f.hi = emu_tr_read(lds, off_b);
#else
    const unsigned base = (unsigned)(uintptr_t)lds;
    asm volatile("ds_read_b64_tr_b16 %0, %2\n\tds_read_b64_tr_b16 %1, %3" : "=&v"(f.lo), "=&v"(f.hi) : "v"(base + off_a), "v"(base + off_b) : "memory");
#endif
}
DI void tr_wait2(TrF& a, TrF& b) {
#ifndef HIPEMU
    asm volatile("s_waitcnt lgkmcnt(0)" : "+v"(a.lo), "+v"(a.hi), "+v"(b.lo), "+v"(b.hi) :: "memory");
#endif
}
DI void tr_wait1(TrF& a) {
#ifndef HIPEMU
    asm volatile("s_waitcnt lgkmcnt(0)" : "+v"(a.lo), "+v"(a.hi) :: "memory");
#endif
}
DI bf16x8 tr_val(const TrF& f) { return __builtin_shufflevector(f.lo, f.hi, 0, 1, 2, 3, 4, 5, 6, 7); }
DI bf16x8 lds_row8(ldsp lds, unsigned off) { return *(const LAS bf16x8*)(lds + off); }
DI bf16x8 pack8(const f32x4& a, const f32x4& b) { u32x4 w; w.x = pk2(a[0], a[1]); w.y = pk2(a[2], a[3]); w.z = pk2(b[0], b[1]); w.w = pk2(b[2], b[3]); return __builtin_bit_cast(bf16x8, w); }
DI float wave_sum(float v) {
#pragma unroll
    for (int m = 32; m >= 1; m >>= 1) v += __shfl_xor(v, m);
    return v;
}
DI float wave_max(float v) {
#pragma unroll
    for (int m = 32; m >= 1; m >>= 1) v = fmaxf(v, __shfl_xor(v, m));
    return v;
}
DI float ld_xcu(const float* p) {
#ifdef HIPEMU
    return *p;
#else
    return __builtin_bit_cast(float, __hip_atomic_load((const unsigned*)p, __ATOMIC_RELAXED, __HIP_MEMORY_SCOPE_AGENT));
#endif
}
DI f32x2 ld_xcu2(const f32x2* p) {
#ifdef HIPEMU
    return *p;
#else
    return __builtin_bit_cast(f32x2, __hip_atomic_load((const unsigned long long*)p, __ATOMIC_RELAXED, __HIP_MEMORY_SCOPE_AGENT));
#endif
}
DI float fexp(float x) {
#ifdef HIPEMU
    return expf(x);
#else
    return __builtin_amdgcn_exp2f(x * 1.4426950408889634f);
#endif
}
DI float frcp(float x) {
#ifdef HIPEMU
    return 1.f / x;
#else
    return __builtin_amdgcn_rcpf(x);
#endif
}
DI float logsig(float x) { return x < 0.f ? x - log1pf(expf(x)) : -log1pf(expf(-x)); }
DI float sigm(float x) { return frcp(1.f + fexp(-x)); }
DI float dot4(const f32x4& a, const f32x4& b) { return a[0] * b[0] + a[1] * b[1] + a[2] * b[2] + a[3] * b[3]; }
DI f32x2 cmul(f32x2 a, f32x2 b) { f32x2 r; r.x = a.x * b.x - a.y * b.y; r.y = a.x * b.y + a.y * b.x; return r; }
DI f32x2 cmulc(f32x2 a, f32x2 b) { f32x2 r; r.x = a.x * b.x + a.y * b.y; r.y = a.y * b.x - a.x * b.y; return r; }
DI f32x2 cconj(f32x2 a) { f32x2 r; r.x = a.x; r.y = -a.y; return r; }
DI unsigned rev4(unsigned k) { const unsigned x = __builtin_bitreverse32(k) >> (32 - 2 * LOG4); return ((x & 0x55555555u) << 1) | ((x >> 1) & 0x55555555u); }

DI int opaque_tid() { int t = (int)threadIdx.x;
#ifndef HIPEMU
    asm volatile("" : "+v"(t));
#endif
    return t; }
#define TID (opaque_tid())
#ifdef HIPEMU
#define WAVE_SYNC() emu_wave_sync()
#else
#define WAVE_SYNC() __builtin_amdgcn_wave_barrier()
#endif
DI unsigned long long lds_ptr_bits(ldsp lds, int i) {
    const LAS unsigned* q = (const LAS unsigned*)(lds + LDS_PTRS + 8 * i); unsigned lo = q[0], hi = q[1];
#ifndef HIPEMU
    lo = __builtin_amdgcn_readfirstlane(lo); hi = __builtin_amdgcn_readfirstlane(hi);
#endif
    return ((unsigned long long)hi << 32) | lo;
}
#define INP(i) ((const float*)(GAS const float*)lds_ptr_bits(lds, (i)))
#define OUTP() ((float*)(GAS float*)lds_ptr_bits(lds, 21))
#define WSP() ((unsigned char*)(GAS unsigned char*)lds_ptr_bits(lds, 22))
DI unsigned char* opaque_ws(unsigned char* w) {
#ifndef HIPEMU
    asm volatile("" : "+s"(w));
#endif
    return w; }
#ifndef HIPEMU
#define MEMFENCE() asm volatile("" ::: "memory")
#else
#define MEMFENCE() do { } while (0)
#endif

DI void phase_mod(ldsp lds) {
    unsigned char* const ws_ = WSP();
    const float* c = INP(I_C); const float* ada_w = INP(I_ADAW); const float* ada_b = INP(I_ADAB); const float* ada_t = INP(I_ADAT);
    float* mod = (float*)(ws_ + WS_MOD);
    LAS float* sc = (LAS float*)lds; LAS float* red = sc + 4096;
    const int tid = TID;
    for (int i = tid; i < 4096; i += 512) { const float v = c[i]; sc[i] = v / (1.f + expf(-v)); }
    __syncthreads();
    for (int cb = blockIdx.x; cb < 256; cb += gridDim.x) {
        const int cv = tid % 24, ks = tid / 24;
        if (ks < 21) {
            f32x4 acc = {0.f, 0.f, 0.f, 0.f};
            for (int k = ks; k < 4096; k += 21) { const f32x4 w = *(const f32x4*)(ada_w + (size_t)k * 24576 + cb * 96 + 4 * cv); acc += w * sc[k]; }
#pragma unroll
            for (int j = 0; j < 4; ++j) red[ks * 96 + 4 * cv + j] = acc[j];
        }
        __syncthreads();
        if (tid < 96) {
            float s = 0.f;
            for (int k = 0; k < 21; ++k) s += red[k * 96 + tid];
            const int j = cb * 96 + tid; s += ada_b[j];
            for (int l = 0; l < 4; ++l) mod[l * 24576 + j] = s + ada_t[l * 24576 + j];
        }
        __syncthreads();
    }
}

template <class RowMap>
DI void wconv_tile(const float* src, int ldn, int K, int kt, int nt4, bf16_t* dst, RowMap rm, ldsp lds, int tid) {
    LAS float* T = (LAS float*)lds;
    const int k0 = kt * 64, n0 = nt4 * 256;
    f32x4 v[8];
#pragma unroll
    for (int i = 0; i < 8; ++i) { const int idx = tid + 512 * i, k = idx >> 6, n4 = idx & 63; v[i] = __builtin_nontemporal_load((const f32x4*)(src + (size_t)(k0 + k) * ldn + n0 + 4 * n4)); }
#pragma unroll
    for (int i = 0; i < 8; ++i) { const int idx = tid + 512 * i, k = idx >> 6, n4 = idx & 63;
#pragma unroll
        for (int j = 0; j < 4; ++j) T[(4 * n4 + j) * 65 + k] = v[i][j]; }
    __syncthreads();
#pragma unroll
    for (int i = 0; i < 4; ++i) {
        const int ch = tid + 512 * i, n = ch >> 3, kc = ch & 7; u32x4 o;
        o.x = pk2(T[n * 65 + 8 * kc + 0], T[n * 65 + 8 * kc + 1]); o.y = pk2(T[n * 65 + 8 * kc + 2], T[n * 65 + 8 * kc + 3]);
        o.z = pk2(T[n * 65 + 8 * kc + 4], T[n * 65 + 8 * kc + 5]); o.w = pk2(T[n * 65 + 8 * kc + 6], T[n * 65 + 8 * kc + 7]);
        *(u32x4*)(dst + (size_t)rm(n0 + n) * K + k0 + 8 * kc) = o;
    }
    __syncthreads();
}
DI void phase_wconv(int l, ldsp lds) {
    unsigned char* const ws_ = WSP();
    const float* w_in = INP(I_WIN) + (size_t)l * 4096 * DIN; const float* w_out = INP(I_WOUT) + (size_t)l * 4096 * 4096;
    const float* w1 = INP(I_W1) + (size_t)l * 4096 * FFN; const float* w3 = INP(I_W3) + (size_t)l * 4096 * FFN; const float* w2 = INP(I_W2) + (size_t)l * FFN * 4096;
    unsigned char* const wb_ = ws_ + wset_off(l);
    bf16_t* wt_in = (bf16_t*)(wb_ + WS_WTIN); bf16_t* wt_out = (bf16_t*)(wb_ + WS_WTOUT); bf16_t* wt13 = (bf16_t*)(wb_ + WS_WT13); bf16_t* wt2 = (bf16_t*)(wb_ + WS_WT2);
    bf16_t* wtg = (bf16_t*)(wb_ + WS_WTG);
    const int tid = TID;
    constexpr int T_IN = 64 * 48, T_OUT = 64 * 16, T_1 = 64 * 43, T_2 = 172 * 16, T_ALL = T_IN + T_OUT + 2 * T_1 + T_2;
    for (int t = blockIdx.x; t < T_ALL; t += gridDim.x) {
        if (t < T_IN) wconv_tile(w_in, DIN, 4096, t / 48, t % 48, wt_in, [](int n) { return n; }, lds, tid);
        else if (t < T_IN + T_OUT) { const int q = t - T_IN; wconv_tile(w_out, 4096, 4096, q / 16, q % 16, wt_out, [](int n) { return n; }, lds, tid); }
        else if (t < T_IN + T_OUT + T_1) { const int q = t - T_IN - T_OUT; wconv_tile(w1, FFN, 4096, q / 43, q % 43, wt13, [](int n) { return (n >> 7) * 256 + (n & 127); }, lds, tid); }
        else if (t < T_IN + T_OUT + 2 * T_1) { const int q = t - T_IN - T_OUT - T_1; wconv_tile(w3, FFN, 4096, q / 43, q % 43, wt13, [](int n) { return (n >> 7) * 256 + 128 + (n & 127); }, lds, tid); }
        else { const int q = t - T_IN - T_OUT - 2 * T_1; wconv_tile(w2, 4096, FFN, q / 16, q % 16, wt2, [](int n) { return n; }, lds, tid); }
    }
    for (int idx = blockIdx.x * 512 + tid; idx < 65536; idx += gridDim.x * 512) { const int k = idx >> 4, n = idx & 15; wtg[n * 4096 + k] = f2bf(w_in[(size_t)k * DIN + 12288 + n]); }
}

DI void phase_norm(ldsp lds, const float* xin, int l, int which) {
    unsigned char* const ws_ = WSP();
    const float* mod = (const float*)(ws_ + WS_MOD) + l * 24576; const float* sh = mod + which * 12288; const float* scv = mod + 4096 + which * 12288;
    bf16_t* H = (bf16_t*)(ws_ + WS_H);
    const int tid_ = TID; const int lane = tid_ & 63, wave = tid_ >> 6;
    for (int row = (blockIdx.x * 8 + wave) * 2; row < SEQ; row += gridDim.x * 16) {
        const float* xr = xin + (size_t)row * 4096; f32x4 v[2][16]; float ss0 = 0.f, ss1 = 0.f;
#pragma unroll
        for (int i = 0; i < 16; ++i) { v[0][i] = *(const f32x4*)(xr + 4 * (lane + 64 * i)); v[1][i] = *(const f32x4*)(xr + 4096 + 4 * (lane + 64 * i)); }
#pragma unroll
        for (int i = 0; i < 16; ++i) { ss0 += dot4(v[0][i], v[0][i]); ss1 += dot4(v[1][i], v[1][i]); }
        ss0 = wave_sum(ss0); ss1 = wave_sum(ss1);
        const float r0 = rsqrtf(ss0 * (1.f / 4096.f) + EPS), r1 = rsqrtf(ss1 * (1.f / 4096.f) + EPS);
#pragma unroll
        for (int i = 0; i < 16; ++i) {
            const int cc = 4 * (lane + 64 * i); const f32x4 s1 = *(const f32x4*)(scv + cc) + 1.f, s0 = *(const f32x4*)(sh + cc);
            const f32x4 o0 = v[0][i] * r0 * s1 + s0, o1 = v[1][i] * r1 * s1 + s0; u32x2 w0, w1; w0.x = pk2(o0[0], o0[1]); w0.y = pk2(o0[2], o0[3]); w1.x = pk2(o1[0], o1[1]); w1.y = pk2(o1[2], o1[3]);
            *(u32x2*)(H + (size_t)row * 4096 + cc) = w0; *(u32x2*)(H + (size_t)(row + 1) * 4096 + cc) = w1;
            if ((i & 3) == 3) MEMFENCE();
        }
    }
}

DI void phase_gates(ldsp lds, int l) {
    unsigned char* const ws_ = WSP();
    const bf16_t* H = (const bf16_t*)(ws_ + WS_H); const bf16_t* WG = (const bf16_t*)(ws_ + wset_off(l) + WS_WTG); float* G = (float*)(ws_ + WS_G);
    LAS float* red = (LAS float*)lds;
    const int tid = TID, lane = tid & 63, wave = tid >> 6, lr = lane & 15, lg = lane >> 4;
    for (int tile = blockIdx.x; tile < SEQ / 16; tile += gridDim.x) {
        f32x4 acc = {0.f, 0.f, 0.f, 0.f};
        const bf16_t* arow = H + (size_t)(tile * 16 + lr) * 4096 + wave * 512 + 8 * lg; const bf16_t* brow = WG + (size_t)lr * 4096 + wave * 512 + 8 * lg;
#pragma unroll 4
        for (int ks = 0; ks < 16; ++ks) { const bf16x8 a = *(const bf16x8*)(arow + 32 * ks); const bf16x8 b = *(const bf16x8*)(brow + 32 * ks); acc = mfma16(a, b, acc); }
#pragma unroll
        for (int r = 0; r < 4; ++r) red[wave * 256 + (4 * lg + r) * 16 + lr] = acc[r];
        __syncthreads();
        if (tid < 256) { float s = 0.f; for (int w = 0; w < 8; ++w) s += red[w * 256 + tid]; G[(size_t)tile * 256 + tid] = s; }
        __syncthreads();
    }
}

DI void phase_hy_filt(int l, ldsp lds) {
    unsigned char* const ws_ = WSP();
    const float* w1 = INP(I_HYW1) + l * 33 * 64; const float* b1 = INP(I_HYB1) + l * 64; const float* w2 = INP(I_HYW2) + l * 2 * 4096; const float* b2 = INP(I_HYB2) + l * 128;
    const float* w3 = INP(I_HYW3) + (size_t)l * 64 * 4096; float* FILT = (float*)(ws_ + WS_FILT);
    LAS float* z = (LAS float*)lds; LAS float* ha = z + 64 * 36; LAS float* hb = ha + 4096;
    const int tid = TID;
    const float min_decay = -4.605170185988091f / 1.5f, max_decay = -4.605170185988091f / 0.3f;
    for (int tt = blockIdx.x; tt < SEQ / 64; tt += gridDim.x) {
        const int tau0 = tt * 64;
        for (int idx = tid; idx < 64 * 33; idx += 512) {
            const int r = idx / 33, f = idx % 33, tau = tau0 + r; float val;
            if (f == 0) val = (float)tau / (float)(SEQ - 1);
            else { const int b = (f - 1) & 15; const float fr = 1e-4f + (float)b * ((15.f - 1e-4f) / 15.f); const float a = ((6.283185307179586f / (float)SEQ) * (float)tau) * fr; val = (f <= 16) ? cosf(a) : -sinf(a); }
            z[r * 36 + f] = val;
        }
        __syncthreads();
        for (int idx = tid; idx < 4096; idx += 512) { const int r = idx >> 6, o = idx & 63; float s = b1[o]; for (int f = 0; f < 33; ++f) s += z[r * 36 + f] * w1[f * 64 + o]; ha[r * 64 + o] = sinf(s); }
        __syncthreads();
        for (int idx = tid; idx < 4096; idx += 512) { const int r = idx >> 6, o = idx & 63; float s = b2[o]; for (int i = 0; i < 64; ++i) s += ha[r * 64 + i] * w2[i * 64 + o]; hb[r * 64 + o] = sinf(s); }
        __syncthreads();
        for (int idx = tid; idx < 4096; idx += 512) { const int r = idx >> 6, o = idx & 63; float s = b2[64 + o]; for (int i = 0; i < 64; ++i) s += hb[r * 64 + i] * w2[4096 + i * 64 + o]; ha[r * 64 + o] = sinf(s); }
        __syncthreads();
        {
            const int lane = tid & 63, wave = tid >> 6, lr = lane & 15, lg = lane >> 4;
            bf16x8 ahi[4][2], alo[4][2];
#pragma unroll
            for (int tt = 0; tt < 4; ++tt)
#pragma unroll
                for (int ks = 0; ks < 2; ++ks) {
                    const f32x4 x0 = *(const LAS f32x4*)(ha + (16 * tt + lr) * 64 + 32 * ks + 8 * lg), x1 = *(const LAS f32x4*)(ha + (16 * tt + lr) * 64 + 32 * ks + 8 * lg + 4);
                    f32x4 h0, h1, l0, l1;
#pragma unroll
                    for (int e = 0; e < 4; ++e) { h0[e] = bf2f(f2bf(x0[e])); h1[e] = bf2f(f2bf(x1[e])); l0[e] = x0[e] - h0[e]; l1[e] = x1[e] - h1[e]; }
                    ahi[tt][ks] = pack8(h0, h1); alo[tt][ks] = pack8(l0, l1);
                }
            f32x4 wn[2][2];
#pragma unroll
            for (int ks = 0; ks < 2; ++ks)
#pragma unroll
                for (int e = 0; e < 4; ++e) { wn[ks][0][e] = w3[(size_t)(32 * ks + 8 * lg + e) * 4096 + 16 * wave + lr]; wn[ks][1][e] = w3[(size_t)(32 * ks + 8 * lg + 4 + e) * 4096 + 16 * wave + lr]; }
#pragma unroll 1
            for (int ct = wave; ct < 256; ct += 8) {
                const int j = 16 * ct + lr, c = j & 1023;
                bf16x8 bhi[2], blo[2];
#pragma unroll
                for (int ks = 0; ks < 2; ++ks) {
                    const f32x4 x0 = wn[ks][0], x1 = wn[ks][1]; f32x4 h0, h1, l0, l1;
#pragma unroll
                    for (int e = 0; e < 4; ++e) { h0[e] = bf2f(f2bf(x0[e])); h1[e] = bf2f(f2bf(x1[e])); l0[e] = x0[e] - h0[e]; l1[e] = x1[e] - h1[e]; }
                    bhi[ks] = pack8(h0, h1); blo[ks] = pack8(l0, l1);
                }
                { const int jn = 16 * ((ct + 8 < 256) ? ct + 8 : ct) + lr;
#pragma unroll
                  for (int ks = 0; ks < 2; ++ks)
#pragma unroll
                      for (int e = 0; e < 4; ++e) { wn[ks][0][e] = w3[(size_t)(32 * ks + 8 * lg + e) * 4096 + jn]; wn[ks][1][e] = w3[(size_t)(32 * ks + 8 * lg + 4 + e) * 4096 + jn]; } }
                const float delta = fabsf(min_decay + (float)c * ((max_decay - min_decay) / 1023.f));
                LAS float* tw_ = hb + 4096 + wave * 1088;
#pragma unroll
                for (int tt = 0; tt < 4; ++tt) {
                    f32x4 acc = {0.f, 0.f, 0.f, 0.f};
#pragma unroll
                    for (int ks = 0; ks < 2; ++ks) { acc = mfma16(ahi[tt][ks], bhi[ks], acc); acc = mfma16(ahi[tt][ks], blo[ks], acc); acc = mfma16(alo[tt][ks], bhi[ks], acc); }
                    f32x4 o;
#pragma unroll
                    for (int r = 0; r < 4; ++r) { const float t = (float)(tau0 + 16 * tt + 4 * lg + r) / (float)(SEQ - 1); o[r] = acc[r] * fexp(-t * delta); }
                    *(LAS f32x4*)(tw_ + lr * 68 + 16 * tt + 4 * lg) = o;
                }
                WAVE_SYNC();
#pragma unroll
                for (int jj = 0; jj < 4; ++jj) {
                    const int col = 4 * jj + (lane >> 4), q4 = lane & 15;
                    const f32x4 o = *(const LAS f32x4*)(tw_ + col * 68 + 4 * q4);
                    *(f32x4*)(FILT + (size_t)(16 * ct + col) * SEQ + tau0 + 4 * q4) = o;
                }
                WAVE_SYNC();
            }
        }
        __syncthreads();
    }
}

constexpr int FFT_PADN = SEQ + (SEQ >> 6) * 4;
constexpr int FFT_X = 0, FFT_T1 = FFT_PADN * 8, FFT_T2 = FFT_T1 + 1024, FFT_SCR = FFT_T2 + 1024;
static_assert(FFT_SCR + 256 <= LDS_PTRS, "fft lds");
DI int fpad(int i) { return i + ((i >> 6) << 2); }
DI void fft_tables(ldsp lds) {
    LAS f32x2* T1 = (LAS f32x2*)(lds + FFT_T1); LAS f32x2* T2 = (LAS f32x2*)(lds + FFT_T2);
    const int tid = TID;
    if (tid < 128) { const double a = -6.283185307179586476925 * (double)((tid * 128) % SEQ) / (double)SEQ; f32x2 v; v.x = (float)cos(a); v.y = (float)sin(a); T1[tid] = v; }
    else if (tid < 256) { const double a = -6.283185307179586476925 * (double)(tid - 128) / (double)SEQ; f32x2 v; v.x = (float)cos(a); v.y = (float)sin(a); T2[tid - 128] = v; }
    __syncthreads();
}
DI f32x2 fft_tw(ldsp lds, int ti) { const LAS f32x2* T1 = (const LAS f32x2*)(lds + FFT_T1); const LAS f32x2* T2 = (const LAS f32x2*)(lds + FFT_T2); return cmul(T1[ti >> 7], T2[ti & 127]); }
DI void r4_fwd(f32x2& x0, f32x2& x1, f32x2& x2, f32x2& x3) {
    const f32x2 t0 = x0 + x2, t1 = x0 - x2, t2 = x1 + x3, d = x1 - x3; f32x2 t3; t3.x = d.y; t3.y = -d.x;
    x0 = t0 + t2; x1 = t1 + t3; x2 = t0 - t2; x3 = t1 - t3;
}
DI void r4_inv(f32x2& x0, f32x2& x1, f32x2& x2, f32x2& x3) {
    const f32x2 t0 = x0 + x2, t1 = x0 - x2, t2 = x1 + x3, d = x1 - x3; f32x2 t3; t3.x = -d.y; t3.y = d.x;
    x0 = t0 + t2; x1 = t1 + t3; x2 = t0 - t2; x3 = t1 - t3;
}
DI f32x2 w16c(int a) { f32x2 r; r.x = (a == 0) ? 1.f : (a == 1) ? 0.92387953251128674f : (a == 2) ? 0.70710678118654752f : 0.38268343236508977f;
    r.y = (a == 0) ? 0.f : (a == 1) ? -0.38268343236508977f : (a == 2) ? -0.70710678118654752f : -0.92387953251128674f; return r; }
template <int M, bool INV> DI void fft_r16(ldsp lds, int tid) {
    LAS f32x2* X = (LAS f32x2*)(lds + FFT_X);
    constexpr int Q4 = M / 16, QQ = M / 4;
    for (int u = tid; u < SEQ / 16; u += 512) {
        const int jp = u & (Q4 - 1), b = (u / Q4) * M + jp;
        constexpr int PA = (Q4 >= 64) ? (Q4 / 64) * 68 : Q4, PC = (QQ >= 64) ? (QQ / 64) * 68 : QQ;
        constexpr bool LIN = (M >= 1024 || M <= 64);
        LAS f32x2* Xb = X + fpad(b);
        f32x2 e[4][4];
#pragma unroll
        for (int c = 0; c < 4; ++c)
#pragma unroll
            for (int a = 0; a < 4; ++a) e[c][a] = LIN ? Xb[a * PA + c * PC] : X[fpad(b + a * Q4 + c * QQ)];
        const f32x2 w0 = fft_tw(lds, jp * (SEQ / M)); const f32x2 wb = fft_tw(lds, jp * (4 * (SEQ / M)));
        const f32x2 wb2 = cmul(wb, wb), wb3 = cmul(wb2, wb);
        if (!INV) {
#pragma unroll
            for (int a = 0; a < 4; ++a) {
                r4_fwd(e[0][a], e[1][a], e[2][a], e[3][a]);
                const f32x2 wa = cmul(w0, w16c(a)), wa2 = cmul(wa, wa), wa3 = cmul(wa2, wa);
                e[1][a] = cmul(e[1][a], wa); e[2][a] = cmul(e[2][a], wa2); e[3][a] = cmul(e[3][a], wa3);
            }
#pragma unroll
            for (int c = 0; c < 4; ++c) { r4_fwd(e[c][0], e[c][1], e[c][2], e[c][3]); e[c][1] = cmul(e[c][1], wb); e[c][2] = cmul(e[c][2], wb2); e[c][3] = cmul(e[c][3], wb3); }
        } else {
#pragma unroll
            for (int c = 0; c < 4; ++c) { e[c][1] = cmulc(e[c][1], wb); e[c][2] = cmulc(e[c][2], wb2); e[c][3] = cmulc(e[c][3], wb3); r4_inv(e[c][0], e[c][1], e[c][2], e[c][3]); }
#pragma unroll
            for (int a = 0; a < 4; ++a) {
                const f32x2 wa = cmul(w0, w16c(a)), wa2 = cmul(wa, wa), wa3 = cmul(wa2, wa);
                e[1][a] = cmulc(e[1][a], wa); e[2][a] = cmulc(e[2][a], wa2); e[3][a] = cmulc(e[3][a], wa3);
                r4_inv(e[0][a], e[1][a], e[2][a], e[3][a]);
            }
        }
#pragma unroll
        for (int c = 0; c < 4; ++c)
#pragma unroll
            for (int a = 0; a < 4; ++a) { if (LIN) Xb[a * PA + c * PC] = e[c][a]; else X[fpad(b + a * Q4 + c * QQ)] = e[c][a]; }
    }
    __syncthreads();
}
template <bool INV> DI void fft_r4_last(ldsp lds, int tid) {
    LAS f32x2* X = (LAS f32x2*)(lds + FFT_X);
    for (int u = tid; u < SEQ / 4; u += 512) {
        LAS f32x4* q = (LAS f32x4*)(X + fpad(4 * u)); const f32x4 lo = q[0], hi = q[1];
        f32x2 x0, x1, x2, x3; x0.x = lo[0]; x0.y = lo[1]; x1.x = lo[2]; x1.y = lo[3]; x2.x = hi[0]; x2.y = hi[1]; x3.x = hi[2]; x3.y = hi[3];
        if (!INV) r4_fwd(x0, x1, x2, x3); else r4_inv(x0, x1, x2, x3);
        f32x4 o0, o1; o0[0] = x0.x; o0[1] = x0.y; o0[2] = x1.x; o0[3] = x1.y; o1[0] = x2.x; o1[1] = x2.y; o1[2] = x3.x; o1[3] = x3.y; q[0] = o0; q[1] = o1;
    }
    __syncthreads();
}
DI void fft_dif(ldsp lds, int tid) {
    if constexpr (LOG4 >= 2) fft_r16<SEQ, false>(lds, tid);
    if constexpr (LOG4 >= 4) fft_r16<SEQ / 16, false>(lds, tid);
    if constexpr (LOG4 >= 6) fft_r16<SEQ / 256, false>(lds, tid);
    if constexpr (LOG4 & 1) fft_r4_last<false>(lds, tid);
}
DI void fft_dit_inv(ldsp lds, int tid) {
    if constexpr (LOG4 & 1) fft_r4_last<true>(lds, tid);
    if constexpr (LOG4 >= 6) fft_r16<SEQ / 256, true>(lds, tid);
    if constexpr (LOG4 >= 4) fft_r16<SEQ / 16, true>(lds, tid);
    if constexpr (LOG4 >= 2) fft_r16<SEQ, true>(lds, tid);
}
DI f32x2 fft_halfroot(ldsp lds, int k) { f32x2 w = fft_tw(lds, k >> 1); if (k & 1) { f32x2 h; h.x = (float)cos(3.14159265358979323846 / (double)SEQ); h.y = -(float)sin(3.14159265358979323846 / (double)SEQ); w = cmul(w, h); } return w; }

DI void phase_hy_fftf(ldsp lds) {
    unsigned char* const ws_ = WSP();
    const float* FILT = (const float*)(ws_ + WS_FILT); f32x2* KF = (f32x2*)(ws_ + WS_KF);
    LAS f32x2* X = (LAS f32x2*)(lds + FFT_X); LAS float* scr = (LAS float*)(lds + FFT_SCR);
    const int tid = TID, lane = tid & 63, wave = tid >> 6;
    fft_tables(lds);
    for (int u = blockIdx.x; u < 2048; u += gridDim.x) {
        const int o = u >> 10, c = u & 1023;
        const float* fwd = FILT + (size_t)(o * 2048 + c) * SEQ; const float* bwd = FILT + (size_t)(o * 2048 + 1024 + c) * SEQ;
        float asum = 0.f;
        {
            constexpr int NVF = (SEQ / 4 + 511) / 512;
            f32x4 lo[NVF], hi[NVF]; float a0[NVF];
#pragma unroll
            for (int jv = 0; jv < NVF; ++jv) {
                const int v = tid + 512 * jv, n = 8 * v; lo[jv] = (f32x4){0.f, 0.f, 0.f, 0.f}; hi[jv] = lo[jv]; a0[jv] = 0.f;
                if (v < SEQ / 4) {
                    if (n < SEQ) { lo[jv] = *(const f32x4*)(fwd + n); hi[jv] = *(const f32x4*)(fwd + n + 4); }
                    else { const float* blk = bwd + (2 * SEQ - n - 8); lo[jv] = *(const f32x4*)blk; hi[jv] = *(const f32x4*)(blk + 4); a0[jv] = (n == SEQ) ? 0.f : bwd[2 * SEQ - n]; }
                }
            }
#pragma unroll
            for (int jv = 0; jv < NVF; ++jv) {
                const int v = tid + 512 * jv, n = 8 * v;
                if (v < SEQ / 4) {
                    f32x4 l2 = lo[jv], h2 = hi[jv];
                    if (n >= SEQ) { const f32x4 b0 = lo[jv], b1 = hi[jv]; l2[0] = a0[jv]; l2[1] = b1[3]; l2[2] = b1[2]; l2[3] = b1[1]; h2[0] = b1[0]; h2[1] = b0[3]; h2[2] = b0[2]; h2[3] = b0[1]; }
                    LAS f32x4* q = (LAS f32x4*)(X + fpad(4 * v)); q[0] = l2; q[1] = h2;
                    asum += fabsf(l2[0]) + fabsf(l2[1]) + fabsf(l2[2]) + fabsf(l2[3]) + fabsf(h2[0]) + fabsf(h2[1]) + fabsf(h2[2]) + fabsf(h2[3]);
                }
            }
        }
        asum = wave_sum(asum);
        if (lane == 0) scr[wave] = asum;
        __syncthreads();
        float tot = 0.f;
        for (int w = 0; w < 8; ++w) tot += scr[w];
        const float inv = 1.f / tot;
        fft_dif(lds, tid);
        f32x4* kfp = (f32x4*)(KF + (size_t)u * KFP);
        for (int j = tid; j < SEQ / 2; j += 512) {
            const int p = 4 * (j >> 1) + (j & 1), k = (int)rev4((unsigned)p); f32x4 o;
            if (k == 0) { const f32x2 c0 = X[0]; o[0] = (c0.x + c0.y) * inv; o[1] = 0.f; o[2] = (c0.x - c0.y) * inv; o[3] = 0.f; }
            else {
                const int k2 = SEQ - k; const f32x2 ck = X[fpad(p)], ck2 = X[fpad(rev4(k2))];
                f32x2 E, O; E.x = 0.5f * (ck.x + ck2.x); E.y = 0.5f * (ck.y - ck2.y);
                const float dx = ck.x - ck2.x, dy = ck.y + ck2.y; O.x = 0.5f * dy; O.y = -0.5f * dx;
                const f32x2 wO = cmul(fft_halfroot(lds, k), O);
                const f32x2 ak = E + wO, ak2 = cconj(E - wO);
                o[0] = ak.x * inv; o[1] = ak.y * inv; o[2] = ak2.x * inv; o[3] = ak2.y * inv;
            }
            kfp[j] = o;
        }
        if (tid == 0) { const f32x2 ck = X[fpad(rev4(SEQ / 2))]; f32x4 o; o[0] = ck.x * inv; o[1] = -ck.y * inv; o[2] = 0.f; o[3] = 0.f; kfp[SEQ / 2] = o; }
        __syncthreads();
    }
}

DI void hy_conv3_vec(const bf16_t* ur, const float* hs, int ch, int v, float (&out)[8]) {
    const float w0 = hs[ch], w1 = hs[3072 + ch], w2 = hs[6144 + ch];
    const bf16x8 xv = *(const bf16x8*)(ur + 8 * v);
    const float xp = (v > 0) ? bf2f(ur[8 * v - 1]) : 0.f, xn = (8 * v + 8 < SEQ) ? bf2f(ur[8 * v + 8]) : 0.f;
    float x[10]; x[0] = xp; x[9] = xn;
#pragma unroll
    for (int i = 0; i < 8; ++i) x[i + 1] = bf2f((unsigned short)xv[i]);
#pragma unroll
    for (int i = 0; i < 8; ++i) out[i] = w0 * x[i] + w1 * x[i + 1] + w2 * x[i + 2];
}
DI void hy_kfload4(const f32x4* kfp, int jbase, f32x4 (&fp)[4]) {
#pragma unroll
    for (int i = 0; i < 4; ++i) { const int j = jbase + 512 * i; fp[i] = kfp[j < SEQ / 2 ? j : 0]; }
}
DI void hy_pointwise4(ldsp lds, int jbase, const f32x4 (&fp)[4]) {
    LAS f32x2* X = (LAS f32x2*)(lds + FFT_X);
#pragma unroll
    for (int i = 0; i < 4; ++i) {
        const int j = jbase + 512 * i; if (j >= SEQ / 2) continue;
        const int p = 4 * (j >> 1) + (j & 1), k = (int)rev4((unsigned)p);
        f32x2 kfk, kfk2; kfk.x = fp[i][0]; kfk.y = fp[i][1]; kfk2.x = fp[i][2]; kfk2.y = fp[i][3];
        if (k == 0) {
            const f32x2 c0 = X[0]; const float a0 = c0.x + c0.y, aL = c0.x - c0.y;
            const f32x2 y0 = kfk * a0, yL = kfk2 * aL;
            f32x2 s, d; s.x = 0.5f * (y0.x + yL.x); s.y = 0.5f * (y0.y - yL.y); d.x = 0.5f * (y0.x - yL.x); d.y = 0.5f * (y0.y + yL.y);
            f32x2 r; r.x = s.x - d.y; r.y = s.y + d.x; X[0] = r;
        } else {
            const int k2 = SEQ - k; const int r1 = fpad(p), r2 = fpad(rev4(k2)); const f32x2 ck = X[r1], ck2 = X[r2];
            f32x2 E, O; E.x = 0.5f * (ck.x + ck2.x); E.y = 0.5f * (ck.y - ck2.y);
            const float dx = ck.x - ck2.x, dy = ck.y + ck2.y; O.x = 0.5f * dy; O.y = -0.5f * dx;
            const f32x2 w = fft_halfroot(lds, k); const f32x2 wO = cmul(w, O);
            const f32x2 yk = cmul(E + wO, kfk), yk2 = cmul(cconj(E - wO), kfk2);
            f32x2 s, d; s.x = 0.5f * (yk.x + yk2.x); s.y = 0.5f * (yk.y - yk2.y); d.x = 0.5f * (yk.x - yk2.x); d.y = 0.5f * (yk.y + yk2.y);
            f32x2 t = cmulc(d, w); f32x2 r; r.x = s.x - t.y; r.y = s.y + t.x; X[r1] = r;
            f32x2 s2 = cconj(s); f32x2 d2; d2.x = -d.x; d2.y = d.y;
            f32x2 t2 = cmul(d2, w); r.x = s2.x + t2.y; r.y = s2.y - t2.x; X[r2] = r;
        }
    }
}
DI void phase_hy_conv(int l, ldsp lds) {
    unsigned char* const ws_ = WSP();
    const bf16_t* UT = (const bf16_t*)(ws_ + WS_UT); const f32x2* KF = (const f32x2*)(ws_ + WS_KF); bf16_t* Z2T = (bf16_t*)(ws_ + WS_Z2T);
    const float* hs = INP(I_HYS) + l * 3 * 3072; const float* hbias = INP(I_HYBIAS) + l * 2048;
    LAS f32x2* X = (LAS f32x2*)(lds + FFT_X);
    const int tid = TID;
    constexpr int NV = (SEQ / 8 + 511) / 512;
    fft_tables(lds);
    for (int c = blockIdx.x; c < 1024; c += gridDim.x) {
        float z[NV][8];
#pragma unroll
        for (int j = 0; j < NV; ++j) { if (tid + 512 * j < SEQ / 8) hy_conv3_vec(UT + (size_t)c * SEQ, hs, c, tid + 512 * j, z[j]); }
#pragma unroll 1
        for (int o = 0; o < 2; ++o) {
#pragma unroll
            for (int j = 0; j < NV; ++j) {
                const int m0 = 4 * (tid + 512 * j); if (tid + 512 * j >= SEQ / 8) continue;
                LAS f32x4* q = (LAS f32x4*)(X + fpad(m0)); f32x4 a, b; a[0] = z[j][0]; a[1] = z[j][1]; a[2] = z[j][2]; a[3] = z[j][3]; b[0] = z[j][4]; b[1] = z[j][5]; b[2] = z[j][6]; b[3] = z[j][7];
                q[0] = a; q[1] = b;
                LAS f32x4* q2 = (LAS f32x4*)(X + fpad(SEQ / 2 + m0)); q2[0] = (f32x4){0.f, 0.f, 0.f, 0.f}; q2[1] = (f32x4){0.f, 0.f, 0.f, 0.f};
            }
            const f32x4* kfp = (const f32x4*)(KF + (size_t)(o * 1024 + c) * KFP);
            __syncthreads();
            fft_dif(lds, tid);
            if (tid == 0) { const int r = fpad(rev4(SEQ / 2)); const f32x2 yk = cmul(cconj(X[r]), ld_xcu2((const f32x2*)(kfp + SEQ / 2))); X[r] = cconj(yk); }
            {
                constexpr int NKI = (SEQ / 2 + 511) / 512, NG = (NKI + 3) / 4;
                f32x4 fp0[4], fp1[4];
                hy_kfload4(kfp, tid, fp0);
#pragma unroll 1
                for (int g = 0; g < NG; g += 2) {
                    if (g + 1 < NG) hy_kfload4(kfp, tid + 2048 * (g + 1), fp1);
                    hy_pointwise4(lds, tid + 2048 * g, fp0);
                    if (g + 2 < NG) hy_kfload4(kfp, tid + 2048 * (g + 2), fp0);
                    if (g + 1 < NG) hy_pointwise4(lds, tid + 2048 * (g + 1), fp1);
                }
            }
            __syncthreads();
            fft_dit_inv(lds, tid);
            const float bias = hbias[o * 1024 + c]; const float invn = 1.f / (float)SEQ;
            const bf16_t* ug = UT + (size_t)(1024 * (o + 1) + c) * SEQ;
#pragma unroll
            for (int j = 0; j < NV; ++j) {
                const int v = tid + 512 * j; if (v >= SEQ / 8) continue; const LAS f32x4* q = (const LAS f32x4*)(X + fpad(4 * v)); const f32x4 a = q[0], b = q[1];
                float g[8]; hy_conv3_vec(ug, hs, 1024 * (o + 1) + c, v, g);
                z[j][0] = g[0] * (a[0] * invn + bias * z[j][0]); z[j][1] = g[1] * (a[1] * invn + bias * z[j][1]); z[j][2] = g[2] * (a[2] * invn + bias * z[j][2]); z[j][3] = g[3] * (a[3] * invn + bias * z[j][3]);
                z[j][4] = g[4] * (b[0] * invn + bias * z[j][4]); z[j][5] = g[5] * (b[1] * invn + bias * z[j][5]); z[j][6] = g[6] * (b[2] * invn + bias * z[j][6]); z[j][7] = g[7] * (b[3] * invn + bias * z[j][7]);
                if (o == 1) { u32x4 w; w.x = pk2(z[j][0], z[j][1]); w.y = pk2(z[j][2], z[j][3]); w.z = pk2(z[j][4], z[j][5]); w.w = pk2(z[j][6], z[j][7]); *(u32x4*)(Z2T + (size_t)c * SEQ + 8 * v) = w; }
            }
        }
        __syncthreads();
    }
}
DI void phase_hy_out(ldsp lds) {
    unsigned char* const ws_ = WSP();
    const bf16_t* Z2T = (const bf16_t*)(ws_ + WS_Z2T); bf16_t* Y = (bf16_t*)(ws_ + WS_Y);
    LAS unsigned short* T = (LAS unsigned short*)lds; const int tid = TID;
    for (int t = blockIdx.x; t < 16 * (SEQ / 64); t += gridDim.x) {
        const int c0 = (t & 15) * 64, t0 = (t >> 4) * 64;
        { const int r = tid >> 3, q8 = tid & 7; const bf16x8 v = *(const bf16x8*)(Z2T + (size_t)(c0 + r) * SEQ + t0 + 8 * q8);
#pragma unroll
          for (int j = 0; j < 8; ++j) T[(8 * q8 + j) * 72 + r] = (unsigned short)v[j]; }
        __syncthreads();
        { const int tt = tid >> 3, cc = tid & 7; *(u32x4*)(Y + (size_t)(t0 + tt) * 4096 + c0 + 8 * cc) = *(const LAS u32x4*)(T + tt * 72 + 8 * cc); }
        __syncthreads();
    }
}

constexpr float RSQ128 = 0.08838834764831845f;
DI void phase_ret_kv(int l, ldsp lds) {
    unsigned char* const ws_ = WSP();
    constexpr int PK = 272, PV = 528, KF_OFF = 0, KB_OFF = 128 * PK, V_OFF = 2 * 128 * PK;
    static_assert(V_OFF + 128 * PV <= LDS_PTRS, "lds");
    const bf16_t* PROJ = (const bf16_t*)(ws_ + WS_PROJ); bf16_t* KVT = (bf16_t*)(ws_ + WS_RKV); const float* dec = INP(I_RDEC) + l * 8;
    const int tid = TID, lane = tid & 63, w = tid >> 6, lr = lane & 15, lg = lane >> 4;
    for (int u = blockIdx.x; u < 4 * NCR; u += gridDim.x) {
        const int h = u / NCR, n = u % NCR, t0 = n * 128;
        const float lgf = logsig(dec[h]), lgb = logsig(dec[4 + h]);
#pragma unroll
        for (int i = 0; i < 4; ++i) {
            const int c = tid + 512 * i, r = c >> 4, cc = c & 15;
            const bf16x8 kv = *(const bf16x8*)(PROJ + (size_t)(t0 + r) * NPROJ + PC_RK + h * 128 + 8 * cc);
            const float sf = RSQ128 * fexp(lgf * (float)(127 - r)), sb = RSQ128 * fexp(lgb * (float)r);
            u32x4 of, ob;
#pragma unroll
            for (int j = 0; j < 4; ++j) { const float a = bf2f((unsigned short)kv[2 * j]), b = bf2f((unsigned short)kv[2 * j + 1]); of[j] = pk2(a * sf, b * sf); ob[j] = pk2(a * sb, b * sb); }
            *(LAS u32x4*)(lds + KF_OFF + r * PK + 16 * cc) = of; *(LAS u32x4*)(lds + KB_OFF + r * PK + 16 * cc) = ob;
        }
#pragma unroll
        for (int i = 0; i < 8; ++i) { const int c = tid + 512 * i, r = c >> 5, cc = c & 31; *(LAS u32x4*)(lds + V_OFF + r * PV + 16 * cc) = *(const u32x4*)(PROJ + (size_t)(t0 + r) * NPROJ + PC_RV + h * 256 + 8 * cc); }
        __syncthreads();
#pragma unroll 1
        for (int dir = 0; dir < 2; ++dir) {
            const unsigned koff = dir ? KB_OFF : KF_OFF;
            f32x4 acc[2][8];
#pragma unroll
            for (int a = 0; a < 2; ++a)
#pragma unroll
                for (int b = 0; b < 8; ++b) acc[a][b] = (f32x4){0.f, 0.f, 0.f, 0.f};
#pragma unroll 1
            for (int ks = 0; ks < 4; ++ks) {
                TrF avf[2], bvf[8];
#pragma unroll
                for (int e2 = 0; e2 < 2; ++e2) tr_issue(lds, V_OFF, PV, 32 * ks + 8 * lg, 32 * ks + 8 * lg + 4, 16 * (2 * w + e2), lr, avf[e2]);
#pragma unroll
                for (int dt = 0; dt < 8; ++dt) tr_issue(lds, koff, PK, 32 * ks + 8 * lg, 32 * ks + 8 * lg + 4, 16 * dt, lr, bvf[dt]);
                tr_wait2(avf[0], avf[1]); tr_wait2(bvf[0], bvf[1]); tr_wait2(bvf[2], bvf[3]); tr_wait2(bvf[4], bvf[5]); tr_wait2(bvf[6], bvf[7]);
#pragma unroll
                for (int dt = 0; dt < 8; ++dt)
#pragma unroll
                    for (int e2 = 0; e2 < 2; ++e2) acc[e2][dt] = mfma16(tr_val(bvf[dt]), tr_val(avf[e2]), acc[e2][dt]);
            }
            bf16_t* dst = KVT + (size_t)((dir * 4 + h) * NCR + n) * 32768;
#pragma unroll
            for (int e2 = 0; e2 < 2; ++e2)
#pragma unroll
                for (int dt = 0; dt < 8; ++dt) { u32x2 pw; pw.x = pk2(acc[e2][dt][0], acc[e2][dt][1]); pw.y = pk2(acc[e2][dt][2], acc[e2][dt][3]); *(u32x2*)(dst + (16 * (2 * w + e2) + lr) * 128 + 16 * dt + 4 * lg) = pw; }
        }
        __syncthreads();
    }
}
DI void phase_ret_scan(ldsp lds, int l) {
    unsigned char* const ws_ = WSP();
    const unsigned* KVT = (const unsigned*)(ws_ + WS_RKV); unsigned* ST = (unsigned*)(ws_ + WS_RST); const float* dec = INP(I_RDEC) + l * 8;
    static_assert(NCR % 8 == 0, "scan unroll");
    for (int g = blockIdx.x * 512 + TID; g < 8 * 16384; g += gridDim.x * 512) {
        const int dh = g >> 14, ep = g & 16383, dir = dh >> 2;
        const float G = expf(logsig(dec[dh]) * 128.f); float s0 = 0.f, s1 = 0.f;
        const unsigned* src = KVT + (size_t)dh * NCR * 16384 + ep; unsigned* dst = ST + (size_t)dh * NCR * 16384 + ep;
#pragma unroll 1
        for (int nb = 0; nb < NCR; nb += 8) {
            const int n0 = dir ? (NCR - 8 - nb) : nb; unsigned v[8];
#pragma unroll
            for (int j = 0; j < 8; ++j) v[j] = src[(size_t)(n0 + j) * 16384];
            if (dir == 0) {
#pragma unroll
                for (int j = 0; j < 8; ++j) { dst[(size_t)(n0 + j) * 16384] = pk2(s0, s1); s0 = s0 * G + bf2f((unsigned short)(v[j] & 0xffffu)); s1 = s1 * G + bf2f((unsigned short)(v[j] >> 16)); }
            } else {
#pragma unroll
                for (int j = 7; j >= 0; --j) { dst[(size_t)(n0 + j) * 16384] = pk2(s0, s1); s0 = s0 * G + bf2f((unsigned short)(v[j] & 0xffffu)); s1 = s1 * G + bf2f((unsigned short)(v[j] >> 16)); }
            }
        }
    }
}
DI void phase_ret_out(int l, ldsp lds) {
    unsigned char* const ws_ = WSP();
    constexpr int PK = 272, PV = 528, K_OFF = 0, V_OFF = 128 * PK;
    const bf16_t* PROJ = (const bf16_t*)(ws_ + WS_PROJ); const bf16_t* ST = (const bf16_t*)(ws_ + WS_RST); bf16_t* Y = (bf16_t*)(ws_ + WS_Y); const float* dec = INP(I_RDEC) + l * 8;
    const int tid = TID, lane = tid & 63, w = tid >> 6, lr = lane & 15, lg = lane >> 4;
    for (int u = blockIdx.x; u < 4 * NCR; u += gridDim.x) {
        const int h = u / NCR, n = u % NCR, t0 = n * 128;
        const float lgf = logsig(dec[h]), lgb = logsig(dec[4 + h]);
        const int i = 16 * w + lr; const size_t tok = (size_t)(t0 + i);
        bf16x8 qf[4];
#pragma unroll
        for (int ks = 0; ks < 4; ++ks) qf[ks] = *(const bf16x8*)(PROJ + tok * NPROJ + PC_RQ + h * 128 + 32 * ks + 8 * lg);
#pragma unroll
        for (int i = 0; i < 4; ++i) {
            const int c = tid + 512 * i, r = c >> 4, cc = c & 15;
            const bf16x8 kv = *(const bf16x8*)(PROJ + (size_t)(t0 + r) * NPROJ + PC_RK + h * 128 + 8 * cc); u32x4 o;
#pragma unroll
            for (int j = 0; j < 4; ++j) o[j] = pk2(bf2f((unsigned short)kv[2 * j]) * RSQ128, bf2f((unsigned short)kv[2 * j + 1]) * RSQ128);
            *(LAS u32x4*)(lds + K_OFF + r * PK + 16 * cc) = o;
        }
#pragma unroll
        for (int i = 0; i < 8; ++i) { const int c = tid + 512 * i, r = c >> 5, cc = c & 31; *(LAS u32x4*)(lds + V_OFF + r * PV + 16 * cc) = *(const u32x4*)(PROJ + (size_t)(t0 + r) * NPROJ + PC_RV + h * 256 + 8 * cc); }
        __syncthreads();
        f32x4 s[8];
#pragma unroll
        for (int jt = 0; jt < 8; ++jt) {
            s[jt] = (f32x4){0.f, 0.f, 0.f, 0.f};
#pragma unroll
            for (int ks = 0; ks < 4; ++ks) s[jt] = mfma16(lds_row8(lds, K_OFF + (16 * jt + lr) * PK + (32 * ks + 8 * lg) * 2), qf[ks], s[jt]);
#pragma unroll
            for (int r = 0; r < 4; ++r) { const int dm = i - (16 * jt + 4 * lg + r); float d = 0.f; if (dm >= 0) d += fexp(lgf * (float)dm); if (dm <= 0) d += fexp(lgb * (float)(-dm)); s[jt][r] *= d; }
        }
        bf16x8 pf[4];
#pragma unroll
        for (int kk = 0; kk < 4; ++kk) pf[kk] = pack8(s[2 * kk], s[2 * kk + 1]);
        const float wqf = fexp(lgf * (float)(i + 1)), wqb = fexp(lgb * (float)(128 - i));
        const bf16_t* stf = ST + (size_t)((0 * 4 + h) * NCR + n) * 32768; const bf16_t* stb = ST + (size_t)((4 + h) * NCR + n) * 32768;
        float* ry = (float*)(ws_ + WS_RY) + tok * 1024 + h * 256 + 4 * lg; float ss = 0.f;
#define RET_LD(et_, SF, SB) do { _Pragma("unroll") for (int ks = 0; ks < 4; ++ks) { SF[ks] = *(const bf16x8*)(stf + (16 * (et_) + lr) * 128 + 32 * ks + 8 * lg); SB[ks] = *(const bf16x8*)(stb + (16 * (et_) + lr) * 128 + 32 * ks + 8 * lg); } } while (0)
#define RET_ET(et_, SF, SB) do { f32x4 a1 = {0.f, 0.f, 0.f, 0.f}, af = a1, ab = a1; TrF vf[4]; \
            _Pragma("unroll") for (int kk = 0; kk < 4; ++kk) tr_issue(lds, V_OFF, PV, 32 * kk + 4 * lg, 32 * kk + 16 + 4 * lg, 16 * (et_), lr, vf[kk]); \
            tr_wait2(vf[0], vf[1]); tr_wait2(vf[2], vf[3]); \
            _Pragma("unroll") for (int kk = 0; kk < 4; ++kk) a1 = mfma16(tr_val(vf[kk]), pf[kk], a1); \
            _Pragma("unroll") for (int ks = 0; ks < 4; ++ks) { af = mfma16(SF[ks], qf[ks], af); ab = mfma16(SB[ks], qf[ks], ab); } \
            const f32x4 yv = a1 + af * wqf + ab * wqb; ss += dot4(yv, yv); *(f32x4*)(ry + 16 * (et_)) = yv; } while (0)
        {
            bf16x8 sfC[4], sbC[4];
            RET_LD(0, sfC, sbC);
#pragma unroll 1
            for (int et = 0; et < 16; ++et) {
                bf16x8 sfN[4], sbN[4]; const int en = (et + 1 < 16) ? et + 1 : et;
                RET_LD(en, sfN, sbN);
                RET_ET(et, sfC, sbC);
#pragma unroll
                for (int ks = 0; ks < 4; ++ks) { sfC[ks] = sfN[ks]; sbC[ks] = sbN[ks]; }
            }
        }
#undef RET_LD
#undef RET_ET
        ss += __shfl_xor(ss, 16); ss += __shfl_xor(ss, 32);
        const float rstd = rsqrtf(ss * (1.f / 256.f) + EPS);
#pragma unroll 1
        for (int et = 0; et < 16; ++et) {
            const int e0 = 16 * et + 4 * lg; const f32x4 yv = *(const f32x4*)(ry + 16 * et);
            const s16x4 gv = *(const s16x4*)(PROJ + tok * NPROJ + PC_RG + h * 256 + e0); float o[4];
#pragma unroll
            for (int r = 0; r < 4; ++r) { const float gg = bf2f((unsigned short)gv[r]); o[r] = yv[r] * rstd * (gg * frcp(1.f + fexp(-gg))); }
            u32x2 ww; ww.x = pk2(o[0], o[1]); ww.y = pk2(o[2], o[3]); *(u32x2*)(Y + tok * 4096 + 1024 + h * 256 + e0) = ww;
        }
        __syncthreads();
    }
}

DI void phase_att(int l, ldsp lds) {
    unsigned char* const ws_ = WSP();
    constexpr int PK = 272, K_OFF = 0, V_OFF = 256 * PK, NB = SEQ / 128;
    static_assert(2 * 256 * PK <= LDS_PTRS, "lds");
    const bf16_t* PROJ = (const bf16_t*)(ws_ + WS_PROJ); bf16_t* OB = (bf16_t*)(ws_ + WS_OB); float* LSE = (float*)(ws_ + WS_LSE);
    const float* gq = INP(I_AGAIN) + l * 256; const float* gk = gq + 128;
    const int tid = TID, lane = tid & 63, w = tid >> 6, lr = lane & 15, lg = lane >> 4;
    bf16x8 kvr[8]; u32x4 vvr[8];
    float gkr[8];
#pragma unroll
    for (int j = 0; j < 8; ++j) gkr[j] = gk[8 * (tid & 15) + j];
#define ATT_LOAD(uu) do { const int br_ = (uu) / (8 * NB), rem_ = (uu) % (8 * NB), h_ = rem_ / NB, ub_ = rem_ % NB; \
        const int dil_ = (br_ == 0) ? 1 : (br_ == 1) ? 4 : 16; const int n_ = SEQ / dil_, nblk_ = n_ / 128, rho_ = ub_ / nblk_, p0_ = (ub_ % nblk_) * 128; \
        _Pragma("unroll") for (int i = 0; i < 8; ++i) { const int c = tid + 512 * i, r = c >> 4, cc = c & 15; const int pp = p0_ - 64 + r; const bool valid = (pp >= 0) && (pp < n_); \
            const size_t tk = (size_t)(valid ? pp * dil_ + rho_ : 0); \
            kvr[i] = *(const bf16x8*)(PROJ + tk * NPROJ + PC_AK + h_ * 128 + 8 * cc); vvr[i] = *(const u32x4*)(PROJ + tk * NPROJ + PC_AV + h_ * 128 + 8 * cc); } } while (0)
    if ((int)blockIdx.x < 3 * 8 * NB) ATT_LOAD((int)blockIdx.x);
    for (int u = blockIdx.x; u < 3 * 8 * NB; u += gridDim.x) {
        const int br = u / (8 * NB), rem = u % (8 * NB), h = rem / NB, ub = rem % NB;
        const int dil = (br == 0) ? 1 : (br == 1) ? 4 : 16; const int n = SEQ / dil, nblk = n / 128, rho = ub / nblk, p0 = (ub % nblk) * 128;
        const float slope = exp2f(-(float)(h + 1)) * (float)dil;
        const int qi = 16 * w + lr; const size_t tq = (size_t)((p0 + qi) * dil + rho);
        bf16x8 qr[4];
#pragma unroll
        for (int ks = 0; ks < 4; ++ks) qr[ks] = *(const bf16x8*)(PROJ + tq * NPROJ + PC_AQ + h * 128 + 32 * ks + 8 * lg);
#pragma unroll
        for (int i = 0; i < 8; ++i) {
            const int c = tid + 512 * i, r = c >> 4, cc = c & 15; const int pp = p0 - 64 + r; const bool valid = (pp >= 0) && (pp < n);
            const bf16x8 kv = kvr[i]; u32x4 vv = vvr[i];
            float x[8]; float ss = 0.f;
#pragma unroll
            for (int j = 0; j < 8; ++j) { x[j] = valid ? bf2f((unsigned short)kv[j]) : 0.f; ss += x[j] * x[j]; }
            ss += __shfl_xor(ss, 1); ss += __shfl_xor(ss, 2); ss += __shfl_xor(ss, 4); ss += __shfl_xor(ss, 8);
            const float rstd = rsqrtf(ss * (1.f / 128.f) + EPS); u32x4 o;
#pragma unroll
            for (int j = 0; j < 4; ++j) o[j] = pk2(x[2 * j] * rstd * gkr[2 * j], x[2 * j + 1] * rstd * gkr[2 * j + 1]);
            if (!valid) vv = (u32x4){0u, 0u, 0u, 0u};
            *(LAS u32x4*)(lds + K_OFF + r * PK + 16 * cc) = o; *(LAS u32x4*)(lds + V_OFF + r * PK + 16 * cc) = vv;
            MEMFENCE();
        }
        __syncthreads();
        bf16x8 qf[4];
        {
            float ss = 0.f;
#pragma unroll
            for (int ks = 0; ks < 4; ++ks) {
#pragma unroll
                for (int j = 0; j < 8; ++j) { const float v = bf2f((unsigned short)qr[ks][j]); ss += v * v; } }
            ss += __shfl_xor(ss, 16); ss += __shfl_xor(ss, 32);
            const float rstd = rsqrtf(ss * (1.f / 128.f) + EPS) * RSQ128;
#pragma unroll
            for (int ks = 0; ks < 4; ++ks) { u32x4 o;
#pragma unroll
                for (int j = 0; j < 4; ++j) { const int d = 32 * ks + 8 * lg + 2 * j; o[j] = pk2(bf2f((unsigned short)qr[ks][2 * j]) * rstd * gq[d], bf2f((unsigned short)qr[ks][2 * j + 1]) * rstd * gq[d + 1]); }
                qf[ks] = __builtin_bit_cast(bf16x8, o); }
        }
        if (u + (int)gridDim.x < 3 * 8 * NB) ATT_LOAD(u + (int)gridDim.x);
        const float dlane = (float)(4 * lg - lr); const int kl = 16 * w + 4 * lg;
        const int klo = (p0 == 0) ? 64 : 0; const unsigned kspan = (unsigned)(((p0 + 128 == n) ? 192 : 256) - klo);
        f32x4 s[10]; float mx = -1e30f;
#pragma unroll
        for (int t = 0; t < 9; ++t) {
            s[t] = (f32x4){0.f, 0.f, 0.f, 0.f};
#pragma unroll
            for (int ks = 0; ks < 4; ++ks) s[t] = mfma16(lds_row8(lds, K_OFF + (16 * (w + t) + lr) * PK + (32 * ks + 8 * lg) * 2), qf[ks], s[t]);
#pragma unroll
            for (int r = 0; r < 4; ++r) {
                const float aof = fabsf((float)(16 * t + r - 64) + dlane);
                const bool valid = (aof <= 64.f) && ((unsigned)(16 * t + r + kl - klo) < kspan);
                const float sv = valid ? s[t][r] - slope * aof : -1e30f; s[t][r] = sv; mx = fmaxf(mx, sv);
            }
            MEMFENCE();
        }
        s[9] = (f32x4){0.f, 0.f, 0.f, 0.f};
        mx = fmaxf(mx, __shfl_xor(mx, 16)); mx = fmaxf(mx, __shfl_xor(mx, 32));
        float lsum = 0.f;
#pragma unroll
        for (int t = 0; t < 9; ++t)
#pragma unroll
            for (int r = 0; r < 4; ++r) { const float sv = s[t][r]; const float e = fexp(sv - mx); s[t][r] = e; lsum += e; }
        lsum += __shfl_xor(lsum, 16); lsum += __shfl_xor(lsum, 32);
        bf16x8 pf[5];
#pragma unroll
        for (int kk = 0; kk < 5; ++kk) pf[kk] = pack8(s[2 * kk], s[2 * kk + 1]);
        const float inv = 1.f / lsum;
        bf16_t* orow = OB + ((size_t)br * SEQ + tq) * 1024 + h * 128;
#pragma unroll 1
        for (int et = 0; et < 8; ++et) {
            f32x4 o = {0.f, 0.f, 0.f, 0.f};
            TrF vf[5];
#pragma unroll
            for (int kk = 0; kk < 5; ++kk) { const int ra = 16 * (w + 2 * kk) + 4 * lg, rb = (kk < 4) ? ra + 16 : ra; tr_issue(lds, V_OFF, PK, ra, rb, 16 * et, lr, vf[kk]); }
            tr_wait2(vf[0], vf[1]); tr_wait2(vf[2], vf[3]); tr_wait1(vf[4]);
#pragma unroll
            for (int kk = 0; kk < 5; ++kk) o = mfma16(tr_val(vf[kk]), pf[kk], o);
            u32x2 ww; ww.x = pk2(o[0] * inv, o[1] * inv); ww.y = pk2(o[2] * inv, o[3] * inv); *(u32x2*)(orow + 16 * et + 4 * lg) = ww;
        }
        if (lg == 0) LSE[((size_t)br * SEQ + tq) * 8 + h] = mx + logf(lsum);
        __syncthreads();
    }
#undef ATT_LOAD
}
DI void phase_att_merge(ldsp lds) {
    unsigned char* const ws_ = WSP();
    const bf16_t* OB = (const bf16_t*)(ws_ + WS_OB); const float* LSE = (const float*)(ws_ + WS_LSE); bf16_t* Y = (bf16_t*)(ws_ + WS_Y);
    for (int g = blockIdx.x * 512 + TID; g < SEQ * 128; g += gridDim.x * 512) {
        const int tok = g >> 7, h = (g >> 4) & 7, e8 = g & 15;
        const float l0 = LSE[((size_t)0 * SEQ + tok) * 8 + h], l1 = LSE[((size_t)1 * SEQ + tok) * 8 + h], l2 = LSE[((size_t)2 * SEQ + tok) * 8 + h];
        const float m = fmaxf(l0, fmaxf(l1, l2)); float w0 = fexp(l0 - m), w1 = fexp(l1 - m), w2 = fexp(l2 - m); const float inv = frcp(w0 + w1 + w2); w0 *= inv; w1 *= inv; w2 *= inv;
        const bf16x8 a = *(const bf16x8*)(OB + ((size_t)0 * SEQ + tok) * 1024 + h * 128 + 8 * e8), b = *(const bf16x8*)(OB + ((size_t)1 * SEQ + tok) * 1024 + h * 128 + 8 * e8), c = *(const bf16x8*)(OB + ((size_t)2 * SEQ + tok) * 1024 + h * 128 + 8 * e8);
        float o[8];
#pragma unroll
        for (int j = 0; j < 8; ++j) o[j] = w0 * bf2f((unsigned short)a[j]) + w1 * bf2f((unsigned short)b[j]) + w2 * bf2f((unsigned short)c[j]);
        u32x4 ww; ww.x = pk2(o[0], o[1]); ww.y = pk2(o[2], o[3]); ww.z = pk2(o[4], o[5]); ww.w = pk2(o[6], o[7]);
        *(u32x4*)(Y + (size_t)tok * 4096 + 2048 + h * 128 + 8 * e8) = ww;
    }
}

DI int ml_tok(int dir, int n, int i) { return dir ? SEQ - 1 - (64 * n + i) : 64 * n + i; }
DI void ml_gate_row(const float* G, const float* gb, int dir, int h, int n, int lane, float& ig, float& b) {
    const size_t tk = (size_t)ml_tok(dir, n, lane);
    ig = G[tk * 16 + dir * 8 + h] + gb[dir * 8 + h];
    const float lf = logsig(G[tk * 16 + dir * 8 + 4 + h] + gb[dir * 8 + 4 + h]);
    b = lf;
#pragma unroll
    for (int d = 1; d < 64; d <<= 1) { const float o = __shfl_up(b, d); if (lane >= d) b += o; }
}
DI void phase_ml_kv(int l, ldsp lds) {
    unsigned char* const ws_ = WSP();
    constexpr int PK = 272, PV = 528, KW_OFF = 0, V_OFF = 64 * PK, WA_OFF = V_OFF + 64 * PV;
    const bf16_t* PROJ = (const bf16_t*)(ws_ + WS_PROJ); const float* G = (const float*)(ws_ + WS_G); const float* gb = INP(I_MGB) + l * 16;
    bf16_t* KVT = (bf16_t*)(ws_ + WS_MKV); float* KSUM = (float*)(ws_ + WS_KSUM); float* MLOC = (float*)(ws_ + WS_MLOC); float* BLAST = (float*)(ws_ + WS_BLAST);
    LAS float* waL = (LAS float*)(lds + WA_OFF);
    const int tid = TID, lane = tid & 63, w = tid >> 6, lr = lane & 15, lg = lane >> 4;
    for (int u = blockIdx.x; u < 8 * NCM; u += gridDim.x) {
        const int dh = u / NCM, n = u % NCM, dir = dh >> 2, h = dh & 3;
        bf16x8 kreg[2]; u32x4 vreg[4];
#pragma unroll
        for (int i = 0; i < 2; ++i) { const int c = tid + 512 * i, r = c >> 4, cc = c & 15; const size_t tk = (size_t)ml_tok(dir, n, r); kreg[i] = *(const bf16x8*)(PROJ + tk * NPROJ + PC_MK + h * 128 + 8 * cc); }
#pragma unroll
        for (int i = 0; i < 4; ++i) { const int c = tid + 512 * i, r = c >> 5, cc = c & 31; const size_t tk = (size_t)ml_tok(dir, n, r); vreg[i] = *(const u32x4*)(PROJ + tk * NPROJ + PC_MV + h * 256 + 8 * cc); }
        if (w == 0) {
            float ig, b; ml_gate_row(G, gb, dir, h, n, lane, ig, b);
            const float blast = __shfl(b, 63); const float a = blast - b + ig; const float mloc = wave_max(a);
            waL[lane] = expf(a - mloc);
            if (lane == 0) { MLOC[dh * NCM + n] = mloc; BLAST[dh * NCM + n] = blast; }
        }
        __syncthreads();
#pragma unroll
        for (int i = 0; i < 2; ++i) {
            const int c = tid + 512 * i, r = c >> 4, cc = c & 15;
            const bf16x8 kv = kreg[i]; const float sc = RSQ128 * waL[r]; u32x4 o;
#pragma unroll
            for (int j = 0; j < 4; ++j) o[j] = pk2(bf2f((unsigned short)kv[2 * j]) * sc, bf2f((unsigned short)kv[2 * j + 1]) * sc);
            *(LAS u32x4*)(lds + KW_OFF + r * PK + 16 * cc) = o;
        }
#pragma unroll
        for (int i = 0; i < 4; ++i) { const int c = tid + 512 * i, r = c >> 5, cc = c & 31; *(LAS u32x4*)(lds + V_OFF + r * PV + 16 * cc) = vreg[i]; }
        __syncthreads();
        f32x4 acc[2][8];
#pragma unroll
        for (int a = 0; a < 2; ++a)
#pragma unroll
            for (int b = 0; b < 8; ++b) acc[a][b] = (f32x4){0.f, 0.f, 0.f, 0.f};
#pragma unroll 1
        for (int ks = 0; ks < 2; ++ks) {
            TrF avf[2], bvf[8];
#pragma unroll
            for (int e2 = 0; e2 < 2; ++e2) tr_issue(lds, V_OFF, PV, 32 * ks + 8 * lg, 32 * ks + 8 * lg + 4, 16 * (2 * w + e2), lr, avf[e2]);
#pragma unroll
            for (int dt = 0; dt < 8; ++dt) tr_issue(lds, KW_OFF, PK, 32 * ks + 8 * lg, 32 * ks + 8 * lg + 4, 16 * dt, lr, bvf[dt]);
            tr_wait2(avf[0], avf[1]); tr_wait2(bvf[0], bvf[1]); tr_wait2(bvf[2], bvf[3]); tr_wait2(bvf[4], bvf[5]); tr_wait2(bvf[6], bvf[7]);
#pragma unroll
            for (int dt = 0; dt < 8; ++dt)
#pragma unroll
                for (int e2 = 0; e2 < 2; ++e2) acc[e2][dt] = mfma16(tr_val(bvf[dt]), tr_val(avf[e2]), acc[e2][dt]);
        }
        bf16_t* dst = KVT + (size_t)(dh * NCM + n) * 32768;
#pragma unroll
        for (int e2 = 0; e2 < 2; ++e2)
#pragma unroll
            for (int dt = 0; dt < 8; ++dt) { u32x2 pw; pw.x = pk2(acc[e2][dt][0], acc[e2][dt][1]); pw.y = pk2(acc[e2][dt][2], acc[e2][dt][3]); *(u32x2*)(dst + (16 * (2 * w + e2) + lr) * 128 + 16 * dt + 4 * lg) = pw; }
        if (tid < 128) { float s = 0.f; for (int r = 0; r < 64; ++r) s += bf2f(*(const LAS unsigned short*)(lds + KW_OFF + r * PK + 2 * tid)); KSUM[(size_t)(dh * NCM + n) * 128 + tid] = s; }
        __syncthreads();
    }
}
DI void phase_ml_scan(ldsp lds) {
    unsigned char* const ws_ = WSP();
    const unsigned* KVT = (const unsigned*)(ws_ + WS_MKV); unsigned* CT = (unsigned*)(ws_ + WS_MCT); const float* KSUM = (const float*)(ws_ + WS_KSUM); float* NPREV = (float*)(ws_ + WS_NPREV);
    const float* MLOC = (const float*)(ws_ + WS_MLOC); const float* BLAST = (const float*)(ws_ + WS_BLAST); float* MPREV = (float*)(ws_ + WS_MPREV);
    LAS float* sp = (LAS float*)lds; LAS float* sc = sp + NCM;
    const int tid = TID;
    for (int wi = blockIdx.x; wi < 256; wi += gridDim.x) {
        const int dh = wi >> 5, slice = wi & 31;
        for (int n = tid; n < NCM; n += 512) { sp[n] = MLOC[dh * NCM + n]; sc[n] = BLAST[dh * NCM + n]; }
        __syncthreads();
        if (tid == 0) {
            float m = 0.f;
            for (int n = 0; n < NCM; ++n) {
                const float mloc = sp[n], bl = sc[n];
                if (slice == 0) MPREV[dh * NCM + n] = m;
                const float mn = fmaxf(bl + m, mloc); sp[n] = expf(bl + m - mn); sc[n] = expf(mloc - mn); m = mn;
            }
        }
        __syncthreads();
        {
            const int ep = slice * 512 + tid; float c0 = 0.f, c1 = 0.f;
            const unsigned* src = KVT + (size_t)dh * NCM * 16384 + ep; unsigned* dst = CT + (size_t)dh * NCM * 16384 + ep;
#pragma unroll 1
            for (int n0 = 0; n0 < NCM; n0 += 8) {
                unsigned v[8];
#pragma unroll
                for (int j = 0; j < 8; ++j) v[j] = src[(size_t)(n0 + j) * 16384];
#pragma unroll
                for (int j = 0; j < 8; ++j) { const float a = sp[n0 + j], b = sc[n0 + j]; dst[(size_t)(n0 + j) * 16384] = pk2(c0, c1); c0 = a * c0 + b * bf2f((unsigned short)(v[j] & 0xffffu)); c1 = a * c1 + b * bf2f((unsigned short)(v[j] >> 16)); }
            }
        }
        if (slice == 0 && tid < 128) { float v = 0.f; for (int n = 0; n < NCM; ++n) { NPREV[(size_t)(dh * NCM + n) * 128 + tid] = v; v = sp[n] * v + sc[n] * KSUM[(size_t)(dh * NCM + n) * 128 + tid]; } }
        __syncthreads();
    }
}
DI void phase_ml_out(int l, ldsp lds) {
    unsigned char* const ws_ = WSP();
    constexpr int PK = 272, PV = 528, K_OFF = 0, V_OFF = 64 * PK, F_OFF = V_OFF + 64 * PV, HF_OFF = F_OFF + 2048, SS_OFF = HF_OFF + 64 * 256 * 4;
    static_assert(SS_OFF + 512 <= LDS_PTRS, "lds");
    const bf16_t* PROJ = (const bf16_t*)(ws_ + WS_PROJ); const float* G = (const float*)(ws_ + WS_G); const float* gb = INP(I_MGB) + l * 16;
    const bf16_t* CT = (const bf16_t*)(ws_ + WS_MCT); const float* NPREV = (const float*)(ws_ + WS_NPREV); const float* MPREV = (const float*)(ws_ + WS_MPREV);
    bf16_t* Y = (bf16_t*)(ws_ + WS_Y); const float* ng = INP(I_MNG) + l * 1024;
    LAS float* U = (LAS float*)(lds + F_OFF); LAS float* BM = U + 64; LAS float* WI = BM + 64; LAS float* EMT = WI + 64; LAS float* NP = EMT + 64;
    LAS float* HF = (LAS float*)(lds + HF_OFF); LAS float* SS = (LAS float*)(lds + SS_OFF);
    const int tid = TID, lane = tid & 63, w = tid >> 6, lr = lane & 15, lg = lane >> 4;
    const int qs = w & 3, eh = w >> 2, i = 16 * qs + lr;
    for (int u = blockIdx.x; u < 4 * NCM; u += gridDim.x) {
        const int h = u / NCM, nt = u % NCM;
#pragma unroll 1
        for (int dir = 0; dir < 2; ++dir) {
            const int dh = dir * 4 + h, n = dir ? NCM - 1 - nt : nt;
            bf16x8 kreg[2]; u32x4 vreg[4]; bf16x8 qf[4];
#pragma unroll
            for (int ii = 0; ii < 2; ++ii) { const int c = tid + 512 * ii, r = c >> 4, cc = c & 15; const size_t tk = (size_t)ml_tok(dir, n, r); kreg[ii] = *(const bf16x8*)(PROJ + tk * NPROJ + PC_MK + h * 128 + 8 * cc); }
#pragma unroll
            for (int ii = 0; ii < 4; ++ii) { const int c = tid + 512 * ii, r = c >> 5, cc = c & 31; const size_t tk = (size_t)ml_tok(dir, n, r); vreg[ii] = *(const u32x4*)(PROJ + tk * NPROJ + PC_MV + h * 256 + 8 * cc); }
            const size_t tq = (size_t)ml_tok(dir, n, i);
#pragma unroll
            for (int ks = 0; ks < 4; ++ks) qf[ks] = *(const bf16x8*)(PROJ + tq * NPROJ + PC_MQ + h * 128 + 32 * ks + 8 * lg);
            const bf16_t* ct = CT + (size_t)(dh * NCM + n) * 32768;
            bf16x8 cfall[4][4];
#pragma unroll
            for (int e8 = 0; e8 < 4; ++e8)
#pragma unroll
                for (int ks = 0; ks < 4; ++ks) cfall[e8][ks] = *(const bf16x8*)(ct + (16 * (8 * eh + e8) + lr) * 128 + 32 * ks + 8 * lg);
            if (w == 0) {
                float ig, b; ml_gate_row(G, gb, dir, h, n, lane, ig, b);
                const float uu = ig - b; float pm = uu;
#pragma unroll
                for (int d = 1; d < 64; d <<= 1) { const float o = __shfl_up(pm, d); if (lane >= d) pm = fmaxf(pm, o); }
                const float mprev = ld_xcu(MPREV + dh * NCM + n); const float mt = b + fmaxf(mprev, pm);
                U[lane] = uu; BM[lane] = b - mt; WI[lane] = expf(b + mprev - mt); EMT[lane] = expf(-mt);
            }
            if (tid >= 64 && tid < 192) NP[tid - 64] = NPREV[(size_t)(dh * NCM + n) * 128 + tid - 64];
#pragma unroll
            for (int ii = 0; ii < 2; ++ii) {
                const int c = tid + 512 * ii, r = c >> 4, cc = c & 15; const bf16x8 kv = kreg[ii]; u32x4 o;
#pragma unroll
                for (int j = 0; j < 4; ++j) o[j] = pk2(bf2f((unsigned short)kv[2 * j]) * RSQ128, bf2f((unsigned short)kv[2 * j + 1]) * RSQ128);
                *(LAS u32x4*)(lds + K_OFF + r * PK + 16 * cc) = o;
            }
#pragma unroll
            for (int ii = 0; ii < 4; ++ii) { const int c = tid + 512 * ii, r = c >> 5, cc = c & 31; *(LAS u32x4*)(lds + V_OFF + r * PV + 16 * cc) = vreg[ii]; }
            __syncthreads();
            float qn = 0.f;
#pragma unroll
            for (int ks = 0; ks < 4; ++ks)
#pragma unroll
                for (int j = 0; j < 8; ++j) qn += bf2f((unsigned short)qf[ks][j]) * NP[32 * ks + 8 * lg + j];
            qn += __shfl_xor(qn, 16); qn += __shfl_xor(qn, 32);
            const float bmi = BM[i], wii = WI[i];
            f32x4 s[4]; float dsum = 0.f;
#pragma unroll
            for (int jt = 0; jt < 4; ++jt) {
                s[jt] = (f32x4){0.f, 0.f, 0.f, 0.f};
                if (jt <= qs) {
#pragma unroll
                    for (int ks = 0; ks < 4; ++ks) s[jt] = mfma16(lds_row8(lds, K_OFF + (16 * jt + lr) * PK + (32 * ks + 8 * lg) * 2), qf[ks], s[jt]);
#pragma unroll
                    for (int r = 0; r < 4; ++r) { const int j = 16 * jt + 4 * lg + r; const float v = (j <= i) ? s[jt][r] * fexp(U[j] + bmi) : 0.f; s[jt][r] = v; dsum += v; }
                }
            }
            dsum += __shfl_xor(dsum, 16); dsum += __shfl_xor(dsum, 32);
            const float den = dsum + wii * qn; const float rden = 1.f / fmaxf(fabsf(den), EMT[i]);
            bf16x8 pf[2];
#pragma unroll
            for (int kk = 0; kk < 2; ++kk) pf[kk] = pack8(s[2 * kk], s[2 * kk + 1]);
            f32x4 tot[8]; float ssq = 0.f;
#pragma unroll
            for (int e8 = 0; e8 < 8; ++e8) {
                const int et = 8 * eh + e8; f32x4 a1 = {0.f, 0.f, 0.f, 0.f}, a2 = a1;
                TrF vf[2];
#pragma unroll
                for (int kk = 0; kk < 2; ++kk) tr_issue(lds, V_OFF, PV, 32 * kk + 4 * lg, 32 * kk + 16 + 4 * lg, 16 * et, lr, vf[kk]);
                tr_wait2(vf[0], vf[1]);
#pragma unroll
                for (int kk = 0; kk < 2; ++kk) a1 = mfma16(tr_val(vf[kk]), pf[kk], a1);
#pragma unroll
                for (int ks = 0; ks < 4; ++ks) a2 = mfma16(cfall[e8 & 3][ks], qf[ks], a2);
                if (e8 < 4) {
#pragma unroll
                    for (int ks = 0; ks < 4; ++ks) cfall[e8][ks] = *(const bf16x8*)(ct + (16 * (et + 4) + lr) * 128 + 32 * ks + 8 * lg);
                }
                const f32x4 hv = (a1 + a2 * wii) * rden;
                if (dir == 0) { *(LAS f32x4*)(HF + i * 256 + 16 * et + 4 * lg) = hv; tot[e8] = hv; }
                else { const f32x4 hf = *(const LAS f32x4*)(HF + (63 - i) * 256 + 16 * et + 4 * lg); tot[e8] = hv + hf; ssq += dot4(tot[e8], tot[e8]); }
                MEMFENCE();
            }
            if (dir == 1) {
                ssq += __shfl_xor(ssq, 16); ssq += __shfl_xor(ssq, 32);
                if (lg == 0) SS[i * 2 + eh] = ssq;
            }
            __syncthreads();
            if (dir == 1) {
                const float rstd = rsqrtf((SS[i * 2] + SS[i * 2 + 1]) * (1.f / 256.f) + EPS);
                const size_t tok = (size_t)(64 * nt + 63 - i);
#pragma unroll
                for (int e8 = 0; e8 < 8; ++e8) {
                    const int e0 = 16 * (8 * eh + e8) + 4 * lg;
                    const f32x4 gn = *(const f32x4*)(ng + h * 256 + e0); const s16x4 ov = *(const s16x4*)(PROJ + tok * NPROJ + PC_MO + h * 256 + e0); float o[4];
#pragma unroll
                    for (int r = 0; r < 4; ++r) o[r] = sigm(bf2f((unsigned short)ov[r])) * tot[e8][r] * rstd * gn[r];
                    u32x2 ww; ww.x = pk2(o[0], o[1]); ww.y = pk2(o[2], o[3]); *(u32x2*)(Y + tok * 4096 + 3072 + h * 256 + e0) = ww;
                }
            }
        }
    }
}

#ifndef HIPEMU
namespace pg8 {
constexpr int BM = 256, BK = 64, HALF = 128, HTB = HALF * BK * 2, STAGE_BYTES = 8 * HTB, NXCD = 8, WGM = 8;
__host__ __device__ __forceinline__ int lds_byte(int r, int c) { const int st = (r >> 4) * 2 + (c >> 5), rr = r & 15, cc = c & 31, ob = rr * 64 + cc * 2; return st * 1024 + (ob ^ (((ob >> 9) & 1) << 5)); }
__host__ __device__ __forceinline__ void stage_rc(int b, int& R, int& C) { const int st = b / 1024, sb = b % 1024, swz = sb ^ (((sb >> 9) & 1) << 5); R = (st >> 1) * 16 + swz / 64; C = (st & 1) * 32 + (swz % 64) / 2; }
__host__ __device__ __forceinline__ int perm32(int rho) { const int n = rho >> 4, i = rho & 15; return 8 * (i >> 2) + 4 * n + (i & 3); }
struct Unit { int pm, pn; };
struct Gemm { const bf16_t* A; const bf16_t* Bt; int M, N, K; };
struct StaticOrder {
    int nM, nN, nwg, G, c;
    __host__ __device__ void init(int M, int N, int G_, int c_) { nM = M / BM; nN = N / BM; nwg = nM * nN; G = G_; c = c_; }
    __host__ __device__ bool next(int i, Unit& u) const {
        const long L = (long)i * G + c; if (L >= nwg) return false;
        int wgid = (int)L; { const int q = nwg / NXCD, r = nwg % NXCD, xcd = wgid % NXCD, off = wgid / NXCD; wgid = (xcd < r ? xcd * (q + 1) : r * (q + 1) + (xcd - r) * q) + off; }
        const int nig = WGM * nN, gid = wgid / nig, fm = gid * WGM, gsz = (nM - fm) < WGM ? (nM - fm) : WGM;
        u.pm = fm + ((wgid % nig) % gsz); u.pn = (wgid % nig) / gsz; return true;
    }
    __device__ __forceinline__ void a_ready(const Unit&) const {}
    __device__ __forceinline__ void done(const Unit&) const {}
};
struct EpiStoreBf16 {
    static constexpr bool PERM = true, AFTER_DRAIN = false;
    bf16_t* O; int ldc;
    __device__ __forceinline__ void operator()(const f32x4 (&acc)[2][2][4][2], const Unit& u, int wr, int wc, int fr, int fq) const {
        const int row0 = u.pm * BM + wr * 64 + fr, col0 = u.pn * BM + wc * 32 + 8 * fq;
#pragma unroll
        for (int ai = 0; ai < 2; ++ai)
#pragma unroll
            for (int m = 0; m < 4; ++m) { bf16_t* rowp = O + (size_t)(row0 + ai * HALF + m * 16) * ldc + col0;
#pragma unroll
                for (int bj = 0; bj < 2; ++bj) { const f32x4 v0 = acc[ai][bj][m][0], v1 = acc[ai][bj][m][1];
                    u32x4 w; w.x = pk2(v0[0], v0[1]); w.y = pk2(v0[2], v0[3]); w.z = pk2(v1[0], v1[1]); w.w = pk2(v1[2], v1[3]);
                    *(u32x4*)(rowp + bj * HALF) = w; } }
    }
};
struct EpiSwiGLU {
    static constexpr bool PERM = true, AFTER_DRAIN = false;
    bf16_t* O; int ldc;
    __device__ __forceinline__ void operator()(const f32x4 (&acc)[2][2][4][2], const Unit& u, int wr, int wc, int fr, int fq) const {
        const int row0 = u.pm * BM + wr * 64 + fr, col0 = u.pn * HALF + wc * 32 + 8 * fq;
#pragma unroll
        for (int ai = 0; ai < 2; ++ai)
#pragma unroll
            for (int m = 0; m < 4; ++m) { bf16_t* rowp = O + (size_t)(row0 + ai * HALF + m * 16) * ldc + col0; float o[8];
#pragma unroll
                for (int n = 0; n < 2; ++n)
#pragma unroll
                    for (int j = 0; j < 4; ++j) { const float a = acc[ai][0][m][n][j], b = acc[ai][1][m][n][j]; o[4 * n + j] = a * __builtin_amdgcn_rcpf(1.f + __builtin_amdgcn_exp2f(a * -1.4426950408889634f)) * b; }
                u32x4 w; w.x = pk2(o[0], o[1]); w.y = pk2(o[2], o[3]); w.z = pk2(o[4], o[5]); w.w = pk2(o[6], o[7]);
                *(u32x4*)rowp = w; }
    }
};
struct EpiResid {
    static constexpr bool PERM = false, AFTER_DRAIN = false;
    const float* xin; float* xout; const float* gate; int ldc;
    __device__ __forceinline__ void operator()(const f32x4 (&acc)[2][2][4][2], const Unit& u, int wr, int wc, int fr, int fq) const {
        const int row0 = u.pm * BM + wr * 64 + fr, col0 = u.pn * BM + wc * 32 + 4 * fq;
        f32x4 gv[2][2];
#pragma unroll
        for (int bj = 0; bj < 2; ++bj)
#pragma unroll
            for (int n = 0; n < 2; ++n) gv[bj][n] = *(const f32x4*)(gate + col0 + bj * HALF + n * 16);
#pragma unroll
        for (int ai = 0; ai < 2; ++ai)
#pragma unroll
            for (int m2 = 0; m2 < 2; ++m2) { f32x4 xi[2][2][2];
#pragma unroll
                for (int mm = 0; mm < 2; ++mm)
#pragma unroll
                    for (int bj = 0; bj < 2; ++bj)
#pragma unroll
                        for (int n = 0; n < 2; ++n) xi[mm][bj][n] = *(const f32x4*)(xin + (size_t)(row0 + ai * HALF + (2 * m2 + mm) * 16) * ldc + col0 + bj * HALF + n * 16);
                asm volatile("s_waitcnt vmcnt(0)" ::: "memory");
#pragma unroll
                for (int mm = 0; mm < 2; ++mm)
#pragma unroll
                    for (int bj = 0; bj < 2; ++bj)
#pragma unroll
                        for (int n = 0; n < 2; ++n) *(f32x4*)(xout + (size_t)(row0 + ai * HALF + (2 * m2 + mm) * 16) * ldc + col0 + bj * HALF + n * 16) = xi[mm][bj][n] + gv[bj][n] * acc[ai][bj][2 * m2 + mm][n]; }
    }
};
template <class Epi, class Sched, bool ALIGN_EPI = false, bool SP2 = false>
__device__ __forceinline__ void gemm_phase(ldsp lds, const Gemm g, const Sched& S, const Epi& E) {
    const int tid = threadIdx.x, wid = __builtin_amdgcn_readfirstlane(tid >> 6), lane = tid & 63, wr = wid >> 2, wc = wid & 3, fr = lane & 15, fq = lane >> 4;
    const int K = g.K, nt = K / BK;
    unsigned voffA[2], voffB[2];
#pragma unroll
    for (int i = 0; i < 2; ++i) { int R, C; stage_rc(tid * 16 + i * 8192, R, C); const int Rb = Epi::PERM ? ((R & ~31) + perm32(R & 31)) : R;
        voffA[i] = (unsigned)(R * K + C) * 2u; voffB[i] = (unsigned)(Rb * K + C) * 2u; }
    const size_t kstep = (size_t)(BK * 2);
    const size_t hstep = (size_t)HALF * K * 2;
    const size_t tstep = 2 * hstep;
    const unsigned ldsw = (unsigned)wid * 1024u;
    const int aoff = lds_byte(wr * 64 + fr, fq * 8), boff = lds_byte(wc * 32 + fr, fq * 8);
#define PG8_SA(b, h) (((b) * 2 + (h)) * HTB)
#define PG8_SB(b, h) ((4 + (b) * 2 + (h)) * HTB)
#define PG8_STAGE(bufoff, gbase, voff) do { _Pragma("unroll") for (int _i = 0; _i < 2; ++_i) \
        __builtin_amdgcn_global_load_lds((const unsigned*)((const char*)(gbase) + (voff)[_i]), (LAS unsigned*)(lds + (bufoff) + ldsw + _i * 8192), 16, 0, 0); } while (0)
#define PG8_LDA(dst, b, h) do { _Pragma("unroll") for (int m = 0; m < 4; ++m) _Pragma("unroll") for (int k = 0; k < 2; ++k) dst[m][k] = *(const LAS bf16x8*)(lds + PG8_SA(b, h) + aoff + m * 2048 + k * 1024); } while (0)
#define PG8_LDB(dst, b, h) do { _Pragma("unroll") for (int n = 0; n < 2; ++n) _Pragma("unroll") for (int k = 0; k < 2; ++k) dst[n][k] = *(const LAS bf16x8*)(lds + PG8_SB(b, h) + boff + n * 2048 + k * 1024); } while (0)
#define PG8_MMA(ai, bj, At, Bt) do { __builtin_amdgcn_s_setprio(1); _Pragma("unroll") for (int m = 0; m < 4; ++m) _Pragma("unroll") for (int n = 0; n < 2; ++n) _Pragma("unroll") for (int k = 0; k < 2; ++k) \
        acc[ai][bj][m][n] = __builtin_amdgcn_mfma_f32_16x16x32_bf16(Bt[n][k], At[m][k], acc[ai][bj][m][n], 0, 0, 0); __builtin_amdgcn_s_setprio(0); } while (0)
#define PG8_WAIT_V(n) asm volatile("s_waitcnt vmcnt(" #n ")" ::: "memory")
#define PG8_WAIT_L(n) asm volatile("s_waitcnt lgkmcnt(" #n ")" ::: "memory")
#define PG8_BAR __builtin_amdgcn_s_barrier()
#define PG8_SCHED __builtin_amdgcn_sched_barrier(0)
    Unit cur, nxt; int ui = 0;
    if (!S.next(0, cur)) return;
    f32x4 acc[2][2][4][2];
#pragma unroll
    for (int a = 0; a < 2; ++a)
#pragma unroll
        for (int b = 0; b < 2; ++b)
#pragma unroll
            for (int m = 0; m < 4; ++m)
#pragma unroll
                for (int n = 0; n < 2; ++n) acc[a][b][m][n] = (f32x4){0.f, 0.f, 0.f, 0.f};
    bf16x8 At[4][2], B0[2][2], B1[2][2];
    const char* cA = (const char*)g.A + (size_t)cur.pm * tstep; const char* cB = (const char*)g.Bt + (size_t)cur.pn * tstep;
    S.a_ready(cur);
    if constexpr (SP2) {
        PG8_STAGE(PG8_SB(0, 0), cB, voffB); PG8_STAGE(PG8_SB(0, 1), cB + hstep, voffB); PG8_STAGE(PG8_SA(0, 0), cA, voffA); PG8_STAGE(PG8_SA(0, 1), cA + hstep, voffA);
        if (wr == 1) PG8_BAR;
        PG8_WAIT_V(2); PG8_BAR;
        PG8_STAGE(PG8_SB(1, 0), cB + kstep, voffB); PG8_STAGE(PG8_SA(1, 0), cA + kstep, voffA); PG8_STAGE(PG8_SB(1, 1), cB + hstep + kstep, voffB);
        PG8_WAIT_V(6); PG8_BAR;
    } else {
        PG8_STAGE(PG8_SB(0, 0), cB, voffB); PG8_STAGE(PG8_SA(0, 0), cA, voffA); PG8_STAGE(PG8_SB(0, 1), cB + hstep, voffB); PG8_STAGE(PG8_SA(0, 1), cA + hstep, voffA);
        if (wr == 1) PG8_BAR;
        PG8_WAIT_V(4); PG8_BAR;
        PG8_STAGE(PG8_SB(1, 0), cB + kstep, voffB); PG8_STAGE(PG8_SA(1, 0), cA + kstep, voffA); PG8_STAGE(PG8_SB(1, 1), cB + hstep + kstep, voffB);
        PG8_WAIT_V(6); PG8_BAR;
    }
    for (;;) {
        const bool has_next = S.next(ui + 1, nxt);
        const char* nA = has_next ? (const char*)g.A + (size_t)nxt.pm * tstep : cA; const char* nB = has_next ? (const char*)g.Bt + (size_t)nxt.pn * tstep : cB;
        for (int t = 0; t < nt; t += 2) {
            const bool last = (t == nt - 2);
            const char* a1 = cA + (size_t)(t + 1) * kstep;
            const char* a2 = last ? nA : cA + (size_t)(t + 2) * kstep; const char* b2 = last ? nB : cB + (size_t)(t + 2) * kstep;
            const char* a3 = a2 + kstep; const char* b3 = b2 + kstep;
            if (last && has_next) S.a_ready(nxt);
            if constexpr (SP2) {
            PG8_LDB(B0, 0, 0); PG8_LDB(B1, 0, 1); PG8_SCHED; PG8_LDA(At, 0, 0); PG8_STAGE(PG8_SA(1, 1), a1 + hstep, voffA);
            PG8_WAIT_V(8); PG8_WAIT_L(0); PG8_BAR; PG8_MMA(0, 0, At, B0); PG8_MMA(0, 1, At, B1); PG8_BAR; PG8_SCHED;
            PG8_LDA(At, 0, 1); PG8_STAGE(PG8_SB(0, 0), b2, voffB); PG8_STAGE(PG8_SB(0, 1), b2 + hstep, voffB); PG8_STAGE(PG8_SA(0, 0), a2, voffA);
            PG8_WAIT_V(8); PG8_WAIT_L(0); PG8_BAR; PG8_MMA(1, 0, At, B0); PG8_MMA(1, 1, At, B1); PG8_BAR; PG8_SCHED;
            PG8_LDB(B0, 1, 0); PG8_LDB(B1, 1, 1); PG8_SCHED; PG8_LDA(At, 1, 0); PG8_STAGE(PG8_SA(0, 1), a2 + hstep, voffA);
            PG8_WAIT_V(8); PG8_WAIT_L(0); PG8_BAR; PG8_MMA(0, 0, At, B0); PG8_MMA(0, 1, At, B1); PG8_BAR; PG8_SCHED;
            PG8_LDA(At, 1, 1); PG8_STAGE(PG8_SB(1, 0), b3, voffB); PG8_STAGE(PG8_SB(1, 1), b3 + hstep, voffB); PG8_STAGE(PG8_SA(1, 0), a3, voffA);
            PG8_WAIT_V(8); PG8_WAIT_L(0); PG8_BAR; PG8_MMA(1, 0, At, B0); PG8_MMA(1, 1, At, B1); PG8_BAR; PG8_SCHED;
            } else {
            PG8_LDB(B0, 0, 0); PG8_SCHED; PG8_LDA(At, 0, 0); PG8_STAGE(PG8_SA(1, 1), a1 + hstep, voffA);
            PG8_WAIT_L(8); PG8_BAR; PG8_WAIT_L(0); PG8_MMA(0, 0, At, B0); PG8_BAR; PG8_SCHED;
            PG8_LDB(B1, 0, 1); PG8_STAGE(PG8_SB(0, 0), b2, voffB);
            PG8_BAR; PG8_WAIT_L(0); PG8_MMA(0, 1, At, B1); PG8_BAR;
            PG8_LDA(At, 0, 1); PG8_STAGE(PG8_SA(0, 0), a2, voffA);
            PG8_BAR; PG8_WAIT_L(0); PG8_MMA(1, 0, At, B0); PG8_BAR; PG8_SCHED;
            PG8_STAGE(PG8_SB(0, 1), b2 + hstep, voffB);
            PG8_WAIT_V(6); PG8_BAR; PG8_MMA(1, 1, At, B1); PG8_BAR;
            PG8_LDB(B0, 1, 0); PG8_SCHED; PG8_LDA(At, 1, 0); PG8_STAGE(PG8_SA(0, 1), a2 + hstep, voffA);
            PG8_WAIT_L(8); PG8_BAR; PG8_WAIT_L(0); PG8_MMA(0, 0, At, B0); PG8_BAR; PG8_SCHED;
            PG8_LDB(B1, 1, 1); PG8_STAGE(PG8_SB(1, 0), b3, voffB);
            PG8_BAR; PG8_WAIT_L(0); PG8_MMA(0, 1, At, B1); PG8_BAR;
            PG8_LDA(At, 1, 1); PG8_STAGE(PG8_SA(1, 0), a3, voffA);
            PG8_BAR; PG8_WAIT_L(0); PG8_MMA(1, 0, At, B0); PG8_BAR; PG8_SCHED;
            PG8_STAGE(PG8_SB(1, 1), b3 + hstep, voffB);
            PG8_WAIT_V(6); PG8_BAR; PG8_MMA(1, 1, At, B1); PG8_BAR;
            }
        }
        if constexpr (ALIGN_EPI) { if (wr == 0) PG8_BAR; }
        if constexpr (!Epi::AFTER_DRAIN) { E(acc, cur, wr, wc, fr, fq); S.done(cur); }
        if (!has_next) break;
#pragma unroll
        for (int a = 0; a < 2; ++a)
#pragma unroll
            for (int b = 0; b < 2; ++b)
#pragma unroll
                for (int m = 0; m < 4; ++m)
#pragma unroll
                    for (int n = 0; n < 2; ++n) acc[a][b][m][n] = (f32x4){0.f, 0.f, 0.f, 0.f};
        cur = nxt; cA = nA; cB = nB; ++ui;
        if constexpr (ALIGN_EPI) { if (wr == 1) PG8_BAR; }
    }
    PG8_WAIT_V(0);
    if constexpr (!ALIGN_EPI) { if (wr == 0) PG8_BAR; }
    PG8_BAR;
    if constexpr (Epi::AFTER_DRAIN) { E.fused(acc, cur, wr, wc, fr, fq, lds, wid, lane); S.done(cur); }
#undef PG8_SA
#undef PG8_SB
#undef PG8_STAGE
#undef PG8_LDA
#undef PG8_LDB
#undef PG8_MMA
#undef PG8_WAIT_V
#undef PG8_WAIT_L
#undef PG8_BAR
#undef PG8_SCHED
}
}

#define XB_TMO      128
#define XB_XCNT(j)  (256  + 64 * (j))
#define XB_XSUB(j)  (1280 + 64 * (j))
#define XB_XGEN(j)  (2304 + 64 * (j))
#define XB_TOP      3328
#define XB_TOPGEN   3392
#define XCD_BAR_WORDS 3456
#define XB_SPIN_CAP (1u << 22)
__device__ __forceinline__ unsigned xb_ld(unsigned* p)              { return __hip_atomic_load(p, __ATOMIC_RELAXED, __HIP_MEMORY_SCOPE_AGENT); }
__device__ __forceinline__ unsigned xb_add(unsigned* p, unsigned v) { return __hip_atomic_fetch_add(p, v, __ATOMIC_RELAXED, __HIP_MEMORY_SCOPE_AGENT); }
__device__ __forceinline__ unsigned xb_xcc_id() { return (unsigned)__builtin_amdgcn_s_getreg((3 << 11) | 20) & 0xFu; }
#define XB_SPIN(cond, bar) do { unsigned _sp = 0; while (cond) { __builtin_amdgcn_s_sleep(1); \
    if ((++_sp & 255u) == 0u) { if (xb_ld(&(bar)[XB_TMO])) break; if (_sp > XB_SPIN_CAP) { atomicAdd(&(bar)[XB_TMO], 1u); break; } } } } while (0)
struct XcdBarrier { unsigned* bar; unsigned x; volatile LAS unsigned* st; };
__device__ __forceinline__ XcdBarrier xcd_barrier_post(unsigned* bar, volatile LAS unsigned* st) {
    XcdBarrier b; b.bar = bar; b.x = xb_xcc_id(); b.st = st;
    if (threadIdx.x == 0) (void)xb_add(&bar[XB_XCNT(b.x)], 1u);
    return b;
}
__device__ __forceinline__ void xcd_barrier_complete(unsigned* bar, unsigned x, unsigned& nloc, unsigned& nx) {
    const unsigned G = gridDim.x * gridDim.y * gridDim.z;
    unsigned sum, cnt, mine, sp = 0u;
    for (;;) {
        sum = 0u; cnt = 0u; mine = 0u;
#pragma unroll
        for (unsigned j = 0; j < 16; ++j) { const unsigned c = xb_ld(&bar[XB_XCNT(j)]); sum += c; cnt += (c > 0u) ? 1u : 0u; mine = (j == x) ? c : mine; }
        if (sum == G) break;
        __builtin_amdgcn_s_sleep(1);
        if ((++sp & 255u) == 0u) { if (xb_ld(&bar[XB_TMO])) break; if (sp > XB_SPIN_CAP) { atomicAdd(&bar[XB_TMO], 1u); break; } }
    }
    nloc = mine > 0u ? mine : 1u; nx = cnt > 0u ? cnt : 1u;
}
__device__ __forceinline__ void xcd_barrier(const XcdBarrier& b) {
    asm volatile("s_waitcnt vmcnt(0)" ::: "memory");
    __syncthreads();
    if (threadIdx.x == 0) {
        unsigned* bar = b.bar;
        __builtin_amdgcn_s_waitcnt(0);
        unsigned nloc = b.st[0], nx = b.st[1];
        if (nloc == 0u) { xcd_barrier_complete(bar, b.x, nloc, nx); b.st[0] = nloc; b.st[1] = nx; }
        const unsigned old = xb_add(&bar[XB_XSUB(b.x)], 1u);
        const unsigned gen = old / nloc;
        if (old + 1u == (gen + 1u) * nloc) {
            __builtin_amdgcn_fence(__ATOMIC_RELEASE, "agent");
            asm volatile("s_waitcnt vmcnt(0)" ::: "memory");
            const unsigned og = xb_add(&bar[XB_TOP], 1u);
            const unsigned tg = og / nx;
            if (og + 1u == (tg + 1u) * nx) xb_add(&bar[XB_TOPGEN], 1u);
            else XB_SPIN(xb_ld(&bar[XB_TOPGEN]) == tg, bar);
            __builtin_amdgcn_fence(__ATOMIC_ACQUIRE, "agent");
            xb_add(&bar[XB_XGEN(b.x)], 1u);
            asm volatile("s_waitcnt vmcnt(0)" ::: "memory");
        } else {
            XB_SPIN(xb_ld(&bar[XB_XGEN(b.x)]) == gen, bar);
            __builtin_amdgcn_fence(__ATOMIC_ACQUIRE, "agent");
            asm volatile("s_waitcnt vmcnt(0)" ::: "memory");
        }
    }
    __syncthreads();
}
#endif

constexpr int NPHASE = 11;
#ifndef GEMM_SP2
#define GEMM_SP2 true
#endif
#ifndef GEMM_ALIGN
#define GEMM_ALIGN true
#endif
#ifndef ONLY_MASK
#define ONLY_MASK 0xFFFFFFFFull
#endif
#define EN(k) if constexpr ((((unsigned long long)(ONLY_MASK)) >> (k)) & 1ull)
#ifndef HIPEMU
typedef XcdBarrier BarT;
#define SYNC() do { if (p.use_bar) xcd_barrier(bar); } while (0)
#else
typedef int BarT;
#define SYNC() do { } while (0)
#endif
#define IN(k) (p.ph_lo <= (k) && (k) < p.ph_hi)
template <int l> DI void layer_body(const Params& p, ldsp lds, const BarT& bar) {
        unsigned char* const ws_ = WSP();
        const float* xin = (l == 0) ? INP(I_X) : OUTP();
        if (IN(0)) {
#ifndef HIPEMU
            EN(0) { if (l == 0) { phase_mod(lds); SYNC(); } }
            const bool alt_first = ((blockIdx.x >> 3) & 1) != 0;
            if (alt_first) { if constexpr (l == 0) { EN(2) phase_hy_filt(l, lds); } else { EN(7) phase_hy_fftf(lds); } }
            if constexpr (l == 0) { EN(1) phase_wconv(l, lds); }
            EN(3) phase_norm(lds, xin, l, 0);
            if (!alt_first) { if constexpr (l == 0) { EN(2) phase_hy_filt(l, lds); } else { EN(7) phase_hy_fftf(lds); } }
#else
            EN(2) phase_hy_filt(l, lds);
#endif
            SYNC();
        }
#ifndef HIPEMU
        if (IN(2)) {
            EN(4) phase_gates(lds, l);
            EN(5) { pg8::Gemm g{(const bf16_t*)(ws_ + wset_off(l) + WS_WTIN), (const bf16_t*)(ws_ + WS_H), NHY, SEQ, 4096}; pg8::StaticOrder S; S.init(NHY, SEQ, gridDim.x, blockIdx.x);
              pg8::EpiStoreBf16 E{(bf16_t*)(ws_ + WS_UT), SEQ}; pg8::gemm_phase<decltype(E), pg8::StaticOrder, GEMM_ALIGN, GEMM_SP2>(lds, g, S, E); }
            EN(6) { pg8::Gemm g{(const bf16_t*)(ws_ + WS_H), (const bf16_t*)(ws_ + wset_off(l) + WS_WTIN) + (size_t)NHY * 4096, SEQ, NPROJ, 4096}; pg8::StaticOrder S; S.init(SEQ, NPROJ, gridDim.x, blockIdx.x);
              pg8::EpiStoreBf16 E{(bf16_t*)(ws_ + WS_PROJ), NPROJ}; pg8::gemm_phase<decltype(E), pg8::StaticOrder, GEMM_ALIGN, GEMM_SP2>(lds, g, S, E); }
            SYNC();
        }
#endif
        if (IN(3)) {
#ifndef HIPEMU
            const bool wc_first = ((blockIdx.x >> 3) & 1) != 0;
            if (wc_first) { if constexpr (l < 3) { EN(1) phase_wconv(l + 1, lds); } }
#endif
            if constexpr (l == 0) { EN(7) phase_hy_fftf(lds); } EN(8) phase_ret_kv(l, lds); EN(9) phase_ml_kv(l, lds); EN(10) phase_att(l, lds);
#ifndef HIPEMU
            if (!wc_first) { if constexpr (l < 3) { EN(1) phase_wconv(l + 1, lds); } }
#endif
            SYNC(); }
        if (IN(4)) {
            const bool conv_first = ((blockIdx.x >> 3) & 1) != 0;
            if (conv_first) { EN(14) phase_hy_conv(l, lds); }
            EN(11) phase_ret_scan(lds, l); EN(12) phase_ml_scan(lds); EN(13) phase_att_merge(lds);
            if (!conv_first) { EN(14) phase_hy_conv(l, lds); }
            SYNC(); }
        if (IN(5)) { EN(15) phase_ret_out(l, lds); EN(16) phase_ml_out(l, lds); EN(17) phase_hy_out(lds); SYNC(); }
#ifndef HIPEMU
        if (IN(7)) EN(19) {
            pg8::Gemm g{(const bf16_t*)(ws_ + WS_Y), (const bf16_t*)(ws_ + wset_off(l) + WS_WTOUT), SEQ, 4096, 4096}; pg8::StaticOrder S; S.init(SEQ, 4096, gridDim.x, blockIdx.x);
            pg8::EpiResid E{xin, OUTP(), (const float*)(ws_ + WS_MOD) + l * 24576 + 8192, 4096}; pg8::gemm_phase<decltype(E), pg8::StaticOrder, GEMM_ALIGN, GEMM_SP2>(lds, g, S, E);
            SYNC();
        }
        if (IN(8)) {
            const bool alt_first = ((blockIdx.x >> 3) & 1) != 0;
            if (alt_first) { if constexpr (l < 3) { EN(2) phase_hy_filt(l + 1, lds); } }
            EN(20) phase_norm(lds, OUTP(), l, 1);
            if (!alt_first) { if constexpr (l < 3) { EN(2) phase_hy_filt(l + 1, lds); } }
            SYNC(); }
        if (IN(9)) EN(21) {
            pg8::Gemm g{(const bf16_t*)(ws_ + WS_H), (const bf16_t*)(ws_ + wset_off(l) + WS_WT13), SEQ, 2 * FFN, 4096}; pg8::StaticOrder S; S.init(SEQ, 2 * FFN, gridDim.x, blockIdx.x);
            pg8::EpiSwiGLU E{(bf16_t*)(ws_ + WS_ACT), FFN}; pg8::gemm_phase<decltype(E), pg8::StaticOrder, GEMM_ALIGN, GEMM_SP2>(lds, g, S, E);
            SYNC();
        }
        if (IN(10)) EN(22) {
            pg8::Gemm g{(const bf16_t*)(ws_ + WS_ACT), (const bf16_t*)(ws_ + wset_off(l) + WS_WT2), SEQ, 4096, FFN}; pg8::StaticOrder S; S.init(SEQ, 4096, gridDim.x, blockIdx.x);
            pg8::EpiResid E{OUTP(), OUTP(), (const float*)(ws_ + WS_MOD) + l * 24576 + 20480, 4096}; pg8::gemm_phase<decltype(E), pg8::StaticOrder, GEMM_ALIGN, GEMM_SP2>(lds, g, S, E);
            SYNC();
        }
#endif
}
__global__ void __launch_bounds__(512, 2) mega(Params p) {
#ifndef HIPEMU
    extern __shared__ __attribute__((aligned(16))) unsigned char lds_raw[];
    ldsp lds = (ldsp)lds_raw;
    XcdBarrier bar; bar.bar = (unsigned*)(p.ws + WS_BAR); bar.x = 0; bar.st = nullptr;
    if (p.use_bar) {
        if (threadIdx.x == 0) { *(volatile LAS unsigned*)(lds + LDS_BARW) = 0u; *(volatile LAS unsigned*)(lds + LDS_BARW + 4) = 0u; }
        __syncthreads();
        bar = xcd_barrier_post((unsigned*)(p.ws + WS_BAR), (volatile LAS unsigned*)(lds + LDS_BARW));
    }
#else
    ldsp lds = emu_lds(); BarT bar = 0;
#endif
    if (threadIdx.x == 0) {
        LAS unsigned long long* pt = (LAS unsigned long long*)(lds + LDS_PTRS);
        pt[0] = (unsigned long long)p.in[0]; pt[1] = (unsigned long long)p.in[1]; pt[2] = (unsigned long long)p.in[2]; pt[3] = (unsigned long long)p.in[3]; pt[4] = (unsigned long long)p.in[4];
        pt[5] = (unsigned long long)p.in[5]; pt[6] = (unsigned long long)p.in[6]; pt[7] = (unsigned long long)p.in[7]; pt[8] = (unsigned long long)p.in[8]; pt[9] = (unsigned long long)p.in[9];
        pt[10] = (unsigned long long)p.in[10]; pt[11] = (unsigned long long)p.in[11]; pt[12] = (unsigned long long)p.in[12]; pt[13] = (unsigned long long)p.in[13]; pt[14] = (unsigned long long)p.in[14];
        pt[15] = (unsigned long long)p.in[15]; pt[16] = (unsigned long long)p.in[16]; pt[17] = (unsigned long long)p.in[17]; pt[18] = (unsigned long long)p.in[18]; pt[19] = (unsigned long long)p.in[19];
        pt[20] = (unsigned long long)p.in[20]; pt[21] = (unsigned long long)p.out; pt[22] = (unsigned long long)p.ws;
    }
    __syncthreads();
    if (0 >= p.lay_lo && 0 < p.lay_hi) layer_body<0>(p, lds, bar);
    if (1 >= p.lay_lo && 1 < p.lay_hi) layer_body<1>(p, lds, bar);
    if (2 >= p.lay_lo && 2 < p.lay_hi) layer_body<2>(p, lds, bar);
    if (3 >= p.lay_lo && 3 < p.lay_hi) layer_body<3>(p, lds, bar);
}
#undef IN
#undef SYNC


#ifndef HIPEMU
#ifndef MK_ONE_LAUNCH
#define MK_ONE_LAUNCH 1
#endif
extern "C" void kernel_launch(void* const* d_in, const int* in_sizes, int n_in, void* d_out, int out_size, void* d_ws, size_t ws_size, hipStream_t stream) {
    static int grid = 0;
    if (grid == 0) {
        if (n_in != 21 || out_size != SEQ * DM || ws_size < WS_END) { fprintf(stderr, "kernel_launch: unexpected shapes (n_in %d out %d ws %zu need %zu)\n", n_in, out_size, ws_size, (size_t)WS_END); grid = -1; return; }
        int dev = 0, cus = 0, per_cu = 0;
        if (hipGetDevice(&dev) != hipSuccess || hipDeviceGetAttribute(&cus, hipDeviceAttributeMultiprocessorCount, dev) != hipSuccess) { grid = -1; return; }
        if (hipFuncSetAttribute((const void*)mega, hipFuncAttributeMaxDynamicSharedMemorySize, LDS_BYTES) != hipSuccess) { fprintf(stderr, "kernel_launch: hipFuncSetAttribute failed\n"); grid = -1; return; }
        if (hipOccupancyMaxActiveBlocksPerMultiprocessor(&per_cu, (const void*)mega, 512, LDS_BYTES) != hipSuccess || per_cu < 1) { fprintf(stderr, "kernel_launch: occupancy query says %d\n", per_cu); (void)hipGetLastError(); }
        grid = cus;
    }
    if (grid < 0) return;
    Params p; memset(&p, 0, sizeof(p));
    for (int i = 0; i < 21; ++i) p.in[i] = (const float*)d_in[i];
    p.out = (float*)d_out; p.ws = (unsigned char*)d_ws;
#if MK_ONE_LAUNCH
    (void)hipMemsetAsync((char*)d_ws + WS_BAR, 0, 16384, stream);
    p.ph_lo = 0; p.ph_hi = NPHASE; p.lay_lo = 0; p.lay_hi = 4; p.use_bar = 1;
    hipLaunchKernelGGL(mega, dim3(grid), dim3(512), LDS_BYTES, stream, p);
#else
    for (int l = 0; l < 4; ++l)
        for (int ph = 0; ph < NPHASE; ++ph) { p.ph_lo = ph; p.ph_hi = ph + 1; p.lay_lo = l; p.lay_hi = l + 1; p.use_bar = 0; hipLaunchKernelGGL(mega, dim3(grid), dim3(512), LDS_BYTES, stream, p); }
#endif
}
#endif
```

```cpp
#ifndef HIPEMU
#include <hip/hip_runtime.h>
#endif
#include <cstdio>
#include <cstdint>
#include <cstring>
#include <cmath>

#ifndef HIPEMU
#define LAS __attribute__((address_space(3)))
#define GAS __attribute__((address_space(1)))
#else
#define LAS
#define GAS
#endif
#define DI __device__ __forceinline__

typedef unsigned short bf16_t;
typedef short bf16x8 __attribute__((ext_vector_type(8)));
typedef short s16x4 __attribute__((ext_vector_type(4)));
typedef float f32x4 __attribute__((ext_vector_type(4)));
typedef float f32x2 __attribute__((ext_vector_type(2)));
typedef unsigned u32x4 __attribute__((ext_vector_type(4)));
typedef unsigned u32x2 __attribute__((ext_vector_type(2)));
typedef LAS unsigned char* ldsp;

#ifdef EMU_SEQ
constexpr int SEQ = EMU_SEQ;
#else
constexpr int SEQ = 16384;
#endif
constexpr int DM = 4096, NPROJ = 9216, NHY = 3072, FFN = 11008, DIN = 12304;
constexpr int NCR = SEQ / 128;
constexpr int NCM = SEQ / 64;
constexpr int KFP = SEQ + 8;
constexpr int LOG4 = (SEQ == 16384) ? 7 : (SEQ == 4096) ? 6 : (SEQ == 1024) ? 5 : (SEQ == 256) ? 4 : -1;
static_assert(LOG4 > 0, "SEQ must be a power of 4");
constexpr float EPS = 1e-6f;
constexpr int PC_RQ = 0, PC_RK = 512, PC_RV = 1024, PC_RG = 2048, PC_AQ = 3072, PC_AK = 4096, PC_AV = 5120, PC_MQ = 6144, PC_MK = 6656, PC_MV = 7168, PC_MO = 8192;
enum { I_X = 0, I_C, I_ADAW, I_ADAB, I_ADAT, I_WIN, I_WOUT, I_HYS, I_HYW1, I_HYB1, I_HYW2, I_HYB2, I_HYW3, I_HYBIAS, I_RDEC, I_AGAIN, I_MGB, I_MNG, I_W1, I_W3, I_W2 };

constexpr size_t al256(size_t x) { return (x + 255) & ~(size_t)255; }
constexpr size_t WS_BAR = 0;
constexpr size_t WS_MOD = 16384;
constexpr size_t WS_G = WS_MOD + al256((size_t)4 * 24576 * 4);
constexpr size_t WS_WTG = WS_G + al256((size_t)SEQ * 16 * 4);
constexpr size_t WS_WTIN = WS_WTG + al256((size_t)16 * 4096 * 2);
constexpr size_t WS_WTOUT = WS_WTIN + al256((size_t)12288 * 4096 * 2);
constexpr size_t WS_WT13 = WS_WTOUT + al256((size_t)4096 * 4096 * 2);
constexpr size_t WS_WT2 = WS_WT13 + al256((size_t)22016 * 4096 * 2);
constexpr size_t WS_H = WS_WT2 + al256((size_t)4096 * 11008 * 2);
constexpr size_t WS_PROJ = WS_H + al256((size_t)SEQ * 4096 * 2);
constexpr size_t WS_UT = WS_PROJ + al256((size_t)SEQ * NPROJ * 2);
constexpr size_t WS_Y = WS_UT + al256((size_t)NHY * SEQ * 2);
constexpr size_t WS_ACT = WS_Y + al256((size_t)SEQ * 4096 * 2);
constexpr size_t WS_FILT = WS_ACT + al256((size_t)SEQ * FFN * 2);
constexpr size_t WS_KF = WS_FILT + al256((size_t)4096 * SEQ * 4);
constexpr size_t WS_Z1T = WS_KF + al256((size_t)2048 * KFP * 8);
constexpr size_t WS_Z2T = WS_Z1T + al256((size_t)1024 * SEQ * 4);
constexpr size_t WS_RKV = WS_Z2T + al256((size_t)1024 * SEQ * 4);
constexpr size_t WS_RST = WS_RKV + al256((size_t)8 * NCR * 32768 * 4);
constexpr size_t WS_OB = WS_RST + al256((size_t)8 * NCR * 32768 * 2);
constexpr size_t WS_LSE = WS_OB + al256((size_t)3 * SEQ * 1024 * 2);
constexpr size_t WS_MKV = WS_LSE + al256((size_t)3 * SEQ * 8 * 4);
constexpr size_t WS_MCT = WS_MKV + al256((size_t)8 * NCM * 32768 * 4);
constexpr size_t WS_KSUM = WS_MCT + al256((size_t)8 * NCM * 32768 * 2);
constexpr size_t WS_NPREV = WS_KSUM + al256((size_t)8 * NCM * 128 * 4);
constexpr size_t WS_MLOC = WS_NPREV + al256((size_t)8 * NCM * 128 * 4);
constexpr size_t WS_BLAST = WS_MLOC + al256((size_t)8 * NCM * 4);
constexpr size_t WS_MPREV = WS_BLAST + al256((size_t)8 * NCM * 4);
constexpr size_t WS_HDIR = WS_MPREV + al256((size_t)8 * NCM * 4);
constexpr size_t WS_RY = WS_HDIR + al256((size_t)2 * SEQ * 1024 * 4);
constexpr size_t WS_WSET2 = WS_RY + al256((size_t)SEQ * 1024 * 4);
constexpr size_t WS_WSET_BYTES = WS_H - WS_WTG;
constexpr size_t WS_END = WS_WSET2 + WS_WSET_BYTES;
constexpr size_t wset_off(int l) { return (l & 1) ? (WS_WSET2 - WS_WTG) : 0; }

constexpr int LDS_BYTES = 147456;
constexpr int LDS_BARW = LDS_BYTES - 16;
constexpr int LDS_PTRS = LDS_BARW - 256;

struct Params { const float* in[21]; float* out; unsigned char* ws; int ph_lo, ph_hi, lay_lo, lay_hi, use_bar, pad; };

DI bf16_t f2bf(float f) { unsigned u = __builtin_bit_cast(unsigned, f); u += 0x7FFFu + ((u >> 16) & 1u); return (bf16_t)(u >> 16); }
DI float bf2f(unsigned short b) { return __builtin_bit_cast(float, ((unsigned)b) << 16); }
DI unsigned pk2(float lo, float hi) {
#ifdef HIPEMU
    return (unsigned)f2bf(lo) | ((unsigned)f2bf(hi) << 16);
#else
    unsigned r; asm volatile("v_cvt_pk_bf16_f32 %0, %1, %2" : "=v"(r) : "v"(lo), "v"(hi)); return r;
#endif
}
DI f32x4 mfma16(bf16x8 a, bf16x8 b, f32x4 c) {
#ifdef HIPEMU
    return emu_mfma16(a, b, c);
#else
    return __builtin_amdgcn_mfma_f32_16x16x32_bf16(a, b, c, 0, 0, 0);
#endif
}
DI bf16x8 tr_read8(ldsp lds, unsigned off_a, unsigned off_b) {
#ifdef HIPEMU
    s16x4 lo = emu_tr_read(lds, off_a), hi = emu_tr_read(lds, off_b);
#else
    s16x4 lo, hi; const unsigned base = (unsigned)(uintptr_t)lds;
    asm volatile("ds_read_b64_tr_b16 %0, %2\n\tds_read_b64_tr_b16 %1, %3\n\ts_waitcnt lgkmcnt(0)" : "=&v"(lo), "=&v"(hi) : "v"(base + off_a), "v"(base + off_b) : "memory");
#endif
    return __builtin_shufflevector(lo, hi, 0, 1, 2, 3, 4, 5, 6, 7);
}
DI bf16x8 tr_frag(ldsp lds, unsigned tile_off, int pitch, int r0a, int r0b, int c0, int lr) {
    const int q = lr >> 2, pp = lr & 3;
    return tr_read8(lds, tile_off + (unsigned)((r0a + q) * pitch + (c0 + 4 * pp) * 2), tile_off + (unsigned)((r0b + q) * pitch + (c0 + 4 * pp) * 2));
}
struct TrF { s16x4 lo, hi; };
DI void tr_issue(ldsp lds, unsigned tile_off, int pitch, int r0a, int r0b, int c0, int lr, TrF& f) {
    const int q = lr >> 2, pp = lr & 3;
    const unsigned off_a = tile_off + (unsigned)((r0a + q) * pitch + (c0 + 4 * pp) * 2), off_b = tile_off + (unsigned)((r0b + q) * pitch + (c0 + 4 * pp) * 2);
#ifdef HIPEMU
    f.lo = emu_tr_read(lds, off_a); f.hi = emu_tr_read(lds, off_b);
#else
    const unsigned base = (unsigned)(uintptr_t)lds;
    asm volatile("ds_read_b64_tr_b16 %0, %2\n\tds_read_b64_tr_b16 %1, %3" : "=&v"(f.lo), "=&v"(f.hi) : "v"(base + off_a), "v"(base + off_b) : "memory");
#endif
}
DI void tr_wait2(TrF& a, TrF& b) {
#ifndef HIPEMU
    asm volatile("s_waitcnt lgkmcnt(0)" : "+v"(a.lo), "+v"(a.hi), "+v"(b.lo), "+v"(b.hi) :: "memory");
#endif
}
DI void tr_wait1(TrF& a) {
#ifndef HIPEMU
    asm volatile("s_waitcnt lgkmcnt(0)" : "+v"(a.lo), "+v"(a.hi) :: "memory");
#endif
}
DI bf16x8 tr_val(const TrF& f) { return __builtin_shufflevector(f.lo, f.hi, 0, 1, 2, 3, 4, 5, 6, 7); }
DI bf16x8 lds_row8(ldsp lds, unsigned off) { return *(const LAS bf16x8*)(lds + off); }
DI bf16x8 pack8(const f32x4& a, const f32x4& b) { u32x4 w; w.x = pk2(a[0], a[1]); w.y = pk2(a[2], a[3]); w.z = pk2(b[0], b[1]); w.w = pk2(b[2], b[3]); return __builtin_bit_cast(bf16x8, w); }
DI float wave_sum(float v) {
#pragma unroll
    for (int m = 32; m >= 1; m >>= 1) v += __shfl_xor(v, m);
    return v;
}
DI float wave_max(float v) {
#pragma unroll
    for (int m = 32; m >= 1; m >>= 1) v = fmaxf(v, __shfl_xor(v, m));
    return v;
}
DI float ld_xcu(const float* p) {
#ifdef HIPEMU
    return *p;
#else
    return __builtin_bit_cast(float, __hip_atomic_load((const unsigned*)p, __ATOMIC_RELAXED, __HIP_MEMORY_SCOPE_AGENT));
#endif
}
DI f32x2 ld_xcu2(const f32x2* p) {
#ifdef HIPEMU
    return *p;
#else
    return __builtin_bit_cast(f32x2, __hip_atomic_load((const unsigned long long*)p, __ATOMIC_RELAXED, __HIP_MEMORY_SCOPE_AGENT));
#endif
}
DI float fexp(float x) {
#ifdef HIPEMU
    return expf(x);
#else
    return __builtin_amdgcn_exp2f(x * 1.4426950408889634f);
#endif
}
DI float frcp(float x) {
#ifdef HIPEMU
    return 1.f / x;
#else
    return __builtin_amdgcn_rcpf(x);
#endif
}
DI float logsig(float x) { return x < 0.f ? x - log1pf(expf(x)) : -log1pf(expf(-x)); }
DI float sigm(float x) { return frcp(1.f + fexp(-x)); }
DI float dot4(const f32x4& a, const f32x4& b) { return a[0] * b[0] + a[1] * b[1] + a[2] * b[2] + a[3] * b[3]; }
DI f32x2 cmul(f32x2 a, f32x2 b) { f32x2 r; r.x = a.x * b.x - a.y * b.y; r.y = a.x * b.y + a.y * b.x; return r; }
DI f32x2 cmulc(f32x2 a, f32x2 b) { f32x2 r; r.x = a.x * b.x + a.y * b.y; r.y = a.y * b.x - a.x * b.y; return r; }
DI f32x2 cconj(f32x2 a) { f32x2 r; r.x = a.x; r.y = -a.y; return r; }
DI unsigned rev4(unsigned k) { const unsigned x = __builtin_bitreverse32(k) >> (32 - 2 * LOG4); return ((x & 0x55555555u) << 1) | ((x >> 1) & 0x55555555u); }

DI int opaque_tid() { int t = (int)threadIdx.x;
#ifndef HIPEMU
    asm volatile("" : "+v"(t));
#endif
    return t; }
#define TID (opaque_tid())
#ifdef HIPEMU
#define WAVE_SYNC() emu_wave_sync()
#else
#define WAVE_SYNC() __builtin_amdgcn_wave_barrier()
#endif
DI unsigned long long lds_ptr_bits(ldsp lds, int i) {
    const LAS unsigned* q = (const LAS unsigned*)(lds + LDS_PTRS + 8 * i); unsigned lo = q[0], hi = q[1];
#ifndef HIPEMU
    lo = __builtin_amdgcn_readfirstlane(lo); hi = __builtin_amdgcn_readfirstlane(hi);
#endif
    return ((unsigned long long)hi << 32) | lo;
}
#define INP(i) ((const float*)(GAS const float*)lds_ptr_bits(lds, (i)))
#define OUTP() ((float*)(GAS float*)lds_ptr_bits(lds, 21))
#define WSP() ((unsigned char*)(GAS unsigned char*)lds_ptr_bits(lds, 22))
DI unsigned char* opaque_ws(unsigned char* w) {
#ifndef HIPEMU
    asm volatile("" : "+s"(w));
#endif
    return w; }
#ifndef HIPEMU
#define MEMFENCE() asm volatile("" ::: "memory")
#else
#define MEMFENCE() do { } while (0)
#endif

DI void phase_mod(ldsp lds) {
    unsigned char* const ws_ = WSP();
    const float* c = INP(I_C); const float* ada_w = INP(I_ADAW); const float* ada_b = INP(I_ADAB); const float* ada_t = INP(I_ADAT);
    float* mod = (float*)(ws_ + WS_MOD);
    LAS float* sc = (LAS float*)lds; LAS float* red = sc + 4096;
    const int tid = TID;
    for (int i = tid; i < 4096; i += 512) { const float v = c[i]; sc[i] = v / (1.f + expf(-v)); }
    __syncthreads();
    for (int cb = blockIdx.x; cb < 256; cb += gridDim.x) {
        const int cv = tid % 24, ks = tid / 24;
        if (ks < 21) {
            f32x4 acc = {0.f, 0.f, 0.f, 0.f};
            for (int k = ks; k < 4096; k += 21) { const f32x4 w = *(const f32x4*)(ada_w + (size_t)k * 24576 + cb * 96 + 4 * cv); acc += w * sc[k]; }
#pragma unroll
            for (int j = 0; j < 4; ++j) red[ks * 96 + 4 * cv + j] = acc[j];
        }
        __syncthreads();
        if (tid < 96) {
            float s = 0.f;
            for (int k = 0; k < 21; ++k) s += red[k * 96 + tid];
            const int j = cb * 96 + tid; s += ada_b[j];
            for (int l = 0; l < 4; ++l) mod[l * 24576 + j] = s + ada_t[l * 24576 + j];
        }
        __syncthreads();
    }
}

template <class RowMap>
DI void wconv_tile(const float* src, int ldn, int K, int kt, int nt4, bf16_t* dst, RowMap rm, ldsp lds, int tid) {
    LAS float* T = (LAS float*)lds;
    const int k0 = kt * 64, n0 = nt4 * 256;
    f32x4 v[8];
#pragma unroll
    for (int i = 0; i < 8; ++i) { const int idx = tid + 512 * i, k = idx >> 6, n4 = idx & 63; v[i] = __builtin_nontemporal_load((const f32x4*)(src + (size_t)(k0 + k) * ldn + n0 + 4 * n4)); }
#pragma unroll
    for (int i = 0; i < 8; ++i) { const int idx = tid + 512 * i, k = idx >> 6, n4 = idx & 63;
#pragma unroll
        for (int j = 0; j < 4; ++j) T[(4 * n4 + j) * 65 + k] = v[i][j]; }
    __syncthreads();
#pragma unroll
    for (int i = 0; i < 4; ++i) {
        const int ch = tid + 512 * i, n = ch >> 3, kc = ch & 7; u32x4 o;
        o.x = pk2(T[n * 65 + 8 * kc + 0], T[n * 65 + 8 * kc + 1]); o.y = pk2(T[n * 65 + 8 * kc + 2], T[n * 65 + 8 * kc + 3]);
        o.z = pk2(T[n * 65 + 8 * kc + 4], T[n * 65 + 8 * kc + 5]); o.w = pk2(T[n * 65 + 8 * kc + 6], T[n * 65 + 8 * kc + 7]);
        *(u32x4*)(dst + (size_t)rm(n0 + n) * K + k0 + 8 * kc) = o;
    }
    __syncthreads();
}
DI void phase_wconv(int l, ldsp lds) {
    unsigned char* const ws_ = WSP();
    const float* w_in = INP(I_WIN) + (size_t)l * 4096 * DIN; const float* w_out = INP(I_WOUT) + (size_t)l * 4096 * 4096;
    const float* w1 = INP(I_W1) + (size_t)l * 4096 * FFN; const float* w3 = INP(I_W3) + (size_t)l * 4096 * FFN; const float* w2 = INP(I_W2) + (size_t)l * FFN * 4096;
    unsigned char* const wb_ = ws_ + wset_off(l);
    bf16_t* wt_in = (bf16_t*)(wb_ + WS_WTIN); bf16_t* wt_out = (bf16_t*)(wb_ + WS_WTOUT); bf16_t* wt13 = (bf16_t*)(wb_ + WS_WT13); bf16_t* wt2 = (bf16_t*)(wb_ + WS_WT2);
    bf16_t* wtg = (bf16_t*)(wb_ + WS_WTG);
    const int tid = TID;
    constexpr int T_IN = 64 * 48, T_OUT = 64 * 16, T_1 = 64 * 43, T_2 = 172 * 16, T_ALL = T_IN + T_OUT + 2 * T_1 + T_2;
    for (int t = blockIdx.x; t < T_ALL; t += gridDim.x) {
        if (t < T_IN) wconv_tile(w_in, DIN, 4096, t / 48, t % 48, wt_in, [](int n) { return n; }, lds, tid);
        else if (t < T_IN + T_OUT) { const int q = t - T_IN; wconv_tile(w_out, 4096, 4096, q / 16, q % 16, wt_out, [](int n) { return n; }, lds, tid); }
        else if (t < T_IN + T_OUT + T_1) { const int q = t - T_IN - T_OUT; wconv_tile(w1, FFN, 4096, q / 43, q % 43, wt13, [](int n) { return (n >> 7) * 256 + (n & 127); }, lds, tid); }
        else if (t < T_IN + T_OUT + 2 * T_1) { const int q = t - T_IN - T_OUT - T_1; wconv_tile(w3, FFN, 4096, q / 43, q % 43, wt13, [](int n) { return (n >> 7) * 256 + 128 + (n & 127); }, lds, tid); }
        else { const int q = t - T_IN - T_OUT - 2 * T_1; wconv_tile(w2, 4096, FFN, q / 16, q % 16, wt2, [](int n) { return n; }, lds, tid); }
    }
    for (int idx = blockIdx.x * 512 + tid; idx < 65536; idx += gridDim.x * 512) { const int k = idx >> 4, n = idx & 15; wtg[n * 4096 + k] = f2bf(w_in[(size_t)k * DIN + 12288 + n]); }
}

DI void phase_norm(ldsp lds, const float* xin, int l, int which) {
    unsigned char* const ws_ = WSP();
    const float* mod = (const float*)(ws_ + WS_MOD) + l * 24576; const float* sh = mod + which * 12288; const float* scv = mod + 4096 + which * 12288;
    bf16_t* H = (bf16_t*)(ws_ + WS_H);
    const int tid_ = TID; const int lane = tid_ & 63, wave = tid_ >> 6;
    for (int row = (blockIdx.x * 8 + wave) * 2; row < SEQ; row += gridDim.x * 16) {
        const float* xr = xin + (size_t)row * 4096; f32x4 v[2][16]; float ss0 = 0.f, ss1 = 0.f;
#pragma unroll
        for (int i = 0; i < 16; ++i) { v[0][i] = *(const f32x4*)(xr + 4 * (lane + 64 * i)); v[1][i] = *(const f32x4*)(xr + 4096 + 4 * (lane + 64 * i)); }
#pragma unroll
        for (int i = 0; i < 16; ++i) { ss0 += dot4(v[0][i], v[0][i]); ss1 += dot4(v[1][i], v[1][i]); }
        ss0 = wave_sum(ss0); ss1 = wave_sum(ss1);
        const float r0 = rsqrtf(ss0 * (1.f / 4096.f) + EPS), r1 = rsqrtf(ss1 * (1.f / 4096.f) + EPS);
#pragma unroll
        for (int i = 0; i < 16; ++i) {
            const int cc = 4 * (lane + 64 * i); const f32x4 s1 = *(const f32x4*)(scv + cc) + 1.f, s0 = *(const f32x4*)(sh + cc);
            const f32x4 o0 = v[0][i] * r0 * s1 + s0, o1 = v[1][i] * r1 * s1 + s0; u32x2 w0, w1; w0.x = pk2(o0[0], o0[1]); w0.y = pk2(o0[2], o0[3]); w1.x = pk2(o1[0], o1[1]); w1.y = pk2(o1[2], o1[3]);
            *(u32x2*)(H + (size_t)row * 4096 + cc) = w0; *(u32x2*)(H + (size_t)(row + 1) * 4096 + cc) = w1;
            if ((i & 3) == 3) MEMFENCE();
        }
    }
}

DI void phase_gates(ldsp lds, int l) {
    unsigned char* const ws_ = WSP();
    const bf16_t* H = (const bf16_t*)(ws_ + WS_H); const bf16_t* WG = (const bf16_t*)(ws_ + wset_off(l) + WS_WTG); float* G = (float*)(ws_ + WS_G);
    LAS float* red = (LAS float*)lds;
    const int tid = TID, lane = tid & 63, wave = tid >> 6, lr = lane & 15, lg = lane >> 4;
    for (int tile = blockIdx.x; tile < SEQ / 16; tile += gridDim.x) {
        f32x4 acc = {0.f, 0.f, 0.f, 0.f};
        const bf16_t* arow = H + (size_t)(tile * 16 + lr) * 4096 + wave * 512 + 8 * lg; const bf16_t* brow = WG + (size_t)lr * 4096 + wave * 512 + 8 * lg;
#pragma unroll 4
        for (int ks = 0; ks < 16; ++ks) { const bf16x8 a = *(const bf16x8*)(arow + 32 * ks); const bf16x8 b = *(const bf16x8*)(brow + 32 * ks); acc = mfma16(a, b, acc); }
#pragma unroll
        for (int r = 0; r < 4; ++r) red[wave * 256 + (4 * lg + r) * 16 + lr] = acc[r];
        __syncthreads();
        if (tid < 256) { float s = 0.f; for (int w = 0; w < 8; ++w) s += red[w * 256 + tid]; G[(size_t)tile * 256 + tid] = s; }
        __syncthreads();
    }
}

DI void phase_hy_filt(int l, ldsp lds) {
    unsigned char* const ws_ = WSP();
    const float* w1 = INP(I_HYW1) + l * 33 * 64; const float* b1 = INP(I_HYB1) + l * 64; const float* w2 = INP(I_HYW2) + l * 2 * 4096; const float* b2 = INP(I_HYB2) + l * 128;
    const float* w3 = INP(I_HYW3) + (size_t)l * 64 * 4096; float* FILT = (float*)(ws_ + WS_FILT);
    LAS float* z = (LAS float*)lds; LAS float* ha = z + 64 * 36; LAS float* hb = ha + 4096;
    const int tid = TID;
    const float min_decay = -4.605170185988091f / 1.5f, max_decay = -4.605170185988091f / 0.3f;
    for (int tt = blockIdx.x; tt < SEQ / 64; tt += gridDim.x) {
        const int tau0 = tt * 64;
        for (int idx = tid; idx < 64 * 33; idx += 512) {
            const int r = idx / 33, f = idx % 33, tau = tau0 + r; float val;
            if (f == 0) val = (float)tau / (float)(SEQ - 1);
            else { const int b = (f - 1) & 15; const float fr = 1e-4f + (float)b * ((15.f - 1e-4f) / 15.f); const float a = ((6.283185307179586f / (float)SEQ) * (float)tau) * fr; val = (f <= 16) ? cosf(a) : -sinf(a); }
            z[r * 36 + f] = val;
        }
        __syncthreads();
        for (int idx = tid; idx < 4096; idx += 512) { const int r = idx >> 6, o = idx & 63; float s = b1[o]; for (int f = 0; f < 33; ++f) s += z[r * 36 + f] * w1[f * 64 + o]; ha[r * 64 + o] = sinf(s); }
        __syncthreads();
        for (int idx = tid; idx < 4096; idx += 512) { const int r = idx >> 6, o = idx & 63; float s = b2[o]; for (int i = 0; i < 64; ++i) s += ha[r * 64 + i] * w2[i * 64 + o]; hb[r * 64 + o] = sinf(s); }
        __syncthreads();
        for (int idx = tid; idx < 4096; idx += 512) { const int r = idx >> 6, o = idx & 63; float s = b2[64 + o]; for (int i = 0; i < 64; ++i) s += hb[r * 64 + i] * w2[4096 + i * 64 + o]; ha[r * 64 + o] = sinf(s); }
        __syncthreads();
        {
            const int lane = tid & 63, wave = tid >> 6, lr = lane & 15, lg = lane >> 4;
            bf16x8 ahi[4][2], alo[4][2];
#pragma unroll
            for (int tt = 0; tt < 4; ++tt)
#pragma unroll
                for (int ks = 0; ks < 2; ++ks) {
                    const f32x4 x0 = *(const LAS f32x4*)(ha + (16 * tt + lr) * 64 + 32 * ks + 8 * lg), x1 = *(const LAS f32x4*)(ha + (16 * tt + lr) * 64 + 32 * ks + 8 * lg + 4);
                    f32x4 h0, h1, l0, l1;
#pragma unroll
                    for (int e = 0; e < 4; ++e) { h0[e] = bf2f(f2bf(x0[e])); h1[e] = bf2f(f2bf(x1[e])); l0[e] = x0[e] - h0[e]; l1[e] = x1[e] - h1[e]; }
                    ahi[tt][ks] = pack8(h0, h1); alo[tt][ks] = pack8(l0, l1);
                }
            f32x4 wn[2][2];
#pragma unroll
            for (int ks = 0; ks < 2; ++ks)
#pragma unroll
                for (int e = 0; e < 4; ++e) { wn[ks][0][e] = w3[(size_t)(32 * ks + 8 * lg + e) * 4096 + 16 * wave + lr]; wn[ks][1][e] = w3[(size_t)(32 * ks + 8 * lg + 4 + e) * 4096 + 16 * wave + lr]; }
#pragma unroll 1
            for (int ct = wave; ct < 256; ct += 8) {
                const int j = 16 * ct + lr, c = j & 1023;
                bf16x8 bhi[2], blo[2];
#pragma unroll
                for (int ks = 0; ks < 2; ++ks) {
                    const f32x4 x0 = wn[ks][0], x1 = wn[ks][1]; f32x4 h0, h1, l0, l1;
#pragma unroll
                    for (int e = 0; e < 4; ++e) { h0[e] = bf2f(f2bf(x0[e])); h1[e] = bf2f(f2bf(x1[e])); l0[e] = x0[e] - h0[e]; l1[e] = x1[e] - h1[e]; }
                    bhi[ks] = pack8(h0, h1); blo[ks] = pack8(l0, l1);
                }
                { const int jn = 16 * ((ct + 8 < 256) ? ct + 8 : ct) + lr;
#pragma unroll
                  for (int ks = 0; ks < 2; ++ks)
#pragma unroll
                      for (int e = 0; e < 4; ++e) { wn[ks][0][e] = w3[(size_t)(32 * ks + 8 * lg + e) * 4096 + jn]; wn[ks][1][e] = w3[(size_t)(32 * ks + 8 * lg + 4 + e) * 4096 + jn]; } }
                const float delta = fabsf(min_decay + (float)c * ((max_decay - min_decay) / 1023.f));
                LAS float* tw_ = hb + 4096 + wave * 1088;
#pragma unroll
                for (int tt = 0; tt < 4; ++tt) {
                    f32x4 acc = {0.f, 0.f, 0.f, 0.f};
#pragma unroll
                    for (int ks = 0; ks < 2; ++ks) { acc = mfma16(ahi[tt][ks], bhi[ks], acc); acc = mfma16(ahi[tt][ks], blo[ks], acc); acc = mfma16(alo[tt][ks], bhi[ks], acc); }
                    f32x4 o;
#pragma unroll
                    for (int r = 0; r < 4; ++r) { const float t = (float)(tau0 + 16 * tt + 4 * lg + r) / (float)(SEQ - 1); o[r] = acc[r] * fexp(-t * delta); }
                    *(LAS f32x4*)(tw_ + lr * 68 + 16 * tt + 4 * lg) = o;
                }
                WAVE_SYNC();
#pragma unroll
                for (int jj = 0; jj < 4; ++jj) {
                    const int col = 4 * jj + (lane >> 4), q4 = lane & 15;
                    const f32x4 o = *(const LAS f32x4*)(tw_ + col * 68 + 4 * q4);
                    *(f32x4*)(FILT + (size_t)(16 * ct + col) * SEQ + tau0 + 4 * q4) = o;
                }
                WAVE_SYNC();
            }
        }
        __syncthreads();
    }
}

constexpr int FFT_PADN = SEQ + (SEQ >> 6) * 4;
constexpr int FFT_X = 0, FFT_T1 = FFT_PADN * 8, FFT_T2 = FFT_T1 + 1024, FFT_SCR = FFT_T2 + 1024;
static_assert(FFT_SCR + 256 <= LDS_PTRS, "fft lds");
DI int fpad(int i) { return i + ((i >> 6) << 2); }
DI void fft_tables(ldsp lds) {
    LAS f32x2* T1 = (LAS f32x2*)(lds + FFT_T1); LAS f32x2* T2 = (LAS f32x2*)(lds + FFT_T2);
    const int tid = TID;
    if (tid < 128) { const double a = -6.283185307179586476925 * (double)((tid * 128) % SEQ) / (double)SEQ; f32x2 v; v.x = (float)cos(a); v.y = (float)sin(a); T1[tid] = v; }
    else if (tid < 256) { const double a = -6.283185307179586476925 * (double)(tid - 128) / (double)SEQ; f32x2 v; v.x = (float)cos(a); v.y = (float)sin(a); T2[tid - 128] = v; }
    __syncthreads();
}
DI f32x2 fft_tw(ldsp lds, int ti) { const LAS f32x2* T1 = (const LAS f32x2*)(lds + FFT_T1); const LAS f32x2* T2 = (const LAS f32x2*)(lds + FFT_T2); return cmul(T1[ti >> 7], T2[ti & 127]); }
DI void r4_fwd(f32x2& x0, f32x2& x1, f32x2& x2, f32x2& x3) {
    const f32x2 t0 = x0 + x2, t1 = x0 - x2, t2 = x1 + x3, d = x1 - x3; f32x2 t3; t3.x = d.y; t3.y = -d.x;
    x0 = t0 + t2; x1 = t1 + t3; x2 = t0 - t2; x3 = t1 - t3;
}
DI void r4_inv(f32x2& x0, f32x2& x1, f32x2& x2, f32x2& x3) {
    const f32x2 t0 = x0 + x2, t1 = x0 - x2, t2 = x1 + x3, d = x1 - x3; f32x2 t3; t3.x = -d.y; t3.y = d.x;
    x0 = t0 + t2; x1 = t1 + t3; x2 = t0 - t2; x3 = t1 - t3;
}
DI f32x2 w16c(int a) { f32x2 r; r.x = (a == 0) ? 1.f : (a == 1) ? 0.92387953251128674f : (a == 2) ? 0.70710678118654752f : 0.38268343236508977f;
    r.y = (a == 0) ? 0.f : (a == 1) ? -0.38268343236508977f : (a == 2) ? -0.70710678118654752f : -0.92387953251128674f; return r; }
template <int M, bool INV> DI void fft_r16(ldsp lds, int tid) {
    LAS f32x2* X = (LAS f32x2*)(lds + FFT_X);
    constexpr int Q4 = M / 16, QQ = M / 4;
    for (int u = tid; u < SEQ / 16; u += 512) {
        const int jp = u & (Q4 - 1), b = (u / Q4) * M + jp;
        constexpr int PA = (Q4 >= 64) ? (Q4 / 64) * 68 : Q4, PC = (QQ >= 64) ? (QQ / 64) * 68 : QQ;
        constexpr bool LIN = (M >= 1024 || M <= 64);
        LAS f32x2* Xb = X + fpad(b);
        f32x2 e[4][4];
#pragma unroll
        for (int c = 0; c < 4; ++c)
#pragma unroll
            for (int a = 0; a < 4; ++a) e[c][a] = LIN ? Xb[a * PA + c * PC] : X[fpad(b + a * Q4 + c * QQ)];
        const f32x2 w0 = fft_tw(lds, jp * (SEQ / M)); const f32x2 wb = fft_tw(lds, jp * (4 * (SEQ / M)));
        const f32x2 wb2 = cmul(wb, wb), wb3 = cmul(wb2, wb);
        if (!INV) {
#pragma unroll
            for (int a = 0; a < 4; ++a) {
                r4_fwd(e[0][a], e[1][a], e[2][a], e[3][a]);
                const f32x2 wa = cmul(w0, w16c(a)), wa2 = cmul(wa, wa), wa3 = cmul(wa2, wa);
                e[1][a] = cmul(e[1][a], wa); e[2][a] = cmul(e[2][a], wa2); e[3][a] = cmul(e[3][a], wa3);
            }
#pragma unroll
            for (int c = 0; c < 4; ++c) { r4_fwd(e[c][0], e[c][1], e[c][2], e[c][3]); e[c][1] = cmul(e[c][1], wb); e[c][2] = cmul(e[c][2], wb2); e[c][3] = cmul(e[c][3], wb3); }
        } else {
#pragma unroll
            for (int c = 0; c < 4; ++c) { e[c][1] = cmulc(e[c][1], wb); e[c][2] = cmulc(e[c][2], wb2); e[c][3] = cmulc(e[c][3], wb3); r4_inv(e[c][0], e[c][1], e[c][2], e[c][3]); }
#pragma unroll
            for (int a = 0; a < 4; ++a) {
                const f32x2 wa = cmul(w0, w16c(a)), wa2 = cmul(wa, wa), wa3 = cmul(wa2, wa);
                e[1][a] = cmulc(e[1][a], wa); e[2][a] = cmulc(e[2][a], wa2); e[3][a] = cmulc(e[3][a], wa3);
                r4_inv(e[0][a], e[1][a], e[2][a], e[3][a]);
            }
        }
#pragma unroll
        for (int c = 0; c < 4; ++c)
#pragma unroll
            for (int a = 0; a < 4; ++a) { if (LIN) Xb[a * PA + c * PC] = e[c][a]; else X[fpad(b + a * Q4 + c * QQ)] = e[c][a]; }
    }
    __syncthreads();
}
template <bool INV> DI void fft_r4_last(ldsp lds, int tid) {
    LAS f32x2* X = (LAS f32x2*)(lds + FFT_X);
    for (int u = tid; u < SEQ / 4; u += 512) {
        LAS f32x4* q = (LAS f32x4*)(X + fpad(4 * u)); const f32x4 lo = q[0], hi = q[1];
        f32x2 x0, x1, x2, x3; x0.x = lo[0]; x0.y = lo[1]; x1.x = lo[2]; x1.y = lo[3]; x2.x = hi[0]; x2.y = hi[1]; x3.x = hi[2]; x3.y = hi[3];
        if (!INV) r4_fwd(x0, x1, x2, x3); else r4_inv(x0, x1, x2, x3);
        f32x4 o0, o1; o0[0] = x0.x; o0[1] = x0.y; o0[2] = x1.x; o0[3] = x1.y; o1[0] = x2.x; o1[1] = x2.y; o1[2] = x3.x; o1[3] = x3.y; q[0] = o0; q[1] = o1;
    }
    __syncthreads();
}
DI void fft_dif(ldsp lds, int tid) {
    if constexpr (LOG4 >= 2) fft_r16<SEQ, false>(lds, tid);
    if constexpr (LOG4 >= 4) fft_r16<SEQ / 16, false>(lds, tid);
    if constexpr (LOG4 >= 6) fft_r16<SEQ / 256, false>(lds, tid);
    if constexpr (LOG4 & 1) fft_r4_last<false>(lds, tid);
}
DI void fft_dit_inv(ldsp lds, int tid) {
    if constexpr (LOG4 & 1) fft_r4_last<true>(lds, tid);
    if constexpr (LOG4 >= 6) fft_r16<SEQ / 256, true>(lds, tid);
    if constexpr (LOG4 >= 4) fft_r16<SEQ / 16, true>(lds, tid);
    if constexpr (LOG4 >= 2) fft_r16<SEQ, true>(lds, tid);
}
DI f32x2 fft_halfroot(ldsp lds, int k) { f32x2 w = fft_tw(lds, k >> 1); if (k & 1) { f32x2 h; h.x = (float)cos(3.14159265358979323846 / (double)SEQ); h.y = -(float)sin(3.14159265358979323846 / (double)SEQ); w = cmul(w, h); } return w; }

DI void phase_hy_fftf(ldsp lds) {
    unsigned char* const ws_ = WSP();
    const float* FILT = (const float*)(ws_ + WS_FILT); f32x2* KF = (f32x2*)(ws_ + WS_KF);
    LAS f32x2* X = (LAS f32x2*)(lds + FFT_X); LAS float* scr = (LAS float*)(lds + FFT_SCR);
    const int tid = TID, lane = tid & 63, wave = tid >> 6;
    fft_tables(lds);
    for (int u = blockIdx.x; u < 2048; u += gridDim.x) {
        const int o = u >> 10, c = u & 1023;
        const float* fwd = FILT + (size_t)(o * 2048 + c) * SEQ; const float* bwd = FILT + (size_t)(o * 2048 + 1024 + c) * SEQ;
        float asum = 0.f;
        {
            constexpr int NVF = (SEQ / 4 + 511) / 512;
            f32x4 lo[NVF], hi[NVF]; float a0[NVF];
#pragma unroll
            for (int jv = 0; jv < NVF; ++jv) {
                const int v = tid + 512 * jv, n = 8 * v; lo[jv] = (f32x4){0.f, 0.f, 0.f, 0.f}; hi[jv] = lo[jv]; a0[jv] = 0.f;
                if (v < SEQ / 4) {
                    if (n < SEQ) { lo[jv] = *(const f32x4*)(fwd + n); hi[jv] = *(const f32x4*)(fwd + n + 4); }
                    else { const float* blk = bwd + (2 * SEQ - n - 8); lo[jv] = *(const f32x4*)blk; hi[jv] = *(const f32x4*)(blk + 4); a0[jv] = (n == SEQ) ? 0.f : bwd[2 * SEQ - n]; }
                }
            }
#pragma unroll
            for (int jv = 0; jv < NVF; ++jv) {
                const int v = tid + 512 * jv, n = 8 * v;
                if (v < SEQ / 4) {
                    f32x4 l2 = lo[jv], h2 = hi[jv];
                    if (n >= SEQ) { const f32x4 b0 = lo[jv], b1 = hi[jv]; l2[0] = a0[jv]; l2[1] = b1[3]; l2[2] = b1[2]; l2[3] = b1[1]; h2[0] = b1[0]; h2[1] = b0[3]; h2[2] = b0[2]; h2[3] = b0[1]; }
                    LAS f32x4* q = (LAS f32x4*)(X + fpad(4 * v)); q[0] = l2; q[1] = h2;
                    asum += fabsf(l2[0]) + fabsf(l2[1]) + fabsf(l2[2]) + fabsf(l2[3]) + fabsf(h2[0]) + fabsf(h2[1]) + fabsf(h2[2]) + fabsf(h2[3]);
                }
            }
        }
        asum = wave_sum(asum);
        if (lane == 0) scr[wave] = asum;
        __syncthreads();
        float tot = 0.f;
        for (int w = 0; w < 8; ++w) tot += scr[w];
        const float inv = 1.f / tot;
        fft_dif(lds, tid);
        f32x4* kfp = (f32x4*)(KF + (size_t)u * KFP);
        for (int j = tid; j < SEQ / 2; j += 512) {
            const int p = 4 * (j >> 1) + (j & 1), k = (int)rev4((unsigned)p); f32x4 o;
            if (k == 0) { const f32x2 c0 = X[0]; o[0] = (c0.x + c0.y) * inv; o[1] = 0.f; o[2] = (c0.x - c0.y) * inv; o[3] = 0.f; }
            else {
                const int k2 = SEQ - k; const f32x2 ck = X[fpad(p)], ck2 = X[fpad(rev4(k2))];
                f32x2 E, O; E.x = 0.5f * (ck.x + ck2.x); E.y = 0.5f * (ck.y - ck2.y);
                const float dx = ck.x - ck2.x, dy = ck.y + ck2.y; O.x = 0.5f * dy; O.y = -0.5f * dx;
                const f32x2 wO = cmul(fft_halfroot(lds, k), O);
                const f32x2 ak = E + wO, ak2 = cconj(E - wO);
                o[0] = ak.x * inv; o[1] = ak.y * inv; o[2] = ak2.x * inv; o[3] = ak2.y * inv;
            }
            kfp[j] = o;
        }
        if (tid == 0) { const f32x2 ck = X[fpad(rev4(SEQ / 2))]; f32x4 o; o[0] = ck.x * inv; o[1] = -ck.y * inv; o[2] = 0.f; o[3] = 0.f; kfp[SEQ / 2] = o; }
        __syncthreads();
    }
}

DI void hy_conv3_vec(const bf16_t* ur, const float* hs, int ch, int v, float (&out)[8]) {
    const float w0 = hs[ch], w1 = hs[3072 + ch], w2 = hs[6144 + ch];
    const bf16x8 xv = *(const bf16x8*)(ur + 8 * v);
    const float xp = (v > 0) ? bf2f(ur[8 * v - 1]) : 0.f, xn = (8 * v + 8 < SEQ) ? bf2f(ur[8 * v + 8]) : 0.f;
    float x[10]; x[0] = xp; x[9] = xn;
#pragma unroll
    for (int i = 0; i < 8; ++i) x[i + 1] = bf2f((unsigned short)xv[i]);
#pragma unroll
    for (int i = 0; i < 8; ++i) out[i] = w0 * x[i] + w1 * x[i + 1] + w2 * x[i + 2];
}
DI void hy_kfload4(const f32x4* kfp, int jbase, f32x4 (&fp)[4]) {
#pragma unroll
    for (int i = 0; i < 4; ++i) { const int j = jbase + 512 * i; fp[i] = kfp[j < SEQ / 2 ? j : 0]; }
}
DI void hy_pointwise4(ldsp lds, int jbase, const f32x4 (&fp)[4]) {
    LAS f32x2* X = (LAS f32x2*)(lds + FFT_X);
#pragma unroll
    for (int i = 0; i < 4; ++i) {
        const int j = jbase + 512 * i; if (j >= SEQ / 2) continue;
        const int p = 4 * (j >> 1) + (j & 1), k = (int)rev4((unsigned)p);
        f32x2 kfk, kfk2; kfk.x = fp[i][0]; kfk.y = fp[i][1]; kfk2.x = fp[i][2]; kfk2.y = fp[i][3];
        if (k == 0) {
            const f32x2 c0 = X[0]; const float a0 = c0.x + c0.y, aL = c0.x - c0.y;
            const f32x2 y0 = kfk * a0, yL = kfk2 * aL;
            f32x2 s, d; s.x = 0.5f * (y0.x + yL.x); s.y = 0.5f * (y0.y - yL.y); d.x = 0.5f * (y0.x - yL.x); d.y = 0.5f * (y0.y + yL.y);
            f32x2 r; r.x = s.x - d.y; r.y = s.y + d.x; X[0] = r;
        } else {
            const int k2 = SEQ - k; const int r1 = fpad(p), r2 = fpad(rev4(k2)); const f32x2 ck = X[r1], ck2 = X[r2];
            f32x2 E, O; E.x = 0.5f * (ck.x + ck2.x); E.y = 0.5f * (ck.y - ck2.y);
            const float dx = ck.x - ck2.x, dy = ck.y + ck2.y; O.x = 0.5f * dy; O.y = -0.5f * dx;
            const f32x2 w = fft_halfroot(lds, k); const f32x2 wO = cmul(w, O);
            const f32x2 yk = cmul(E + wO, kfk), yk2 = cmul(cconj(E - wO), kfk2);
            f32x2 s, d; s.x = 0.5f * (yk.x + yk2.x); s.y = 0.5f * (yk.y - yk2.y); d.x = 0.5f * (yk.x - yk2.x); d.y = 0.5f * (yk.y + yk2.y);
            f32x2 t = cmulc(d, w); f32x2 r; r.x = s.x - t.y; r.y = s.y + t.x; X[r1] = r;
            f32x2 s2 = cconj(s); f32x2 d2; d2.x = -d.x; d2.y = d.y;
            f32x2 t2 = cmul(d2, w); r.x = s2.x + t2.y; r.y = s2.y - t2.x; X[r2] = r;
        }
    }
}
DI void phase_hy_conv(int l, ldsp lds) {
    unsigned char* const ws_ = WSP();
    const bf16_t* UT = (const bf16_t*)(ws_ + WS_UT); const f32x2* KF = (const f32x2*)(ws_ + WS_KF); bf16_t* Z2T = (bf16_t*)(ws_ + WS_Z2T);
    const float* hs = INP(I_HYS) + l * 3 * 3072; const float* hbias = INP(I_HYBIAS) + l * 2048;
    LAS f32x2* X = (LAS f32x2*)(lds + FFT_X);
    const int tid = TID;
    constexpr int NV = (SEQ / 8 + 511) / 512;
    fft_tables(lds);
    for (int c = blockIdx.x; c < 1024; c += gridDim.x) {
        float z[NV][8];
#pragma unroll
        for (int j = 0; j < NV; ++j) { if (tid + 512 * j < SEQ / 8) hy_conv3_vec(UT + (size_t)c * SEQ, hs, c, tid + 512 * j, z[j]); }
#pragma unroll 1
        for (int o = 0; o < 2; ++o) {
#pragma unroll
            for (int j = 0; j < NV; ++j) {
                const int m0 = 4 * (tid + 512 * j); if (tid + 512 * j >= SEQ / 8) continue;
                LAS f32x4* q = (LAS f32x4*)(X + fpad(m0)); f32x4 a, b; a[0] = z[j][0]; a[1] = z[j][1]; a[2] = z[j][2]; a[3] = z[j][3]; b[0] = z[j][4]; b[1] = z[j][5]; b[2] = z[j][6]; b[3] = z[j][7];
                q[0] = a; q[1] = b;
                LAS f32x4* q2 = (LAS f32x4*)(X + fpad(SEQ / 2 + m0)); q2[0] = (f32x4){0.f, 0.f, 0.f, 0.f}; q2[1] = (f32x4){0.f, 0.f, 0.f, 0.f};
            }
            const f32x4* kfp = (const f32x4*)(KF + (size_t)(o * 1024 + c) * KFP);
            __syncthreads();
            fft_dif(lds, tid);
            if (tid == 0) { const int r = fpad(rev4(SEQ / 2)); const f32x2 yk = cmul(cconj(X[r]), ld_xcu2((const f32x2*)(kfp + SEQ / 2))); X[r] = cconj(yk); }
            {
                constexpr int NKI = (SEQ / 2 + 511) / 512, NG = (NKI + 3) / 4;
                f32x4 fp0[4], fp1[4];
                hy_kfload4(kfp, tid, fp0);
#pragma unroll 1
                for (int g = 0; g < NG; g += 2) {
                    if (g + 1 < NG) hy_kfload4(kfp, tid + 2048 * (g + 1), fp1);
                    hy_pointwise4(lds, tid + 2048 * g, fp0);
                    if (g + 2 < NG) hy_kfload4(kfp, tid + 2048 * (g + 2), fp0);
                    if (g + 1 < NG) hy_pointwise4(lds, tid + 2048 * (g + 1), fp1);
                }
            }
            __syncthreads();
            fft_dit_inv(lds, tid);
            const float bias = hbias[o * 1024 + c]; const float invn = 1.f / (float)SEQ;
            const bf16_t* ug = UT + (size_t)(1024 * (o + 1) + c) * SEQ;
#pragma unroll
            for (int j = 0; j < NV; ++j) {
                const int v = tid + 512 * j; if (v >= SEQ / 8) continue; const LAS f32x4* q = (const LAS f32x4*)(X + fpad(4 * v)); const f32x4 a = q[0], b = q[1];
                float g[8]; hy_conv3_vec(ug, hs, 1024 * (o + 1) + c, v, g);
                z[j][0] = g[0] * (a[0] * invn + bias * z[j][0]); z[j][1] = g[1] * (a[1] * invn + bias * z[j][1]); z[j][2] = g[2] * (a[2] * invn + bias * z[j][2]); z[j][3] = g[3] * (a[3] * invn + bias * z[j][3]);
                z[j][4] = g[4] * (b[0] * invn + bias * z[j][4]); z[j][5] = g[5] * (b[1] * invn + bias * z[j][5]); z[j][6] = g[6] * (b[2] * invn + bias * z[j][6]); z[j][7] = g[7] * (b[3] * invn + bias * z[j][7]);
                if (o == 1) { u32x4 w; w.x = pk2(z[j][0], z[j][1]); w.y = pk2(z[j][2], z[j][3]); w.z = pk2(z[j][4], z[j][5]); w.w = pk2(z[j][6], z[j][7]); *(u32x4*)(Z2T + (size_t)c * SEQ + 8 * v) = w; }
            }
        }
        __syncthreads();
    }
}
DI void phase_hy_out(ldsp lds) {
    unsigned char* const ws_ = WSP();
    const bf16_t* Z2T = (const bf16_t*)(ws_ + WS_Z2T); bf16_t* Y = (bf16_t*)(ws_ + WS_Y);
    LAS unsigned short* T = (LAS unsigned short*)lds; const int tid = TID;
    for (int t = blockIdx.x; t < 16 * (SEQ / 64); t += gridDim.x) {
        const int c0 = (t & 15) * 64, t0 = (t >> 4) * 64;
        { const int r = tid >> 3, q8 = tid & 7; const bf16x8 v = *(const bf16x8*)(Z2T + (size_t)(c0 + r) * SEQ + t0 + 8 * q8);
#pragma unroll
          for (int j = 0; j < 8; ++j) T[(8 * q8 + j) * 72 + r] = (unsigned short)v[j]; }
        __syncthreads();
        { const int tt = tid >> 3, cc = tid & 7; *(u32x4*)(Y + (size_t)(t0 + tt) * 4096 + c0 + 8 * cc) = *(const LAS u32x4*)(T + tt * 72 + 8 * cc); }
        __syncthreads();
    }
}

constexpr float RSQ128 = 0.08838834764831845f;
DI void phase_ret_kv(int l, ldsp lds) {
    unsigned char* const ws_ = WSP();
    constexpr int PK = 272, PV = 528, KF_OFF = 0, KB_OFF = 128 * PK, V_OFF = 2 * 128 * PK;
    static_assert(V_OFF + 128 * PV <= LDS_PTRS, "lds");
    const bf16_t* PROJ = (const bf16_t*)(ws_ + WS_PROJ); bf16_t* KVT = (bf16_t*)(ws_ + WS_RKV); const float* dec = INP(I_RDEC) + l * 8;
    const int tid = TID, lane = tid & 63, w = tid >> 6, lr = lane & 15, lg = lane >> 4;
    for (int u = blockIdx.x; u < 4 * NCR; u += gridDim.x) {
        const int h = u / NCR, n = u % NCR, t0 = n * 128;
        const float lgf = logsig(dec[h]), lgb = logsig(dec[4 + h]);
#pragma unroll
        for (int i = 0; i < 4; ++i) {
            const int c = tid + 512 * i, r = c >> 4, cc = c & 15;
            const bf16x8 kv = *(const bf16x8*)(PROJ + (size_t)(t0 + r) * NPROJ + PC_RK + h * 128 + 8 * cc);
            const float sf = RSQ128 * fexp(lgf * (float)(127 - r)), sb = RSQ128 * fexp(lgb * (float)r);
            u32x4 of, ob;
#pragma unroll
            for (int j = 0; j < 4; ++j) { const float a = bf2f((unsigned short)kv[2 * j]), b = bf2f((unsigned short)kv[2 * j + 1]); of[j] = pk2(a * sf, b * sf); ob[j] = pk2(a * sb, b * sb); }
            *(LAS u32x4*)(lds + KF_OFF + r * PK + 16 * cc) = of; *(LAS u32x4*)(lds + KB_OFF + r * PK + 16 * cc) = ob;
        }
#pragma unroll
        for (int i = 0; i < 8; ++i) { const int c = tid + 512 * i, r = c >> 5, cc = c & 31; *(LAS u32x4*)(lds + V_OFF + r * PV + 16 * cc) = *(const u32x4*)(PROJ + (size_t)(t0 + r) * NPROJ + PC_RV + h * 256 + 8 * cc); }
        __syncthreads();
#pragma unroll 1
        for (int dir = 0; dir < 2; ++dir) {
            const unsigned koff = dir ? KB_OFF : KF_OFF;
            f32x4 acc[2][8];
#pragma unroll
            for (int a = 0; a < 2; ++a)
#pragma unroll
                for (int b = 0; b < 8; ++b) acc[a][b] = (f32x4){0.f, 0.f, 0.f, 0.f};
#pragma unroll 1
            for (int ks = 0; ks < 4; ++ks) {
                TrF avf[2], bvf[8];
#pragma unroll
                for (int e2 = 0; e2 < 2; ++e2) tr_issue(lds, V_OFF, PV, 32 * ks + 8 * lg, 32 * ks + 8 * lg + 4, 16 * (2 * w + e2), lr, avf[e2]);
#pragma unroll
                for (int dt = 0; dt < 8; ++dt) tr_issue(lds, koff, PK, 32 * ks + 8 * lg, 32 * ks + 8 * lg + 4, 16 * dt, lr, bvf[dt]);
                tr_wait2(avf[0], avf[1]); tr_wait2(bvf[0], bvf[1]); tr_wait2(bvf[2], bvf[3]); tr_wait2(bvf[4], bvf[5]); tr_wait2(bvf[6], bvf[7]);
#pragma unroll
                for (int dt = 0; dt < 8; ++dt)
#pragma unroll
                    for (int e2 = 0; e2 < 2; ++e2) acc[e2][dt] = mfma16(tr_val(bvf[dt]), tr_val(avf[e2]), acc[e2][dt]);
            }
            bf16_t* dst = KVT + (size_t)((dir * 4 + h) * NCR + n) * 32768;
#pragma unroll
            for (int e2 = 0; e2 < 2; ++e2)
#pragma unroll
                for (int dt = 0; dt < 8; ++dt) { u32x2 pw; pw.x = pk2(acc[e2][dt][0], acc[e2][dt][1]); pw.y = pk2(acc[e2][dt][2], acc[e2][dt][3]); *(u32x2*)(dst + (16 * (2 * w + e2) + lr) * 128 + 16 * dt + 4 * lg) = pw; }
        }
        __syncthreads();
    }
}
DI void phase_ret_scan(ldsp lds, int l) {
    unsigned char* const ws_ = WSP();
    const unsigned* KVT = (const unsigned*)(ws_ + WS_RKV); unsigned* ST = (unsigned*)(ws_ + WS_RST); const float* dec = INP(I_RDEC) + l * 8;
    static_assert(NCR % 8 == 0, "scan unroll");
    for (int g = blockIdx.x * 512 + TID; g < 8 * 16384; g += gridDim.x * 512) {
        const int dh = g >> 14, ep = g & 16383, dir = dh >> 2;
        const float G = expf(logsig(dec[dh]) * 128.f); float s0 = 0.f, s1 = 0.f;
        const unsigned* src = KVT + (size_t)dh * NCR * 16384 + ep; unsigned* dst = ST + (size_t)dh * NCR * 16384 + ep;
#pragma unroll 1
        for (int nb = 0; nb < NCR; nb += 8) {
            const int n0 = dir ? (NCR - 8 - nb) : nb; unsigned v[8];
#pragma unroll
            for (int j = 0; j < 8; ++j) v[j] = src[(size_t)(n0 + j) * 16384];
            if (dir == 0) {
#pragma unroll
                for (int j = 0; j < 8; ++j) { dst[(size_t)(n0 + j) * 16384] = pk2(s0, s1); s0 = s0 * G + bf2f((unsigned short)(v[j] & 0xffffu)); s1 = s1 * G + bf2f((unsigned short)(v[j] >> 16)); }
            } else {
#pragma unroll
                for (int j = 7; j >= 0; --j) { dst[(size_t)(n0 + j) * 16384] = pk2(s0, s1); s0 = s0 * G + bf2f((unsigned short)(v[j] & 0xffffu)); s1 = s1 * G + bf2f((unsigned short)(v[j] >> 16)); }
            }
        }
    }
}
DI void phase_ret_out(int l, ldsp lds) {
    unsigned char* const ws_ = WSP();
    constexpr int PK = 272, PV = 528, K_OFF = 0, V_OFF = 128 * PK;
    const bf16_t* PROJ = (const bf16_t*)(ws_ + WS_PROJ); const bf16_t* ST = (const bf16_t*)(ws_ + WS_RST); bf16_t* Y = (bf16_t*)(ws_ + WS_Y); const float* dec = INP(I_RDEC) + l * 8;
    const int tid = TID, lane = tid & 63, w = tid >> 6, lr = lane & 15, lg = lane >> 4;
    for (int u = blockIdx.x; u < 4 * NCR; u += gridDim.x) {
        const int h = u / NCR, n = u % NCR, t0 = n * 128;
        const float lgf = logsig(dec[h]), lgb = logsig(dec[4 + h]);
        const int i = 16 * w + lr; const size_t tok = (size_t)(t0 + i);
        bf16x8 qf[4];
#pragma unroll
        for (int ks = 0; ks < 4; ++ks) qf[ks] = *(const bf16x8*)(PROJ + tok * NPROJ + PC_RQ + h * 128 + 32 * ks + 8 * lg);
#pragma unroll
        for (int i = 0; i < 4; ++i) {
            const int c = tid + 512 * i, r = c >> 4, cc = c & 15;
            const bf16x8 kv = *(const bf16x8*)(PROJ + (size_t)(t0 + r) * NPROJ + PC_RK + h * 128 + 8 * cc); u32x4 o;
#pragma unroll
            for (int j = 0; j < 4; ++j) o[j] = pk2(bf2f((unsigned short)kv[2 * j]) * RSQ128, bf2f((unsigned short)kv[2 * j + 1]) * RSQ128);
            *(LAS u32x4*)(lds + K_OFF + r * PK + 16 * cc) = o;
        }
#pragma unroll
        for (int i = 0; i < 8; ++i) { const int c = tid + 512 * i, r = c >> 5, cc = c & 31; *(LAS u32x4*)(lds + V_OFF + r * PV + 16 * cc) = *(const u32x4*)(PROJ + (size_t)(t0 + r) * NPROJ + PC_RV + h * 256 + 8 * cc); }
        __syncthreads();
        f32x4 s[8];
#pragma unroll
        for (int jt = 0; jt < 8; ++jt) {
            s[jt] = (f32x4){0.f, 0.f, 0.f, 0.f};
#pragma unroll
            for (int ks = 0; ks < 4; ++ks) s[jt] = mfma16(lds_row8(lds, K_OFF + (16 * jt + lr) * PK + (32 * ks + 8 * lg) * 2), qf[ks], s[jt]);
#pragma unroll
            for (int r = 0; r < 4; ++r) { const int dm = i - (16 * jt + 4 * lg + r); float d = 0.f; if (dm >= 0) d += fexp(lgf * (float)dm); if (dm <= 0) d += fexp(lgb * (float)(-dm)); s[jt][r] *= d; }
        }
        bf16x8 pf[4];
#pragma unroll
        for (int kk = 0; kk < 4; ++kk) pf[kk] = pack8(s[2 * kk], s[2 * kk + 1]);
        const float wqf = fexp(lgf * (float)(i + 1)), wqb = fexp(lgb * (float)(128 - i));
        const bf16_t* stf = ST + (size_t)((0 * 4 + h) * NCR + n) * 32768; const bf16_t* stb = ST + (size_t)((4 + h) * NCR + n) * 32768;
        float* ry = (float*)(ws_ + WS_RY) + tok * 1024 + h * 256 + 4 * lg; float ss = 0.f;
#define RET_LD(et_, SF, SB) do { _Pragma("unroll") for (int ks = 0; ks < 4; ++ks) { SF[ks] = *(const bf16x8*)(stf + (16 * (et_) + lr) * 128 + 32 * ks + 8 * lg); SB[ks] = *(const bf16x8*)(stb + (16 * (et_) + lr) * 128 + 32 * ks + 8 * lg); } } while (0)
#define RET_ET(et_, SF, SB) do { f32x4 a1 = {0.f, 0.f, 0.f, 0.f}, af = a1, ab = a1; TrF vf[4]; \
            _Pragma("unroll") for (int kk = 0; kk < 4; ++kk) tr_issue(lds, V_OFF, PV, 32 * kk + 4 * lg, 32 * kk + 16 + 4 * lg, 16 * (et_), lr, vf[kk]); \
            tr_wait2(vf[0], vf[1]); tr_wait2(vf[2], vf[3]); \
            _Pragma("unroll") for (int kk = 0; kk < 4; ++kk) a1 = mfma16(tr_val(vf[kk]), pf[kk], a1); \
            _Pragma("unroll") for (int ks = 0; ks < 4; ++ks) { af = mfma16(SF[ks], qf[ks], af); ab = mfma16(SB[ks], qf[ks], ab); } \
            const f32x4 yv = a1 + af * wqf + ab * wqb; ss += dot4(yv, yv); *(f32x4*)(ry + 16 * (et_)) = yv; } while (0)
        {
            bf16x8 sfC[4], sbC[4];
            RET_LD(0, sfC, sbC);
#pragma unroll 1
            for (int et = 0; et < 16; ++et) {
                bf16x8 sfN[4], sbN[4]; const int en = (et + 1 < 16) ? et + 1 : et;
                RET_LD(en, sfN, sbN);
                RET_ET(et, sfC, sbC);
#pragma unroll
                for (int ks = 0; ks < 4; ++ks) { sfC[ks] = sfN[ks]; sbC[ks] = sbN[ks]; }
            }
        }
#undef RET_LD
#undef RET_ET
        ss += __shfl_xor(ss, 16); ss += __shfl_xor(ss, 32);
        const float rstd = rsqrtf(ss * (1.f / 256.f) + EPS);
#pragma unroll 1
        for (int et = 0; et < 16; ++et) {
            const int e0 = 16 * et + 4 * lg; const f32x4 yv = *(const f32x4*)(ry + 16 * et);
            const s16x4 gv = *(const s16x4*)(PROJ + tok * NPROJ + PC_RG + h * 256 + e0); float o[4];
#pragma unroll
            for (int r = 0; r < 4; ++r) { const float gg = bf2f((unsigned short)gv[r]); o[r] = yv[r] * rstd * (gg * frcp(1.f + fexp(-gg))); }
            u32x2 ww; ww.x = pk2(o[0], o[1]); ww.y = pk2(o[2], o[3]); *(u32x2*)(Y + tok * 4096 + 1024 + h * 256 + e0) = ww;
        }
        __syncthreads();
    }
}

DI void phase_att(int l, ldsp lds) {
    unsigned char* const ws_ = WSP();
    constexpr int PK = 272, K_OFF = 0, V_OFF = 256 * PK, NB = SEQ / 128;
    static_assert(2 * 256 * PK <= LDS_PTRS, "lds");
    const bf16_t* PROJ = (const bf16_t*)(ws_ + WS_PROJ); bf16_t* OB = (bf16_t*)(ws_ + WS_OB); float* LSE = (float*)(ws_ + WS_LSE);
    const float* gq = INP(I_AGAIN) + l * 256; const float* gk = gq + 128;
    const int tid = TID, lane = tid & 63, w = tid >> 6, lr = lane & 15, lg = lane >> 4;
    bf16x8 kvr[8]; u32x4 vvr[8];
    float gkr[8];
#pragma unroll
    for (int j = 0; j < 8; ++j) gkr[j] = gk[8 * (tid & 15) + j];
#define ATT_LOAD(uu) do { const int br_ = (uu) / (8 * NB), rem_ = (uu) % (8 * NB), h_ = rem_ / NB, ub_ = rem_ % NB; \
        const int dil_ = (br_ == 0) ? 1 : (br_ == 1) ? 4 : 16; const int n_ = SEQ / dil_, nblk_ = n_ / 128, rho_ = ub_ / nblk_, p0_ = (ub_ % nblk_) * 128; \
        _Pragma("unroll") for (int i = 0; i < 8; ++i) { const int c = tid + 512 * i, r = c >> 4, cc = c & 15; const int pp = p0_ - 64 + r; const bool valid = (pp >= 0) && (pp < n_); \
            const size_t tk = (size_t)(valid ? pp * dil_ + rho_ : 0); \
            kvr[i] = *(const bf16x8*)(PROJ + tk * NPROJ + PC_AK + h_ * 128 + 8 * cc); vvr[i] = *(const u32x4*)(PROJ + tk * NPROJ + PC_AV + h_ * 128 + 8 * cc); } } while (0)
    if ((int)blockIdx.x < 3 * 8 * NB) ATT_LOAD((int)blockIdx.x);
    for (int u = blockIdx.x; u < 3 * 8 * NB; u += gridDim.x) {
        const int br = u / (8 * NB), rem = u % (8 * NB), h = rem / NB, ub = rem % NB;
        const int dil = (br == 0) ? 1 : (br == 1) ? 4 : 16; const int n = SEQ / dil, nblk = n / 128, rho = ub / nblk, p0 = (ub % nblk) * 128;
        const float slope = exp2f(-(float)(h + 1)) * (float)dil;
        const int qi = 16 * w + lr; const size_t tq = (size_t)((p0 + qi) * dil + rho);
        bf16x8 qr[4];
#pragma unroll
        for (int ks = 0; ks < 4; ++ks) qr[ks] = *(const bf16x8*)(PROJ + tq * NPROJ + PC_AQ + h * 128 + 32 * ks + 8 * lg);
#pragma unroll
        for (int i = 0; i < 8; ++i) {
            const int c = tid + 512 * i, r = c >> 4, cc = c & 15; const int pp = p0 - 64 + r; const bool valid = (pp >= 0) && (pp < n);
            const bf16x8 kv = kvr[i]; u32x4 vv = vvr[i];
            float x[8]; float ss = 0.f;
#pragma unroll
            for (int j = 0; j < 8; ++j) { x[j] = valid ? bf2f((unsigned short)kv[j]) : 0.f; ss += x[j] * x[j]; }
            ss += __shfl_xor(ss, 1); ss += __shfl_xor(ss, 2); ss += __shfl_xor(ss, 4); ss += __shfl_xor(ss, 8);
            const float rstd = rsqrtf(ss * (1.f / 128.f) + EPS); u32x4 o;
#pragma unroll
            for (int j = 0; j < 4; ++j) o[j] = pk2(x[2 * j] * rstd * gkr[2 * j], x[2 * j + 1] * rstd * gkr[2 * j + 1]);
            if (!valid) vv = (u32x4){0u, 0u, 0u, 0u};
            *(LAS u32x4*)(lds + K_OFF + r * PK + 16 * cc) = o; *(LAS u32x4*)(lds + V_OFF + r * PK + 16 * cc) = vv;
            MEMFENCE();
        }
        __syncthreads();
        bf16x8 qf[4];
        {
            float ss = 0.f;
#pragma unroll
            for (int ks = 0; ks < 4; ++ks) {
#pragma unroll
                for (int j = 0; j < 8; ++j) { const float v = bf2f((unsigned short)qr[ks][j]); ss += v * v; } }
            ss += __shfl_xor(ss, 16); ss += __shfl_xor(ss, 32);
            const float rstd = rsqrtf(ss * (1.f / 128.f) + EPS) * RSQ128;
#pragma unroll
            for (int ks = 0; ks < 4; ++ks) { u32x4 o;
#pragma unroll
                for (int j = 0; j < 4; ++j) { const int d = 32 * ks + 8 * lg + 2 * j; o[j] = pk2(bf2f((unsigned short)qr[ks][2 * j]) * rstd * gq[d], bf2f((unsigned short)qr[ks][2 * j + 1]) * rstd * gq[d + 1]); }
                qf[ks] = __builtin_bit_cast(bf16x8, o); }
        }
        if (u + (int)gridDim.x < 3 * 8 * NB) ATT_LOAD(u + (int)gridDim.x);
        const float dlane = (float)(4 * lg - lr); const int kl = 16 * w + 4 * lg;
        const int klo = (p0 == 0) ? 64 : 0; const unsigned kspan = (unsigned)(((p0 + 128 == n) ? 192 : 256) - klo);
        f32x4 s[10]; float mx = -1e30f;
#pragma unroll
        for (int t = 0; t < 9; ++t) {
            s[t] = (f32x4){0.f, 0.f, 0.f, 0.f};
#pragma unroll
            for (int ks = 0; ks < 4; ++ks) s[t] = mfma16(lds_row8(lds, K_OFF + (16 * (w + t) + lr) * PK + (32 * ks + 8 * lg) * 2), qf[ks], s[t]);
#pragma unroll
            for (int r = 0; r < 4; ++r) {
                const float aof = fabsf((float)(16 * t + r - 64) + dlane);
                const bool valid = (aof <= 64.f) && ((unsigned)(16 * t + r + kl - klo) < kspan);
                const float sv = valid ? s[t][r] - slope * aof : -1e30f; s[t][r] = sv; mx = fmaxf(mx, sv);
            }
            MEMFENCE();
        }
        s[9] = (f32x4){0.f, 0.f, 0.f, 0.f};
        mx = fmaxf(mx, __shfl_xor(mx, 16)); mx = fmaxf(mx, __shfl_xor(mx, 32));
        float lsum = 0.f;
#pragma unroll
        for (int t = 0; t < 9; ++t)
#pragma unroll
            for (int r = 0; r < 4; ++r) { const float sv = s[t][r]; const float e = fexp(sv - mx); s[t][r] = e; lsum += e; }
        lsum += __shfl_xor(lsum, 16); lsum += __shfl_xor(lsum, 32);
        bf16x8 pf[5];
#pragma unroll
        for (int kk = 0; kk < 5; ++kk) pf[kk] = pack8(s[2 * kk], s[2 * kk + 1]);
        const float inv = 1.f / lsum;
        bf16_t* orow = OB + ((size_t)br * SEQ + tq) * 1024 + h * 128;
#pragma unroll 1
        for (int et = 0; et < 8; ++et) {
            f32x4 o = {0.f, 0.f, 0.f, 0.f};
            TrF vf[5];
#pragma unroll
            for (int kk = 0; kk < 5; ++kk) { const int ra = 16 * (w + 2 * kk) + 4 * lg, rb = (kk < 4) ? ra + 16 : ra; tr_issue(lds, V_OFF, PK, ra, rb, 16 * et, lr, vf[kk]); }
            tr_wait2(vf[0], vf[1]); tr_wait2(vf[2], vf[3]); tr_wait1(vf[4]);
#pragma unroll
            for (int kk = 0; kk < 5; ++kk) o = mfma16(tr_val(vf[kk]), pf[kk], o);
            u32x2 ww; ww.x = pk2(o[0] * inv, o[1] * inv); ww.y = pk2(o[2] * inv, o[3] * inv); *(u32x2*)(orow + 16 * et + 4 * lg) = ww;
        }
        if (lg == 0) LSE[((size_t)br * SEQ + tq) * 8 + h] = mx + logf(lsum);
        __syncthreads();
    }
#undef ATT_LOAD
}
DI void phase_att_merge(ldsp lds) {
    unsigned char* const ws_ = WSP();
    const bf16_t* OB = (const bf16_t*)(ws_ + WS_OB); const float* LSE = (const float*)(ws_ + WS_LSE); bf16_t* Y = (bf16_t*)(ws_ + WS_Y);
    for (int g = blockIdx.x * 512 + TID; g < SEQ * 128; g += gridDim.x * 512) {
        const int tok = g >> 7, h = (g >> 4) & 7, e8 = g & 15;
        const float l0 = LSE[((size_t)0 * SEQ + tok) * 8 + h], l1 = LSE[((size_t)1 * SEQ + tok) * 8 + h], l2 = LSE[((size_t)2 * SEQ + tok) * 8 + h];
        const float m = fmaxf(l0, fmaxf(l1, l2)); float w0 = fexp(l0 - m), w1 = fexp(l1 - m), w2 = fexp(l2 - m); const float inv = frcp(w0 + w1 + w2); w0 *= inv; w1 *= inv; w2 *= inv;
        const bf16x8 a = *(const bf16x8*)(OB + ((size_t)0 * SEQ + tok) * 1024 + h * 128 + 8 * e8), b = *(const bf16x8*)(OB + ((size_t)1 * SEQ + tok) * 1024 + h * 128 + 8 * e8), c = *(const bf16x8*)(OB + ((size_t)2 * SEQ + tok) * 1024 + h * 128 + 8 * e8);
        float o[8];
#pragma unroll
        for (int j = 0; j < 8; ++j) o[j] = w0 * bf2f((unsigned short)a[j]) + w1 * bf2f((unsigned short)b[j]) + w2 * bf2f((unsigned short)c[j]);
        u32x4 ww; ww.x = pk2(o[0], o[1]); ww.y = pk2(o[2], o[3]); ww.z = pk2(o[4], o[5]); ww.w = pk2(o[6], o[7]);
        *(u32x4*)(Y + (size_t)tok * 4096 + 2048 + h * 128 + 8 * e8) = ww;
    }
}

DI int ml_tok(int dir, int n, int i) { return dir ? SEQ - 1 - (64 * n + i) : 64 * n + i; }
DI void ml_gate_row(const float* G, const float* gb, int dir, int h, int n, int lane, float& ig, float& b) {
    const size_t tk = (size_t)ml_tok(dir, n, lane);
    ig = G[tk * 16 + dir * 8 + h] + gb[dir * 8 + h];
    const float lf = logsig(G[tk * 16 + dir * 8 + 4 + h] + gb[dir * 8 + 4 + h]);
    b = lf;
#pragma unroll
    for (int d = 1; d < 64; d <<= 1) { const float o = __shfl_up(b, d); if (lane >= d) b += o; }
}
DI void phase_ml_kv(int l, ldsp lds) {
    unsigned char* const ws_ = WSP();
    constexpr int PK = 272, PV = 528, KW0_OFF = 0, KW1_OFF = 64 * PK, V_OFF = 2 * 64 * PK, WA_OFF = V_OFF + 64 * PV;
    const bf16_t* PROJ = (const bf16_t*)(ws_ + WS_PROJ); const float* G = (const float*)(ws_ + WS_G); const float* gb = INP(I_MGB) + l * 16;
    bf16_t* KVT = (bf16_t*)(ws_ + WS_MKV); float* KSUM = (float*)(ws_ + WS_KSUM); float* MLOC = (float*)(ws_ + WS_MLOC); float* BLAST = (float*)(ws_ + WS_BLAST);
    LAS float* waL = (LAS float*)(lds + WA_OFF);
    const int tid = TID, lane = tid & 63, w = tid >> 6, lr = lane & 15, lg = lane >> 4;
    for (int u = blockIdx.x; u < 4 * NCM; u += gridDim.x) {
        const int h = u / NCM, nt = u % NCM;
        bf16x8 kreg[2]; u32x4 vreg[4];
#pragma unroll
        for (int i = 0; i < 2; ++i) { const int c = tid + 512 * i, r = c >> 4, cc = c & 15; const size_t tk = (size_t)(64 * nt + r); kreg[i] = *(const bf16x8*)(PROJ + tk * NPROJ + PC_MK + h * 128 + 8 * cc); }
#pragma unroll
        for (int i = 0; i < 4; ++i) { const int c = tid + 512 * i, r = c >> 5, cc = c & 31; const size_t tk = (size_t)(64 * nt + r); vreg[i] = *(const u32x4*)(PROJ + tk * NPROJ + PC_MV + h * 256 + 8 * cc); }
        if (w < 2) {
            const int dir = w, n = dir ? NCM - 1 - nt : nt, dh = dir * 4 + h;
            float ig, b; ml_gate_row(G, gb, dir, h, n, lane, ig, b);
            const float blast = __shfl(b, 63); const float a = blast - b + ig; const float mloc = wave_max(a);
            waL[64 * dir + (dir ? 63 - lane : lane)] = expf(a - mloc);
            if (lane == 0) { MLOC[dh * NCM + n] = mloc; BLAST[dh * NCM + n] = blast; }
        }
        __syncthreads();
#pragma unroll
        for (int i = 0; i < 2; ++i) {
            const int c = tid + 512 * i, r = c >> 4, cc = c & 15;
            const bf16x8 kv = kreg[i]; const float s0 = RSQ128 * waL[r], s1 = RSQ128 * waL[64 + r]; u32x4 o0, o1;
#pragma unroll
            for (int j = 0; j < 4; ++j) { const float x0 = bf2f((unsigned short)kv[2 * j]), x1 = bf2f((unsigned short)kv[2 * j + 1]); o0[j] = pk2(x0 * s0, x1 * s0); o1[j] = pk2(x0 * s1, x1 * s1); }
            *(LAS u32x4*)(lds + KW0_OFF + r * PK + 16 * cc) = o0; *(LAS u32x4*)(lds + KW1_OFF + r * PK + 16 * cc) = o1;
        }
#pragma unroll
        for (int i = 0; i < 4; ++i) { const int c = tid + 512 * i, r = c >> 5, cc = c & 31; *(LAS u32x4*)(lds + V_OFF + r * PV + 16 * cc) = vreg[i]; }
        __syncthreads();
#pragma unroll 1
        for (int dir = 0; dir < 2; ++dir) {
            const unsigned koff = dir ? KW1_OFF : KW0_OFF; const int n = dir ? NCM - 1 - nt : nt, dh = dir * 4 + h;
            f32x4 acc[2][8];
#pragma unroll
            for (int a = 0; a < 2; ++a)
#pragma unroll
                for (int b = 0; b < 8; ++b) acc[a][b] = (f32x4){0.f, 0.f, 0.f, 0.f};
#pragma unroll 1
            for (int ks = 0; ks < 2; ++ks) {
                TrF avf[2], bvf[8];
#pragma unroll
                for (int e2 = 0; e2 < 2; ++e2) tr_issue(lds, V_OFF, PV, 32 * ks + 8 * lg, 32 * ks + 8 * lg + 4, 16 * (2 * w + e2), lr, avf[e2]);
#pragma unroll
                for (int dt = 0; dt < 8; ++dt) tr_issue(lds, koff, PK, 32 * ks + 8 * lg, 32 * ks + 8 * lg + 4, 16 * dt, lr, bvf[dt]);
                tr_wait2(avf[0], avf[1]); tr_wait2(bvf[0], bvf[1]); tr_wait2(bvf[2], bvf[3]); tr_wait2(bvf[4], bvf[5]); tr_wait2(bvf[6], bvf[7]);
#pragma unroll
                for (int dt = 0; dt < 8; ++dt)
#pragma unroll
                    for (int e2 = 0; e2 < 2; ++e2) acc[e2][dt] = mfma16(tr_val(bvf[dt]), tr_val(avf[e2]), acc[e2][dt]);
            }
            bf16_t* dst = KVT + (size_t)(dh * NCM + n) * 32768;
#pragma unroll
            for (int e2 = 0; e2 < 2; ++e2)
#pragma unroll
                for (int dt = 0; dt < 8; ++dt) { u32x2 pw; pw.x = pk2(acc[e2][dt][0], acc[e2][dt][1]); pw.y = pk2(acc[e2][dt][2], acc[e2][dt][3]); *(u32x2*)(dst + (16 * (2 * w + e2) + lr) * 128 + 16 * dt + 4 * lg) = pw; }
            if (tid < 128) { float s = 0.f; for (int r = 0; r < 64; ++r) s += bf2f(*(const LAS unsigned short*)(lds + koff + r * PK + 2 * tid)); KSUM[(size_t)(dh * NCM + n) * 128 + tid] = s; }
        }
        __syncthreads();
    }
}
DI void phase_ml_scan(ldsp lds) {
    unsigned char* const ws_ = WSP();
    const unsigned* KVT = (const unsigned*)(ws_ + WS_MKV); unsigned* CT = (unsigned*)(ws_ + WS_MCT); const float* KSUM = (const float*)(ws_ + WS_KSUM); float* NPREV = (float*)(ws_ + WS_NPREV);
    const float* MLOC = (const float*)(ws_ + WS_MLOC); const float* BLAST = (const float*)(ws_ + WS_BLAST); float* MPREV = (float*)(ws_ + WS_MPREV);
    LAS float* sp = (LAS float*)lds; LAS float* sc = sp + NCM;
    const int tid = TID;
    for (int wi = blockIdx.x; wi < 256; wi += gridDim.x) {
        const int dh = wi >> 5, slice = wi & 31;
        for (int n = tid; n < NCM; n += 512) { sp[n] = MLOC[dh * NCM + n]; sc[n] = BLAST[dh * NCM + n]; }
        __syncthreads();
        if (tid == 0) {
            float m = 0.f;
            for (int n = 0; n < NCM; ++n) {
                const float mloc = sp[n], bl = sc[n];
                if (slice == 0) MPREV[dh * NCM + n] = m;
                const float mn = fmaxf(bl + m, mloc); sp[n] = expf(bl + m - mn); sc[n] = expf(mloc - mn); m = mn;
            }
        }
        __syncthreads();
        {
            const int ep = slice * 512 + tid; float c0 = 0.f, c1 = 0.f;
            const unsigned* src = KVT + (size_t)dh * NCM * 16384 + ep; unsigned* dst = CT + (size_t)dh * NCM * 16384 + ep;
#pragma unroll 1
            for (int n0 = 0; n0 < NCM; n0 += 8) {
                unsigned v[8];
#pragma unroll
                for (int j = 0; j < 8; ++j) v[j] = src[(size_t)(n0 + j) * 16384];
#pragma unroll
                for (int j = 0; j < 8; ++j) { const float a = sp[n0 + j], b = sc[n0 + j]; dst[(size_t)(n0 + j) * 16384] = pk2(c0, c1); c0 = a * c0 + b * bf2f((unsigned short)(v[j] & 0xffffu)); c1 = a * c1 + b * bf2f((unsigned short)(v[j] >> 16)); }
            }
        }
        if (slice == 0 && tid < 128) { float v = 0.f; for (int n = 0; n < NCM; ++n) { NPREV[(size_t)(dh * NCM + n) * 128 + tid] = v; v = sp[n] * v + sc[n] * KSUM[(size_t)(dh * NCM + n) * 128 + tid]; } }
        __syncthreads();
    }
}
DI void phase_ml_out(int l, ldsp lds) {
    unsigned char* const ws_ = WSP();
    constexpr int PK = 272, PV = 528, K_OFF = 0, V_OFF = 64 * PK, F_OFF = V_OFF + 64 * PV, HF_OFF = F_OFF + 2048, SS_OFF = HF_OFF + 64 * 256 * 4;
    static_assert(SS_OFF + 512 <= LDS_PTRS, "lds");
    const bf16_t* PROJ = (const bf16_t*)(ws_ + WS_PROJ); const float* G = (const float*)(ws_ + WS_G); const float* gb = INP(I_MGB) + l * 16;
    const bf16_t* CT = (const bf16_t*)(ws_ + WS_MCT); const float* NPREV = (const float*)(ws_ + WS_NPREV); const float* MPREV = (const float*)(ws_ + WS_MPREV);
    bf16_t* Y = (bf16_t*)(ws_ + WS_Y); const float* ng = INP(I_MNG) + l * 1024;
    LAS float* U = (LAS float*)(lds + F_OFF); LAS float* BM = U + 64; LAS float* WI = BM + 64; LAS float* EMT = WI + 64; LAS float* NP = EMT + 64;
    LAS float* HF = (LAS float*)(lds + HF_OFF); LAS float* SS = (LAS float*)(lds + SS_OFF);
    const int tid = TID, lane = tid & 63, w = tid >> 6, lr = lane & 15, lg = lane >> 4;
    const int qs = w & 3, eh = w >> 2, i = 16 * qs + lr;
    for (int u = blockIdx.x; u < 4 * NCM; u += gridDim.x) {
        const int h = u / NCM, nt = u % NCM;
#pragma unroll 1
        for (int dir = 0; dir < 2; ++dir) {
            const int dh = dir * 4 + h, n = dir ? NCM - 1 - nt : nt;
            bf16x8 kreg[2]; u32x4 vreg[4]; bf16x8 qf[4];
#pragma unroll
            for (int ii = 0; ii < 2; ++ii) { const int c = tid + 512 * ii, r = c >> 4, cc = c & 15; const size_t tk = (size_t)ml_tok(dir, n, r); kreg[ii] = *(const bf16x8*)(PROJ + tk * NPROJ + PC_MK + h * 128 + 8 * cc); }
#pragma unroll
            for (int ii = 0; ii < 4; ++ii) { const int c = tid + 512 * ii, r = c >> 5, cc = c & 31; const size_t tk = (size_t)ml_tok(dir, n, r); vreg[ii] = *(const u32x4*)(PROJ + tk * NPROJ + PC_MV + h * 256 + 8 * cc); }
            const size_t tq = (size_t)ml_tok(dir, n, i);
#pragma unroll
            for (int ks = 0; ks < 4; ++ks) qf[ks] = *(const bf16x8*)(PROJ + tq * NPROJ + PC_MQ + h * 128 + 32 * ks + 8 * lg);
            const bf16_t* ct = CT + (size_t)(dh * NCM + n) * 32768;
            bf16x8 cfall[4][4];
#pragma unroll
            for (int e8 = 0; e8 < 4; ++e8)
#pragma unroll
                for (int ks = 0; ks < 4; ++ks) cfall[e8][ks] = *(const bf16x8*)(ct + (16 * (8 * eh + e8) + lr) * 128 + 32 * ks + 8 * lg);
            if (w == 0) {
                float ig, b; ml_gate_row(G, gb, dir, h, n, lane, ig, b);
                const float uu = ig - b; float pm = uu;
#pragma unroll
                for (int d = 1; d < 64; d <<= 1) { const float o = __shfl_up(pm, d); if (lane >= d) pm = fmaxf(pm, o); }
                const float mprev = ld_xcu(MPREV + dh * NCM + n); const float mt = b + fmaxf(mprev, pm);
                U[lane] = uu; BM[lane] = b - mt; WI[lane] = expf(b + mprev - mt); EMT[lane] = expf(-mt);
            }
            if (tid >= 64 && tid < 192) NP[tid - 64] = NPREV[(size_t)(dh * NCM + n) * 128 + tid - 64];
#pragma unroll
            for (int ii = 0; ii < 2; ++ii) {
                const int c = tid + 512 * ii, r = c >> 4, cc = c & 15; const bf16x8 kv = kreg[ii]; u32x4 o;
#pragma unroll
                for (int j = 0; j < 4; ++j) o[j] = pk2(bf2f((unsigned short)kv[2 * j]) * RSQ128, bf2f((unsigned short)kv[2 * j + 1]) * RSQ128);
                *(LAS u32x4*)(lds + K_OFF + r * PK + 16 * cc) = o;
            }
#pragma unroll
            for (int ii = 0; ii < 4; ++ii) { const int c = tid + 512 * ii, r = c >> 5, cc = c & 31; *(LAS u32x4*)(lds + V_OFF + r * PV + 16 * cc) = vreg[ii]; }
            __syncthreads();
            float qn = 0.f;
#pragma unroll
            for (int ks = 0; ks < 4; ++ks)
#pragma unroll
                for (int j = 0; j < 8; ++j) qn += bf2f((unsigned short)qf[ks][j]) * NP[32 * ks + 8 * lg + j];
            qn += __shfl_xor(qn, 16); qn += __shfl_xor(qn, 32);
            const float bmi = BM[i], wii = WI[i];
            f32x4 s[4]; float dsum = 0.f;
#pragma unroll
            for (int jt = 0; jt < 4; ++jt) {
                s[jt] = (f32x4){0.f, 0.f, 0.f, 0.f};
                if (jt <= qs) {
#pragma unroll
                    for (int ks = 0; ks < 4; ++ks) s[jt] = mfma16(lds_row8(lds, K_OFF + (16 * jt + lr) * PK + (32 * ks + 8 * lg) * 2), qf[ks], s[jt]);
#pragma unroll
                    for (int r = 0; r < 4; ++r) { const int j = 16 * jt + 4 * lg + r; const float v = (j <= i) ? s[jt][r] * fexp(U[j] + bmi) : 0.f; s[jt][r] = v; dsum += v; }
                }
            }
            dsum += __shfl_xor(dsum, 16); dsum += __shfl_xor(dsum, 32);
            const float den = dsum + wii * qn; const float rden = 1.f / fmaxf(fabsf(den), EMT[i]);
            bf16x8 pf[2];
#pragma unroll
            for (int kk = 0; kk < 2; ++kk) pf[kk] = pack8(s[2 * kk], s[2 * kk + 1]);
            f32x4 tot[8]; float ssq = 0.f;
#pragma unroll
            for (int e8 = 0; e8 < 8; ++e8) {
                const int et = 8 * eh + e8; f32x4 a1 = {0.f, 0.f, 0.f, 0.f}, a2 = a1;
                TrF vf[2];
#pragma unroll
                for (int kk = 0; kk < 2; ++kk) tr_issue(lds, V_OFF, PV, 32 * kk + 4 * lg, 32 * kk + 16 + 4 * lg, 16 * et, lr, vf[kk]);
                tr_wait2(vf[0], vf[1]);
#pragma unroll
                for (int kk = 0; kk < 2; ++kk) a1 = mfma16(tr_val(vf[kk]), pf[kk], a1);
#pragma unroll
                for (int ks = 0; ks < 4; ++ks) a2 = mfma16(cfall[e8 & 3][ks], qf[ks], a2);
                if (e8 < 4) {
#pragma unroll
                    for (int ks = 0; ks < 4; ++ks) cfall[e8][ks] = *(const bf16x8*)(ct + (16 * (et + 4) + lr) * 128 + 32 * ks + 8 * lg);
                }
                const f32x4 hv = (a1 + a2 * wii) * rden;
                if (dir == 0) { *(LAS f32x4*)(HF + i * 256 + 16 * et + 4 * lg) = hv; tot[e8] = hv; }
                else { const f32x4 hf = *(const LAS f32x4*)(HF + (63 - i) * 256 + 16 * et + 4 * lg); tot[e8] = hv + hf; ssq += dot4(tot[e8], tot[e8]); }
                MEMFENCE();
            }
            if (dir == 1) {
                ssq += __shfl_xor(ssq, 16); ssq += __shfl_xor(ssq, 32);
                if (lg == 0) SS[i * 2 + eh] = ssq;
            }
            __syncthreads();
            if (dir == 1) {
                const float rstd = rsqrtf((SS[i * 2] + SS[i * 2 + 1]) * (1.f / 256.f) + EPS);
                const size_t tok = (size_t)(64 * nt + 63 - i);
#pragma unroll
                for (int e8 = 0; e8 < 8; ++e8) {
                    const int e0 = 16 * (8 * eh + e8) + 4 * lg;
                    const f32x4 gn = *(const f32x4*)(ng + h * 256 + e0); const s16x4 ov = *(const s16x4*)(PROJ + tok * NPROJ + PC_MO + h * 256 + e0); float o[4];
#pragma unroll
                    for (int r = 0; r < 4; ++r) o[r] = sigm(bf2f((unsigned short)ov[r])) * tot[e8][r] * rstd * gn[r];
                    u32x2 ww; ww.x = pk2(o[0], o[1]); ww.y = pk2(o[2], o[3]); *(u32x2*)(Y + tok * 4096 + 3072 + h * 256 + e0) = ww;
                }
            }
        }
    }
}

#ifndef HIPEMU
namespace pg8 {
constexpr int BM = 256, BK = 64, HALF = 128, HTB = HALF * BK * 2, STAGE_BYTES = 8 * HTB, NXCD = 8, WGM = 8;
__host__ __device__ __forceinline__ int lds_byte(int r, int c) { const int st = (r >> 4) * 2 + (c >> 5), rr = r & 15, cc = c & 31, ob = rr * 64 + cc * 2; return st * 1024 + (ob ^ (((ob >> 9) & 1) << 5)); }
__host__ __device__ __forceinline__ void stage_rc(int b, int& R, int& C) { const int st = b / 1024, sb = b % 1024, swz = sb ^ (((sb >> 9) & 1) << 5); R = (st >> 1) * 16 + swz / 64; C = (st & 1) * 32 + (swz % 64) / 2; }
__host__ __device__ __forceinline__ int perm32(int rho) { const int n = rho >> 4, i = rho & 15; return 8 * (i >> 2) + 4 * n + (i & 3); }
struct Unit { int pm, pn; };
struct Gemm { const bf16_t* A; const bf16_t* Bt; int M, N, K; };
struct StaticOrder {
    int nM, nN, nwg, G, c;
    __host__ __device__ void init(int M, int N, int G_, int c_) { nM = M / BM; nN = N / BM; nwg = nM * nN; G = G_; c = c_; }
    __host__ __device__ bool next(int i, Unit& u) const {
        const long L = (long)i * G + c; if (L >= nwg) return false;
        int wgid = (int)L; { const int q = nwg / NXCD, r = nwg % NXCD, xcd = wgid % NXCD, off = wgid / NXCD; wgid = (xcd < r ? xcd * (q + 1) : r * (q + 1) + (xcd - r) * q) + off; }
        const int nig = WGM * nN, gid = wgid / nig, fm = gid * WGM, gsz = (nM - fm) < WGM ? (nM - fm) : WGM;
        u.pm = fm + ((wgid % nig) % gsz); u.pn = (wgid % nig) / gsz; return true;
    }
    __device__ __forceinline__ void a_ready(const Unit&) const {}
    __device__ __forceinline__ void done(const Unit&) const {}
};
struct EpiStoreBf16 {
    static constexpr bool PERM = true, AFTER_DRAIN = false;
    bf16_t* O; int ldc;
    __device__ __forceinline__ void operator()(const f32x4 (&acc)[2][2][4][2], const Unit& u, int wr, int wc, int fr, int fq) const {
        const int row0 = u.pm * BM + wr * 64 + fr, col0 = u.pn * BM + wc * 32 + 8 * fq;
#pragma unroll
        for (int ai = 0; ai < 2; ++ai)
#pragma unroll
            for (int m = 0; m < 4; ++m) { bf16_t* rowp = O + (size_t)(row0 + ai * HALF + m * 16) * ldc + col0;
#pragma unroll
                for (int bj = 0; bj < 2; ++bj) { const f32x4 v0 = acc[ai][bj][m][0], v1 = acc[ai][bj][m][1];
                    u32x4 w; w.x = pk2(v0[0], v0[1]); w.y = pk2(v0[2], v0[3]); w.z = pk2(v1[0], v1[1]); w.w = pk2(v1[2], v1[3]);
                    *(u32x4*)(rowp + bj * HALF) = w; } }
    }
};
struct EpiSwiGLU {
    static constexpr bool PERM = true, AFTER_DRAIN = false;
    bf16_t* O; int ldc;
    __device__ __forceinline__ void operator()(const f32x4 (&acc)[2][2][4][2], const Unit& u, int wr, int wc, int fr, int fq) const {
        const int row0 = u.pm * BM + wr * 64 + fr, col0 = u.pn * HALF + wc * 32 + 8 * fq;
#pragma unroll
        for (int ai = 0; ai < 2; ++ai)
#pragma unroll
            for (int m = 0; m < 4; ++m) { bf16_t* rowp = O + (size_t)(row0 + ai * HALF + m * 16) * ldc + col0; float o[8];
#pragma unroll
                for (int n = 0; n < 2; ++n)
#pragma unroll
                    for (int j = 0; j < 4; ++j) { const float a = acc[ai][0][m][n][j], b = acc[ai][1][m][n][j]; o[4 * n + j] = a * __builtin_amdgcn_rcpf(1.f + __builtin_amdgcn_exp2f(a * -1.4426950408889634f)) * b; }
                u32x4 w; w.x = pk2(o[0], o[1]); w.y = pk2(o[2], o[3]); w.z = pk2(o[4], o[5]); w.w = pk2(o[6], o[7]);
                *(u32x4*)rowp = w; }
    }
};
struct EpiResid {
    static constexpr bool PERM = false, AFTER_DRAIN = false;
    const float* xin; float* xout; const float* gate; int ldc;
    __device__ __forceinline__ void operator()(const f32x4 (&acc)[2][2][4][2], const Unit& u, int wr, int wc, int fr, int fq) const {
        const int row0 = u.pm * BM + wr * 64 + fr, col0 = u.pn * BM + wc * 32 + 4 * fq;
        f32x4 gv[2][2];
#pragma unroll
        for (int bj = 0; bj < 2; ++bj)
#pragma unroll
            for (int n = 0; n < 2; ++n) gv[bj][n] = *(const f32x4*)(gate + col0 + bj * HALF + n * 16);
#pragma unroll
        for (int ai = 0; ai < 2; ++ai)
#pragma unroll
            for (int m2 = 0; m2 < 2; ++m2) { f32x4 xi[2][2][2];
#pragma unroll
                for (int mm = 0; mm < 2; ++mm)
#pragma unroll
                    for (int bj = 0; bj < 2; ++bj)
#pragma unroll
                        for (int n = 0; n < 2; ++n) xi[mm][bj][n] = *(const f32x4*)(xin + (size_t)(row0 + ai * HALF + (2 * m2 + mm) * 16) * ldc + col0 + bj * HALF + n * 16);
                asm volatile("s_waitcnt vmcnt(0)" ::: "memory");
#pragma unroll
                for (int mm = 0; mm < 2; ++mm)
#pragma unroll
                    for (int bj = 0; bj < 2; ++bj)
#pragma unroll
                        for (int n = 0; n < 2; ++n) *(f32x4*)(xout + (size_t)(row0 + ai * HALF + (2 * m2 + mm) * 16) * ldc + col0 + bj * HALF + n * 16) = xi[mm][bj][n] + gv[bj][n] * acc[ai][bj][2 * m2 + mm][n]; }
    }
};
template <class Epi, class Sched, bool ALIGN_EPI = false, bool SP2 = false>
__device__ __forceinline__ void gemm_phase(ldsp lds, const Gemm g, const Sched& S, const Epi& E) {
    const int tid = threadIdx.x, wid = __builtin_amdgcn_readfirstlane(tid >> 6), lane = tid & 63, wr = wid >> 2, wc = wid & 3, fr = lane & 15, fq = lane >> 4;
    const int K = g.K, nt = K / BK;
    unsigned voffA[2], voffB[2];
#pragma unroll
    for (int i = 0; i < 2; ++i) { int R, C; stage_rc(tid * 16 + i * 8192, R, C); const int Rb = Epi::PERM ? ((R & ~31) + perm32(R & 31)) : R;
        voffA[i] = (unsigned)(R * K + C) * 2u; voffB[i] = (unsigned)(Rb * K + C) * 2u; }
    const size_t kstep = (size_t)(BK * 2);
    const size_t hstep = (size_t)HALF * K * 2;
    const size_t tstep = 2 * hstep;
    const unsigned ldsw = (unsigned)wid * 1024u;
    const int aoff = lds_byte(wr * 64 + fr, fq * 8), boff = lds_byte(wc * 32 + fr, fq * 8);
#define PG8_SA(b, h) (((b) * 2 + (h)) * HTB)
#define PG8_SB(b, h) ((4 + (b) * 2 + (h)) * HTB)
#define PG8_STAGE(bufoff, gbase, voff) do { _Pragma("unroll") for (int _i = 0; _i < 2; ++_i) \
        __builtin_amdgcn_global_load_lds((const unsigned*)((const char*)(gbase) + (voff)[_i]), (LAS unsigned*)(lds + (bufoff) + ldsw + _i * 8192), 16, 0, 0); } while (0)
#define PG8_LDA(dst, b, h) do { _Pragma("unroll") for (int m = 0; m < 4; ++m) _Pragma("unroll") for (int k = 0; k < 2; ++k) dst[m][k] = *(const LAS bf16x8*)(lds + PG8_SA(b, h) + aoff + m * 2048 + k * 1024); } while (0)
#define PG8_LDB(dst, b, h) do { _Pragma("unroll") for (int n = 0; n < 2; ++n) _Pragma("unroll") for (int k = 0; k < 2; ++k) dst[n][k] = *(const LAS bf16x8*)(lds + PG8_SB(b, h) + boff + n * 2048 + k * 1024); } while (0)
#define PG8_MMA(ai, bj, At, Bt) do { __builtin_amdgcn_s_setprio(1); _Pragma("unroll") for (int m = 0; m < 4; ++m) _Pragma("unroll") for (int n = 0; n < 2; ++n) _Pragma("unroll") for (int k = 0; k < 2; ++k) \
        acc[ai][bj][m][n] = __builtin_amdgcn_mfma_f32_16x16x32_bf16(Bt[n][k], At[m][k], acc[ai][bj][m][n], 0, 0, 0); __builtin_amdgcn_s_setprio(0); } while (0)
#define PG8_WAIT_V(n) asm volatile("s_waitcnt vmcnt(" #n ")" ::: "memory")
#define PG8_WAIT_L(n) asm volatile("s_waitcnt lgkmcnt(" #n ")" ::: "memory")
#define PG8_BAR __builtin_amdgcn_s_barrier()
#define PG8_SCHED __builtin_amdgcn_sched_barrier(0)
    Unit cur, nxt; int ui = 0;
    if (!S.next(0, cur)) return;
    f32x4 acc[2][2][4][2];
#pragma unroll
    for (int a = 0; a < 2; ++a)
#pragma unroll
        for (int b = 0; b < 2; ++b)
#pragma unroll
            for (int m = 0; m < 4; ++m)
#pragma unroll
                for (int n = 0; n < 2; ++n) acc[a][b][m][n] = (f32x4){0.f, 0.f, 0.f, 0.f};
    bf16x8 At[4][2], B0[2][2], B1[2][2];
    const char* cA = (const char*)g.A + (size_t)cur.pm * tstep; const char* cB = (const char*)g.Bt + (size_t)cur.pn * tstep;
    S.a_ready(cur);
    if constexpr (SP2) {
        PG8_STAGE(PG8_SB(0, 0), cB, voffB); PG8_STAGE(PG8_SB(0, 1), cB + hstep, voffB); PG8_STAGE(PG8_SA(0, 0), cA, voffA); PG8_STAGE(PG8_SA(0, 1), cA + hstep, voffA);
        if (wr == 1) PG8_BAR;
        PG8_WAIT_V(2); PG8_BAR;
        PG8_STAGE(PG8_SB(1, 0), cB + kstep, voffB); PG8_STAGE(PG8_SA(1, 0), cA + kstep, voffA); PG8_STAGE(PG8_SB(1, 1), cB + hstep + kstep, voffB);
        PG8_WAIT_V(6); PG8_BAR;
    } else {
        PG8_STAGE(PG8_SB(0, 0), cB, voffB); PG8_STAGE(PG8_SA(0, 0), cA, voffA); PG8_STAGE(PG8_SB(0, 1), cB + hstep, voffB); PG8_STAGE(PG8_SA(0, 1), cA + hstep, voffA);
        if (wr == 1) PG8_BAR;
        PG8_WAIT_V(4); PG8_BAR;
        PG8_STAGE(PG8_SB(1, 0), cB + kstep, voffB); PG8_STAGE(PG8_SA(1, 0), cA + kstep, voffA); PG8_STAGE(PG8_SB(1, 1), cB + hstep + kstep, voffB);
        PG8_WAIT_V(6); PG8_BAR;
    }
    for (;;) {
        const bool has_next = S.next(ui + 1, nxt);
        const char* nA = has_next ? (const char*)g.A + (size_t)nxt.pm * tstep : cA; const char* nB = has_next ? (const char*)g.Bt + (size_t)nxt.pn * tstep : cB;
        for (int t = 0; t < nt; t += 2) {
            const bool last = (t == nt - 2);
            const char* a1 = cA + (size_t)(t + 1) * kstep;
            const char* a2 = last ? nA : cA + (size_t)(t + 2) * kstep; const char* b2 = last ? nB : cB + (size_t)(t + 2) * kstep;
            const char* a3 = a2 + kstep; const char* b3 = b2 + kstep;
            if (last && has_next) S.a_ready(nxt);
            if constexpr (SP2) {
            PG8_LDB(B0, 0, 0); PG8_LDB(B1, 0, 1); PG8_SCHED; PG8_LDA(At, 0, 0); PG8_STAGE(PG8_SA(1, 1), a1 + hstep, voffA);
            PG8_WAIT_V(8); PG8_WAIT_L(0); PG8_BAR; PG8_MMA(0, 0, At, B0); PG8_MMA(0, 1, At, B1); PG8_BAR; PG8_SCHED;
            PG8_LDA(At, 0, 1); PG8_STAGE(PG8_SB(0, 0), b2, voffB); PG8_STAGE(PG8_SB(0, 1), b2 + hstep, voffB); PG8_STAGE(PG8_SA(0, 0), a2, voffA);
            PG8_WAIT_V(8); PG8_WAIT_L(0); PG8_BAR; PG8_MMA(1, 0, At, B0); PG8_MMA(1, 1, At, B1); PG8_BAR; PG8_SCHED;
            PG8_LDB(B0, 1, 0); PG8_LDB(B1, 1, 1); PG8_SCHED; PG8_LDA(At, 1, 0); PG8_STAGE(PG8_SA(0, 1), a2 + hstep, voffA);
            PG8_WAIT_V(8); PG8_WAIT_L(0); PG8_BAR; PG8_MMA(0, 0, At, B0); PG8_MMA(0, 1, At, B1); PG8_BAR; PG8_SCHED;
            PG8_LDA(At, 1, 1); PG8_STAGE(PG8_SB(1, 0), b3, voffB); PG8_STAGE(PG8_SB(1, 1), b3 + hstep, voffB); PG8_STAGE(PG8_SA(1, 0), a3, voffA);
            PG8_WAIT_V(8); PG8_WAIT_L(0); PG8_BAR; PG8_MMA(1, 0, At, B0); PG8_MMA(1, 1, At, B1); PG8_BAR; PG8_SCHED;
            } else {
            PG8_LDB(B0, 0, 0); PG8_SCHED; PG8_LDA(At, 0, 0); PG8_STAGE(PG8_SA(1, 1), a1 + hstep, voffA);
            PG8_WAIT_L(8); PG8_BAR; PG8_WAIT_L(0); PG8_MMA(0, 0, At, B0); PG8_BAR; PG8_SCHED;
            PG8_LDB(B1, 0, 1); PG8_STAGE(PG8_SB(0, 0), b2, voffB);
            PG8_BAR; PG8_WAIT_L(0); PG8_MMA(0, 1, At, B1); PG8_BAR;
            PG8_LDA(At, 0, 1); PG8_STAGE(PG8_SA(0, 0), a2, voffA);
            PG8_BAR; PG8_WAIT_L(0); PG8_MMA(1, 0, At, B0); PG8_BAR; PG8_SCHED;
            PG8_STAGE(PG8_SB(0, 1), b2 + hstep, voffB);
            PG8_WAIT_V(6); PG8_BAR; PG8_MMA(1, 1, At, B1); PG8_BAR;
            PG8_LDB(B0, 1, 0); PG8_SCHED; PG8_LDA(At, 1, 0); PG8_STAGE(PG8_SA(0, 1), a2 + hstep, voffA);
            PG8_WAIT_L(8); PG8_BAR; PG8_WAIT_L(0); PG8_MMA(0, 0, At, B0); PG8_BAR; PG8_SCHED;
            PG8_LDB(B1, 1, 1); PG8_STAGE(PG8_SB(1, 0), b3, voffB);
            PG8_BAR; PG8_WAIT_L(0); PG8_MMA(0, 1, At, B1); PG8_BAR;
            PG8_LDA(At, 1, 1); PG8_STAGE(PG8_SA(1, 0), a3, voffA);
            PG8_BAR; PG8_WAIT_L(0); PG8_MMA(1, 0, At, B0); PG8_BAR; PG8_SCHED;
            PG8_STAGE(PG8_SB(1, 1), b3 + hstep, voffB);
            PG8_WAIT_V(6); PG8_BAR; PG8_MMA(1, 1, At, B1); PG8_BAR;
            }
        }
        if constexpr (ALIGN_EPI) { if (wr == 0) PG8_BAR; }
        if constexpr (!Epi::AFTER_DRAIN) { E(acc, cur, wr, wc, fr, fq); S.done(cur); }
        if (!has_next) break;
#pragma unroll
        for (int a = 0; a < 2; ++a)
#pragma unroll
            for (int b = 0; b < 2; ++b)
#pragma unroll
                for (int m = 0; m < 4; ++m)
#pragma unroll
                    for (int n = 0; n < 2; ++n) acc[a][b][m][n] = (f32x4){0.f, 0.f, 0.f, 0.f};
        cur = nxt; cA = nA; cB = nB; ++ui;
        if constexpr (ALIGN_EPI) { if (wr == 1) PG8_BAR; }
    }
    PG8_WAIT_V(0);
    if constexpr (!ALIGN_EPI) { if (wr == 0) PG8_BAR; }
    PG8_BAR;
    if constexpr (Epi::AFTER_DRAIN) { E.fused(acc, cur, wr, wc, fr, fq, lds, wid, lane); S.done(cur); }
#undef PG8_SA
#undef PG8_SB
#undef PG8_STAGE
#undef PG8_LDA
#undef PG8_LDB
#undef PG8_MMA
#undef PG8_WAIT_V
#undef PG8_WAIT_L
#undef PG8_BAR
#undef PG8_SCHED
}
}

#define XB_TMO      128
#define XB_XCNT(j)  (256  + 64 * (j))
#define XB_XSUB(j)  (1280 + 64 * (j))
#define XB_XGEN(j)  (2304 + 64 * (j))
#define XB_TOP      3328
#define XB_TOPGEN   3392
#define XCD_BAR_WORDS 3456
#define XB_SPIN_CAP (1u << 22)
__device__ __forceinline__ unsigned xb_ld(unsigned* p)              { return __hip_atomic_load(p, __ATOMIC_RELAXED, __HIP_MEMORY_SCOPE_AGENT); }
__device__ __forceinline__ unsigned xb_add(unsigned* p, unsigned v) { return __hip_atomic_fetch_add(p, v, __ATOMIC_RELAXED, __HIP_MEMORY_SCOPE_AGENT); }
__device__ __forceinline__ unsigned xb_xcc_id() { return (unsigned)__builtin_amdgcn_s_getreg((3 << 11) | 20) & 0xFu; }
#define XB_SPIN(cond, bar) do { unsigned _sp = 0; while (cond) { __builtin_amdgcn_s_sleep(1); \
    if ((++_sp & 255u) == 0u) { if (xb_ld(&(bar)[XB_TMO])) break; if (_sp > XB_SPIN_CAP) { atomicAdd(&(bar)[XB_TMO], 1u); break; } } } } while (0)
struct XcdBarrier { unsigned* bar; unsigned x; volatile LAS unsigned* st; };
__device__ __forceinline__ XcdBarrier xcd_barrier_post(unsigned* bar, volatile LAS unsigned* st) {
    XcdBarrier b; b.bar = bar; b.x = xb_xcc_id(); b.st = st;
    if (threadIdx.x == 0) (void)xb_add(&bar[XB_XCNT(b.x)], 1u);
    return b;
}
__device__ __forceinline__ void xcd_barrier_complete(unsigned* bar, unsigned x, unsigned& nloc, unsigned& nx) {
    const unsigned G = gridDim.x * gridDim.y * gridDim.z;
    unsigned sum, cnt, mine, sp = 0u;
    for (;;) {
        sum = 0u; cnt = 0u; mine = 0u;
#pragma unroll
        for (unsigned j = 0; j < 16; ++j) { const unsigned c = xb_ld(&bar[XB_XCNT(j)]); sum += c; cnt += (c > 0u) ? 1u : 0u; mine = (j == x) ? c : mine; }
        if (sum == G) break;
        __builtin_amdgcn_s_sleep(1);
        if ((++sp & 255u) == 0u) { if (xb_ld(&bar[XB_TMO])) break; if (sp > XB_SPIN_CAP) { atomicAdd(&bar[XB_TMO], 1u); break; } }
    }
    nloc = mine > 0u ? mine : 1u; nx = cnt > 0u ? cnt : 1u;
}
__device__ __forceinline__ void xcd_barrier(const XcdBarrier& b) {
    asm volatile("s_waitcnt vmcnt(0)" ::: "memory");
    __syncthreads();
    if (threadIdx.x == 0) {
        unsigned* bar = b.bar;
        __builtin_amdgcn_s_waitcnt(0);
        unsigned nloc = b.st[0], nx = b.st[1];
        if (nloc == 0u) { xcd_barrier_complete(bar, b.x, nloc, nx); b.st[0] = nloc; b.st[1] = nx; }
        const unsigned old = xb_add(&bar[XB_XSUB(b.x)], 1u);
        const unsigned gen = old / nloc;
        if (old + 1u == (gen + 1u) * nloc) {
            __builtin_amdgcn_fence(__ATOMIC_RELEASE, "agent");
            asm volatile("s_waitcnt vmcnt(0)" ::: "memory");
            const unsigned og = xb_add(&bar[XB_TOP], 1u);
            const unsigned tg = og / nx;
            if (og + 1u == (tg + 1u) * nx) xb_add(&bar[XB_TOPGEN], 1u);
            else XB_SPIN(xb_ld(&bar[XB_TOPGEN]) == tg, bar);
            __builtin_amdgcn_fence(__ATOMIC_ACQUIRE, "agent");
            xb_add(&bar[XB_XGEN(b.x)], 1u);
            asm volatile("s_waitcnt vmcnt(0)" ::: "memory");
        } else {
            XB_SPIN(xb_ld(&bar[XB_XGEN(b.x)]) == gen, bar);
            __builtin_amdgcn_fence(__ATOMIC_ACQUIRE, "agent");
            asm volatile("s_waitcnt vmcnt(0)" ::: "memory");
        }
    }
    __syncthreads();
}
#endif

constexpr int NPHASE = 11;
#ifndef GEMM_SP2
#define GEMM_SP2 true
#endif
#ifndef GEMM_ALIGN
#define GEMM_ALIGN true
#endif
#ifndef ONLY_MASK
#define ONLY_MASK 0xFFFFFFFFull
#endif
#define EN(k) if constexpr ((((unsigned long long)(ONLY_MASK)) >> (k)) & 1ull)
#ifndef HIPEMU
typedef XcdBarrier BarT;
#define SYNC() do { if (p.use_bar) xcd_barrier(bar); } while (0)
#else
typedef int BarT;
#define SYNC() do { } while (0)
#endif
#define IN(k) (p.ph_lo <= (k) && (k) < p.ph_hi)
template <int l> DI void layer_body(const Params& p, ldsp lds, const BarT& bar) {
        unsigned char* const ws_ = WSP();
        const float* xin = (l == 0) ? INP(I_X) : OUTP();
        if (IN(0)) {
#ifndef HIPEMU
            EN(0) { if (l == 0) { phase_mod(lds); SYNC(); } }
            const bool alt_first = ((blockIdx.x >> 3) & 1) != 0;
            if (alt_first) { if constexpr (l == 0) { EN(2) phase_hy_filt(l, lds); } else { EN(7) phase_hy_fftf(lds); } }
            if constexpr (l == 0) { EN(1) phase_wconv(l, lds); }
            EN(3) phase_norm(lds, xin, l, 0);
            if (!alt_first) { if constexpr (l == 0) { EN(2) phase_hy_filt(l, lds); } else { EN(7) phase_hy_fftf(lds); } }
#else
            EN(2) phase_hy_filt(l, lds);
#endif
            SYNC();
        }
#ifndef HIPEMU
        if (IN(2)) {
            EN(4) phase_gates(lds, l);
            EN(5) { pg8::Gemm g{(const bf16_t*)(ws_ + wset_off(l) + WS_WTIN), (const bf16_t*)(ws_ + WS_H), NHY, SEQ, 4096}; pg8::StaticOrder S; S.init(NHY, SEQ, gridDim.x, blockIdx.x);
              pg8::EpiStoreBf16 E{(bf16_t*)(ws_ + WS_UT), SEQ}; pg8::gemm_phase<decltype(E), pg8::StaticOrder, GEMM_ALIGN, GEMM_SP2>(lds, g, S, E); }
            EN(6) { pg8::Gemm g{(const bf16_t*)(ws_ + WS_H), (const bf16_t*)(ws_ + wset_off(l) + WS_WTIN) + (size_t)NHY * 4096, SEQ, NPROJ, 4096}; pg8::StaticOrder S; S.init(SEQ, NPROJ, gridDim.x, blockIdx.x);
              pg8::EpiStoreBf16 E{(bf16_t*)(ws_ + WS_PROJ), NPROJ}; pg8::gemm_phase<decltype(E), pg8::StaticOrder, GEMM_ALIGN, GEMM_SP2>(lds, g, S, E); }
            SYNC();
        }
#endif
        if (IN(3)) {
#ifndef HIPEMU
            const bool wc_first = ((blockIdx.x >> 3) & 1) != 0;
            if (wc_first) { if constexpr (l < 3) { EN(1) phase_wconv(l + 1, lds); } }
#endif
            if constexpr (l == 0) { EN(7) phase_hy_fftf(lds); } EN(8) phase_ret_kv(l, lds); EN(9) phase_ml_kv(l, lds); EN(10) phase_att(l, lds);
#ifndef HIPEMU
            if (!wc_first) { if constexpr (l < 3) { EN(1) phase_wconv(l + 1, lds); } }
#endif
            SYNC(); }
        if (IN(4)) {
            const bool conv_first = ((blockIdx.x >> 3) & 1) != 0;
            if (conv_first) { EN(14) phase_hy_conv(l, lds); }
            EN(11) phase_ret_scan(lds, l); EN(12) phase_ml_scan(lds); EN(13) phase_att_merge(lds);
            if (!conv_first) { EN(14) phase_hy_conv(l, lds); }
            SYNC(); }
        if (IN(5)) { EN(15) phase_ret_out(l, lds); EN(16) phase_ml_out(l, lds); EN(17) phase_hy_out(lds); SYNC(); }
#ifndef HIPEMU
        if (IN(7)) EN(19) {
            pg8::Gemm g{(const bf16_t*)(ws_ + WS_Y), (const bf16_t*)(ws_ + wset_off(l) + WS_WTOUT), SEQ, 4096, 4096}; pg8::StaticOrder S; S.init(SEQ, 4096, gridDim.x, blockIdx.x);
            pg8::EpiResid E{xin, OUTP(), (const float*)(ws_ + WS_MOD) + l * 24576 + 8192, 4096}; pg8::gemm_phase<decltype(E), pg8::StaticOrder, GEMM_ALIGN, GEMM_SP2>(lds, g, S, E);
            SYNC();
        }
        if (IN(8)) {
            const bool alt_first = ((blockIdx.x >> 3) & 1) != 0;
            if (alt_first) { if constexpr (l < 3) { EN(2) phase_hy_filt(l + 1, lds); } }
            EN(20) phase_norm(lds, OUTP(), l, 1);
            if (!alt_first) { if constexpr (l < 3) { EN(2) phase_hy_filt(l + 1, lds); } }
            SYNC(); }
        if (IN(9)) EN(21) {
            pg8::Gemm g{(const bf16_t*)(ws_ + WS_H), (const bf16_t*)(ws_ + wset_off(l) + WS_WT13), SEQ, 2 * FFN, 4096}; pg8::StaticOrder S; S.init(SEQ, 2 * FFN, gridDim.x, blockIdx.x);
            pg8::EpiSwiGLU E{(bf16_t*)(ws_ + WS_ACT), FFN}; pg8::gemm_phase<decltype(E), pg8::StaticOrder, GEMM_ALIGN, GEMM_SP2>(lds, g, S, E);
            SYNC();
        }
        if (IN(10)) EN(22) {
            pg8::Gemm g{(const bf16_t*)(ws_ + WS_ACT), (const bf16_t*)(ws_ + wset_off(l) + WS_WT2), SEQ, 4096, FFN}; pg8::StaticOrder S; S.init(SEQ, 4096, gridDim.x, blockIdx.x);
            pg8::EpiResid E{OUTP(), OUTP(), (const float*)(ws_ + WS_MOD) + l * 24576 + 20480, 4096}; pg8::gemm_phase<decltype(E), pg8::StaticOrder, GEMM_ALIGN, GEMM_SP2>(lds, g, S, E);
            SYNC();
        }
#endif
}
__global__ void __launch_bounds__(512, 2) mega(Params p) {
#ifndef HIPEMU
    extern __shared__ __attribute__((aligned(16))) unsigned char lds_raw[];
    ldsp lds = (ldsp)lds_raw;
    XcdBarrier bar; bar.bar = (unsigned*)(p.ws + WS_BAR); bar.x = 0; bar.st = nullptr;
    if (p.use_bar) {
        if (threadIdx.x == 0) { *(volatile LAS unsigned*)(lds + LDS_BARW) = 0u; *(volatile LAS unsigned*)(lds + LDS_BARW + 4) = 0u; }
        __syncthreads();
        bar = xcd_barrier_post((unsigned*)(p.ws + WS_BAR), (volatile LAS unsigned*)(lds + LDS_BARW));
    }
#else
    ldsp lds = emu_lds(); BarT bar = 0;
#endif
    if (threadIdx.x == 0) {
        LAS unsigned long long* pt = (LAS unsigned long long*)(lds + LDS_PTRS);
        pt[0] = (unsigned long long)p.in[0]; pt[1] = (unsigned long long)p.in[1]; pt[2] = (unsigned long long)p.in[2]; pt[3] = (unsigned long long)p.in[3]; pt[4] = (unsigned long long)p.in[4];
        pt[5] = (unsigned long long)p.in[5]; pt[6] = (unsigned long long)p.in[6]; pt[7] = (unsigned long long)p.in[7]; pt[8] = (unsigned long long)p.in[8]; pt[9] = (unsigned long long)p.in[9];
        pt[10] = (unsigned long long)p.in[10]; pt[11] = (unsigned long long)p.in[11]; pt[12] = (unsigned long long)p.in[12]; pt[13] = (unsigned long long)p.in[13]; pt[14] = (unsigned long long)p.in[14];
        pt[15] = (unsigned long long)p.in[15]; pt[16] = (unsigned long long)p.in[16]; pt[17] = (unsigned long long)p.in[17]; pt[18] = (unsigned long long)p.in[18]; pt[19] = (unsigned long long)p.in[19];
        pt[20] = (unsigned long long)p.in[20]; pt[21] = (unsigned long long)p.out; pt[22] = (unsigned long long)p.ws;
    }
    __syncthreads();
    if (0 >= p.lay_lo && 0 < p.lay_hi) layer_body<0>(p, lds, bar);
    if (1 >= p.lay_lo && 1 < p.lay_hi) layer_body<1>(p, lds, bar);
    if (2 >= p.lay_lo && 2 < p.lay_hi) layer_body<2>(p, lds, bar);
    if (3 >= p.lay_lo && 3 < p.lay_hi) layer_body<3>(p, lds, bar);
}
#undef IN
#undef SYNC


#ifndef HIPEMU
#ifndef MK_ONE_LAUNCH
#define MK_ONE_LAUNCH 1
#endif
extern "C" void kernel_launch(void* const* d_in, const int* in_sizes, int n_in, void* d_out, int out_size, void* d_ws, size_t ws_size, hipStream_t stream) {
    static int grid = 0;
    if (grid == 0) {
        if (n_in != 21 || out_size != SEQ * DM || ws_size < WS_END) { fprintf(stderr, "kernel_launch: unexpected shapes (n_in %d out %d ws %zu need %zu)\n", n_in, out_size, ws_size, (size_t)WS_END); grid = -1; return; }
        int dev = 0, cus = 0, per_cu = 0;
        if (hipGetDevice(&dev) != hipSuccess || hipDeviceGetAttribute(&cus, hipDeviceAttributeMultiprocessorCount, dev) != hipSuccess) { grid = -1; return; }
        if (hipFuncSetAttribute((const void*)mega, hipFuncAttributeMaxDynamicSharedMemorySize, LDS_BYTES) != hipSuccess) { fprintf(stderr, "kernel_launch: hipFuncSetAttribute failed\n"); grid = -1; return; }
        if (hipOccupancyMaxActiveBlocksPerMultiprocessor(&per_cu, (const void*)mega, 512, LDS_BYTES) != hipSuccess || per_cu < 1) { fprintf(stderr, "kernel_launch: occupancy query says %d\n", per_cu); (void)hipGetLastError(); }
        grid = cus;
    }
    if (grid < 0) return;
    Params p; memset(&p, 0, sizeof(p));
    for (int i = 0; i < 21; ++i) p.in[i] = (const float*)d_in[i];
    p.out = (float*)d_out; p.ws = (unsigned char*)d_ws;
#if MK_ONE_LAUNCH
    (void)hipMemsetAsync((char*)d_ws + WS_BAR, 0, 16384, stream);
    p.ph_lo = 0; p.ph_hi = NPHASE; p.lay_lo = 0; p.lay_hi = 4; p.use_bar = 1;
    hipLaunchKernelGGL(mega, dim3(grid), dim3(512), LDS_BYTES, stream, p);
#else
    for (int l = 0; l < 4; ++l)
        for (int ph = 0; ph < NPHASE; ++ph) { p.ph_lo = ph; p.ph_hi = ph + 1; p.lay_lo = l; p.lay_hi = l + 1; p.use_bar = 0; hipLaunchKernelGGL(mega, dim3(grid), dim3(512), LDS_BYTES, stream, p); }
#endif
}
#endif
```

```cpp
#ifndef HIPEMU
#include <hip/hip_runtime.h>
#endif
#include <cstdio>
#include <cstdint>
#include <cstring>
#include <cmath>

#ifndef HIPEMU
#define LAS __attribute__((address_space(3)))
#define GAS __attribute__((address_space(1)))
#else
#define LAS
#define GAS
#endif
#define DI __device__ __forceinline__

typedef unsigned short bf16_t;
typedef short bf16x8 __attribute__((ext_vector_type(8)));
typedef short s16x4 __attribute__((ext_vector_type(4)));
typedef float f32x4 __attribute__((ext_vector_type(4)));
typedef float f32x2 __attribute__((ext_vector_type(2)));
typedef unsigned u32x4 __attribute__((ext_vector_type(4)));
typedef unsigned u32x2 __attribute__((ext_vector_type(2)));
typedef LAS unsigned char* ldsp;

#ifdef EMU_SEQ
constexpr int SEQ = EMU_SEQ;
#else
constexpr int SEQ = 16384;
#endif
constexpr int DM = 4096, NPROJ = 9216, NHY = 3072, FFN = 11008, DIN = 12304;
constexpr int NCR = SEQ / 128;
constexpr int NCM = SEQ / 64;
constexpr int KFP = SEQ + 8;
constexpr int LOG4 = (SEQ == 16384) ? 7 : (SEQ == 4096) ? 6 : (SEQ == 1024) ? 5 : (SEQ == 256) ? 4 : -1;
static_assert(LOG4 > 0, "SEQ must be a power of 4");
constexpr float EPS = 1e-6f;
constexpr int PC_RQ = 0, PC_RK = 512, PC_RV = 1024, PC_RG = 2048, PC_AQ = 3072, PC_AK = 4096, PC_AV = 5120, PC_MQ = 6144, PC_MK = 6656, PC_MV = 7168, PC_MO = 8192;
enum { I_X = 0, I_C, I_ADAW, I_ADAB, I_ADAT, I_WIN, I_WOUT, I_HYS, I_HYW1, I_HYB1, I_HYW2, I_HYB2, I_HYW3, I_HYBIAS, I_RDEC, I_AGAIN, I_MGB, I_MNG, I_W1, I_W3, I_W2 };

constexpr size_t al256(size_t x) { return (x + 255) & ~(size_t)255; }
constexpr size_t WS_BAR = 0;
constexpr size_t WS_MOD = 16384;
constexpr size_t WS_G = WS_MOD + al256((size_t)4 * 24576 * 4);
constexpr size_t WS_WTG = WS_G + al256((size_t)SEQ * 16 * 4);
constexpr size_t WS_WTIN = WS_WTG + al256((size_t)16 * 4096 * 2);
constexpr size_t WS_WTOUT = WS_WTIN + al256((size_t)12288 * 4096 * 2);
constexpr size_t WS_WT13 = WS_WTOUT + al256((size_t)4096 * 4096 * 2);
constexpr size_t WS_WT2 = WS_WT13 + al256((size_t)22016 * 4096 * 2);
constexpr size_t WS_H = WS_WT2 + al256((size_t)4096 * 11008 * 2);
constexpr size_t WS_PROJ = WS_H + al256((size_t)SEQ * 4096 * 2);
constexpr size_t WS_UT = WS_PROJ + al256((size_t)SEQ * NPROJ * 2);
constexpr size_t WS_Y = WS_UT + al256((size_t)NHY * SEQ * 2);
constexpr size_t WS_ACT = WS_Y + al256((size_t)SEQ * 4096 * 2);
constexpr size_t WS_FILT = WS_ACT + al256((size_t)SEQ * FFN * 2);
constexpr size_t WS_KF = WS_FILT + al256((size_t)4096 * SEQ * 4);
constexpr size_t WS_Z1T = WS_KF + al256((size_t)2048 * KFP * 8);
constexpr size_t WS_Z2T = WS_Z1T + al256((size_t)1024 * SEQ * 4);
constexpr size_t WS_RKV = WS_Z2T + al256((size_t)1024 * SEQ * 4);
constexpr size_t WS_RST = WS_RKV + al256((size_t)8 * NCR * 32768 * 4);
constexpr size_t WS_OB = WS_RST + al256((size_t)8 * NCR * 32768 * 2);
constexpr size_t WS_LSE = WS_OB + al256((size_t)3 * SEQ * 1024 * 2);
constexpr size_t WS_MKV = WS_LSE + al256((size_t)3 * SEQ * 8 * 4);
constexpr size_t WS_MCT = WS_MKV + al256((size_t)8 * NCM * 32768 * 4);
constexpr size_t WS_KSUM = WS_MCT + al256((size_t)8 * NCM * 32768 * 2);
constexpr size_t WS_NPREV = WS_KSUM + al256((size_t)8 * NCM * 128 * 4);
constexpr size_t WS_MLOC = WS_NPREV + al256((size_t)8 * NCM * 128 * 4);
constexpr size_t WS_BLAST = WS_MLOC + al256((size_t)8 * NCM * 4);
constexpr size_t WS_MPREV = WS_BLAST + al256((size_t)8 * NCM * 4);
constexpr size_t WS_HDIR = WS_MPREV + al256((size_t)8 * NCM * 4);
constexpr size_t WS_RY = WS_HDIR + al256((size_t)2 * SEQ * 1024 * 4);
constexpr size_t WS_WSET2 = WS_RY + al256((size_t)SEQ * 1024 * 4);
constexpr size_t WS_WSET_BYTES = WS_H - WS_WTG;
constexpr size_t WS_END = WS_WSET2 + WS_WSET_BYTES;
constexpr size_t wset_off(int l) { return (l & 1) ? (WS_WSET2 - WS_WTG) : 0; }

constexpr int LDS_BYTES = 147456;
constexpr int LDS_BARW = LDS_BYTES - 16;
constexpr int LDS_PTRS = LDS_BARW - 256;

struct Params { const float* in[21]; float* out; unsigned char* ws; int ph_lo, ph_hi, lay_lo, lay_hi, use_bar, pad; };

DI bf16_t f2bf(float f) { unsigned u = __builtin_bit_cast(unsigned, f); u += 0x7FFFu + ((u >> 16) & 1u); return (bf16_t)(u >> 16); }
DI float bf2f(unsigned short b) { return __builtin_bit_cast(float, ((unsigned)b) << 16); }
DI unsigned pk2(float lo, float hi) {
#ifdef HIPEMU
    return (unsigned)f2bf(lo) | ((unsigned)f2bf(hi) << 16);
#else
    unsigned r; asm volatile("v_cvt_pk_bf16_f32 %0, %1, %2" : "=v"(r) : "v"(lo), "v"(hi)); return r;
#endif
}
DI f32x4 mfma16(bf16x8 a, bf16x8 b, f32x4 c) {
#ifdef HIPEMU
    return emu_mfma16(a, b, c);
#else
    return __builtin_amdgcn_mfma_f32_16x16x32_bf16(a, b, c, 0, 0, 0);
#endif
}
DI bf16x8 tr_read8(ldsp lds, unsigned off_a, unsigned off_b) {
#ifdef HIPEMU
    s16x4 lo = emu_tr_read(lds, off_a), hi = emu_tr_read(lds, off_b);
#else
    s16x4 lo, hi; const unsigned base = (unsigned)(uintptr_t)lds;
    asm volatile("ds_read_b64_tr_b16 %0, %2\n\tds_read_b64_tr_b16 %1, %3\n\ts_waitcnt lgkmcnt(0)" : "=&v"(lo), "=&v"(hi) : "v"(base + off_a), "v"(base + off_b) : "memory");
#endif
    return __builtin_shufflevector(lo, hi, 0, 1, 2, 3, 4, 5, 6, 7);
}
DI bf16x8 tr_frag(ldsp lds, unsigned tile_off, int pitch, int r0a, int r0b, int c0, int lr) {
    const int q = lr >> 2, pp = lr & 3;
    return tr_read8(lds, tile_off + (unsigned)((r0a + q) * pitch + (c0 + 4 * pp) * 2), tile_off + (unsigned)((r0b + q) * pitch + (c0 + 4 * pp) * 2));
}
struct TrF { s16x4 lo, hi; };
DI void tr_issue(ldsp lds, unsigned tile_off, int pitch, int r0a, int r0b, int c0, int lr, TrF& f) {
    const int q = lr >> 2, pp = lr & 3;
    const unsigned off_a = tile_off + (unsigned)((r0a + q) * pitch + (c0 + 4 * pp) * 2), off_b = tile_off + (unsigned)((r0b + q) * pitch + (c0 + 4 * pp) * 2);
#ifdef HIPEMU
    f.lo = emu_tr_read(lds, off_a); f.hi = emu_tr_read(lds, off_b);
#else
    const unsigned base = (unsigned)(uintptr_t)lds;
    asm volatile("ds_read_b64_tr_b16 %0, %2\n\tds_read_b64_tr_b16 %1, %3" : "=&v"(f.lo), "=&v"(f.hi) : "v"(base + off_a), "v"(base + off_b) : "memory");
#endif
}
DI void tr_wait2(TrF& a, TrF& b) {
#ifndef HIPEMU
    asm volatile("s_waitcnt lgkmcnt(0)" : "+v"(a.lo), "+v"(a.hi), "+v"(b.lo), "+v"(b.hi) :: "memory");
#endif
}
DI void tr_wait1(TrF& a) {
#ifndef HIPEMU
    asm volatile("s_waitcnt lgkmcnt(0)" : "+v"(a.lo), "+v"(a.hi) :: "memory");
#endif
}
DI bf16x8 tr_val(const TrF& f) { return __builtin_shufflevector(f.lo, f.hi, 0, 1, 2, 3, 4, 5, 6, 7); }
DI bf16x8 lds_row8(ldsp lds, unsigned off) { return *(const LAS bf16x8*)(lds + off); }
DI bf16x8 pack8(const f32x4& a, const f32x4& b) { u32x4 w; w.x = pk2(a[0], a[1]); w.y = pk2(a[2], a[3]); w.z = pk2(b[0], b[1]); w.w = pk2(b[2], b[3]); return __builtin_bit_cast(bf16x8, w); }
DI float wave_sum(float v) {
#pragma unroll
    for (int m = 32; m >= 1; m >>= 1) v += __shfl_xor(v, m);
    return v;
}
DI float wave_max(float v) {
#pragma unroll
    for (int m = 32; m >= 1; m >>= 1) v = fmaxf(v, __shfl_xor(v, m));
    return v;
}
DI float ld_xcu(const float* p) {
#ifdef HIPEMU
    return *p;
#else
    return __builtin_bit_cast(float, __hip_atomic_load((const unsigned*)p, __ATOMIC_RELAXED, __HIP_MEMORY_SCOPE_AGENT));
#endif
}
DI f32x2 ld_xcu2(const f32x2* p) {
#ifdef HIPEMU
    return *p;
#else
    return __builtin_bit_cast(f32x2, __hip_atomic_load((const unsigned long long*)p, __ATOMIC_RELAXED, __HIP_MEMORY_SCOPE_AGENT));
#endif
}
DI float fexp(float x) {
#ifdef HIPEMU
    return expf(x);
#else
    return __builtin_amdgcn_exp2f(x * 1.4426950408889634f);
#endif
}
DI float frcp(float x) {
#ifdef HIPEMU
    return 1.f / x;
#else
    return __builtin_amdgcn_rcpf(x);
#endif
}
DI float logsig(float x) { return x < 0.f ? x - log1pf(expf(x)) : -log1pf(expf(-x)); }
DI float sigm(float x) { return frcp(1.f + fexp(-x)); }
DI float dot4(const f32x4& a, const f32x4& b) { return a[0] * b[0] + a[1] * b[1] + a[2] * b[2] + a[3] * b[3]; }
DI f32x2 cmul(f32x2 a, f32x2 b) { f32x2 r; r.x = a.x * b.x - a.y * b.y; r.y = a.x * b.y + a.y * b.x; return r; }
DI f32x2 cmulc(f32x2 a, f32x2 b) { f32x2 r; r.x = a.x * b.x + a.y * b.y; r.y = a.y * b.x - a.x * b.y; return r; }
DI f32x2 cconj(f32x2 a) { f32x2 r; r.x = a.x; r.y = -a.y; return r; }
DI unsigned rev4(unsigned k) { const unsigned x = __builtin_bitreverse32(k) >> (32 - 2 * LOG4); return ((x & 0x55555555u) << 1) | ((x >> 1) & 0x55555555u); }

DI int opaque_tid() { int t = (int)threadIdx.x;
#ifndef HIPEMU
    asm volatile("" : "+v"(t));
#endif
    return t; }
#define TID (opaque_tid())
#ifdef HIPEMU
#define WAVE_SYNC() emu_wave_sync()
#else
#define WAVE_SYNC() __builtin_amdgcn_wave_barrier()
#endif
DI unsigned long long lds_ptr_bits(ldsp lds, int i) {
    const LAS unsigned* q = (const LAS unsigned*)(lds + LDS_PTRS + 8 * i); unsigned lo = q[0], hi = q[1];
#ifndef HIPEMU
    lo = __builtin_amdgcn_readfirstlane(lo); hi = __builtin_amdgcn_readfirstlane(hi);
#endif
    return ((unsigned long long)hi << 32) | lo;
}
#define INP(i) ((const float*)(GAS const float*)lds_ptr_bits(lds, (i)))
#define OUTP() ((float*)(GAS float*)lds_ptr_bits(lds, 21))
#define WSP() ((unsigned char*)(GAS unsigned char*)lds_ptr_bits(lds, 22))
DI unsigned char* opaque_ws(unsigned char* w) {
#ifndef HIPEMU
    asm volatile("" : "+s"(w));
#endif
    return w; }
#ifndef HIPEMU
#define MEMFENCE() asm volatile("" ::: "memory")
#else
#define MEMFENCE() do { } while (0)
#endif

DI void phase_mod(ldsp lds) {
    unsigned char* const ws_ = WSP();
    const float* c = INP(I_C); const float* ada_w = INP(I_ADAW); const float* ada_b = INP(I_ADAB); const float* ada_t = INP(I_ADAT);
    float* mod = (float*)(ws_ + WS_MOD);
    LAS float* sc = (LAS float*)lds; LAS float* red = sc + 4096;
    const int tid = TID;
    for (int i = tid; i < 4096; i += 512) { const float v = c[i]; sc[i] = v / (1.f + expf(-v)); }
    __syncthreads();
    for (int cb = blockIdx.x; cb < 256; cb += gridDim.x) {
        const int cv = tid % 24, ks = tid / 24;
        if (ks < 21) {
            f32x4 acc = {0.f, 0.f, 0.f, 0.f};
            for (int k = ks; k < 4096; k += 21) { const f32x4 w = *(const f32x4*)(ada_w + (size_t)k * 24576 + cb * 96 + 4 * cv); acc += w * sc[k]; }
#pragma unroll
            for (int j = 0; j < 4; ++j) red[ks * 96 + 4 * cv + j] = acc[j];
        }
        __syncthreads();
        if (tid < 96) {
            float s = 0.f;
            for (int k = 0; k < 21; ++k) s += red[k * 96 + tid];
            const int j = cb * 96 + tid; s += ada_b[j];
            for (int l = 0; l < 4; ++l) mod[l * 24576 + j] = s + ada_t[l * 24576 + j];
        }
        __syncthreads();
    }
}

template <class RowMap>
DI void wconv_tile(const float* src, int ldn, int K, int kt, int nt4, bf16_t* dst, RowMap rm, ldsp lds, int tid) {
    LAS float* T = (LAS float*)lds;
    const int k0 = kt * 64, n0 = nt4 * 256;
    f32x4 v[8];
#pragma unroll
    for (int i = 0; i < 8; ++i) { const int idx = tid + 512 * i, k = idx >> 6, n4 = idx & 63; v[i] = __builtin_nontemporal_load((const f32x4*)(src + (size_t)(k0 + k) * ldn + n0 + 4 * n4)); }
#pragma unroll
    for (int i = 0; i < 8; ++i) { const int idx = tid + 512 * i, k = idx >> 6, n4 = idx & 63;
#pragma unroll
        for (int j = 0; j < 4; ++j) T[(4 * n4 + j) * 65 + k] = v[i][j]; }
    __syncthreads();
#pragma unroll
    for (int i = 0; i < 4; ++i) {
        const int ch = tid + 512 * i, n = ch >> 3, kc = ch & 7; u32x4 o;
        o.x = pk2(T[n * 65 + 8 * kc + 0], T[n * 65 + 8 * kc + 1]); o.y = pk2(T[n * 65 + 8 * kc + 2], T[n * 65 + 8 * kc + 3]);
        o.z = pk2(T[n * 65 + 8 * kc + 4], T[n * 65 + 8 * kc + 5]); o.w = pk2(T[n * 65 + 8 * kc + 6], T[n * 65 + 8 * kc + 7]);
        *(u32x4*)(dst + (size_t)rm(n0 + n) * K + k0 + 8 * kc) = o;
    }
    __syncthreads();
}
DI void phase_wconv(int l, ldsp lds) {
    unsigned char* const ws_ = WSP();
    const float* w_in = INP(I_WIN) + (size_t)l * 4096 * DIN; const float* w_out = INP(I_WOUT) + (size_t)l * 4096 * 4096;
    const float* w1 = INP(I_W1) + (size_t)l * 4096 * FFN; const float* w3 = INP(I_W3) + (size_t)l * 4096 * FFN; const float* w2 = INP(I_W2) + (size_t)l * FFN * 4096;
    unsigned char* const wb_ = ws_ + wset_off(l);
    bf16_t* wt_in = (bf16_t*)(wb_ + WS_WTIN); bf16_t* wt_out = (bf16_t*)(wb_ + WS_WTOUT); bf16_t* wt13 = (bf16_t*)(wb_ + WS_WT13); bf16_t* wt2 = (bf16_t*)(wb_ + WS_WT2);
    bf16_t* wtg = (bf16_t*)(wb_ + WS_WTG);
    const int tid = TID;
    constexpr int T_IN = 64 * 48, T_OUT = 64 * 16, T_1 = 64 * 43, T_2 = 172 * 16, T_ALL = T_IN + T_OUT + 2 * T_1 + T_2;
    for (int t = blockIdx.x; t < T_ALL; t += gridDim.x) {
        if (t < T_IN) wconv_tile(w_in, DIN, 4096, t / 48, t % 48, wt_in, [](int n) { return n; }, lds, tid);
        else if (t < T_IN + T_OUT) { const int q = t - T_IN; wconv_tile(w_out, 4096, 4096, q / 16, q % 16, wt_out, [](int n) { return n; }, lds, tid); }
        else if (t < T_IN + T_OUT + T_1) { const int q = t - T_IN - T_OUT; wconv_tile(w1, FFN, 4096, q / 43, q % 43, wt13, [](int n) { return (n >> 7) * 256 + (n & 127); }, lds, tid); }
        else if (t < T_IN + T_OUT + 2 * T_1) { const int q = t - T_IN - T_OUT - T_1; wconv_tile(w3, FFN, 4096, q / 43, q % 43, wt13, [](int n) { return (n >> 7) * 256 + 128 + (n & 127); }, lds, tid); }
        else { const int q = t - T_IN - T_OUT - 2 * T_1; wconv_tile(w2, 4096, FFN, q / 16, q % 16, wt2, [](int n) { return n; }, lds, tid); }
    }
    for (int idx = blockIdx.x * 512 + tid; idx < 65536; idx += gridDim.x * 512) { const int k = idx >> 4, n = idx & 15; wtg[n * 4096 + k] = f2bf(w_in[(size_t)k * DIN + 12288 + n]); }
}

DI void phase_norm(ldsp lds, const float* xin, int l, int which) {
    unsigned char* const ws_ = WSP();
    const float* mod = (const float*)(ws_ + WS_MOD) + l * 24576; const float* sh = mod + which * 12288; const float* scv = mod + 4096 + which * 12288;
    bf16_t* H = (bf16_t*)(ws_ + WS_H);
    const int tid_ = TID; const int lane = tid_ & 63, wave = tid_ >> 6;
    for (int row = (blockIdx.x * 8 + wave) * 2; row < SEQ; row += gridDim.x * 16) {
        const float* xr = xin + (size_t)row * 4096; f32x4 v[2][16]; float ss0 = 0.f, ss1 = 0.f;
#pragma unroll
        for (int i = 0; i < 16; ++i) { v[0][i] = *(const f32x4*)(xr + 4 * (lane + 64 * i)); v[1][i] = *(const f32x4*)(xr + 4096 + 4 * (lane + 64 * i)); }
#pragma unroll
        for (int i = 0; i < 16; ++i) { ss0 += dot4(v[0][i], v[0][i]); ss1 += dot4(v[1][i], v[1][i]); }
        ss0 = wave_sum(ss0); ss1 = wave_sum(ss1);
        const float r0 = rsqrtf(ss0 * (1.f / 4096.f) + EPS), r1 = rsqrtf(ss1 * (1.f / 4096.f) + EPS);
#pragma unroll
        for (int i = 0; i < 16; ++i) {
            const int cc = 4 * (lane + 64 * i); const f32x4 s1 = *(const f32x4*)(scv + cc) + 1.f, s0 = *(const f32x4*)(sh + cc);
            const f32x4 o0 = v[0][i] * r0 * s1 + s0, o1 = v[1][i] * r1 * s1 + s0; u32x2 w0, w1; w0.x = pk2(o0[0], o0[1]); w0.y = pk2(o0[2], o0[3]); w1.x = pk2(o1[0], o1[1]); w1.y = pk2(o1[2], o1[3]);
            *(u32x2*)(H + (size_t)row * 4096 + cc) = w0; *(u32x2*)(H + (size_t)(row + 1) * 4096 + cc) = w1;
            if ((i & 3) == 3) MEMFENCE();
        }
    }
}

DI void phase_gates(ldsp lds, int l) {
    unsigned char* const ws_ = WSP();
    const bf16_t* H = (const bf16_t*)(ws_ + WS_H); const bf16_t* WG = (const bf16_t*)(ws_ + wset_off(l) + WS_WTG); float* G = (float*)(ws_ + WS_G);
    LAS float* red = (LAS float*)lds;
    const int tid = TID, lane = tid & 63, wave = tid >> 6, lr = lane & 15, lg = lane >> 4;
    for (int tile = blockIdx.x; tile < SEQ / 16; tile += gridDim.x) {
        f32x4 acc = {0.f, 0.f, 0.f, 0.f};
        const bf16_t* arow = H + (size_t)(tile * 16 + lr) * 4096 + wave * 512 + 8 * lg; const bf16_t* brow = WG + (size_t)lr * 4096 + wave * 512 + 8 * lg;
#pragma unroll 4
        for (int ks = 0; ks < 16; ++ks) { const bf16x8 a = *(const bf16x8*)(arow + 32 * ks); const bf16x8 b = *(const bf16x8*)(brow + 32 * ks); acc = mfma16(a, b, acc); }
#pragma unroll
        for (int r = 0; r < 4; ++r) red[wave * 256 + (4 * lg + r) * 16 + lr] = acc[r];
        __syncthreads();
        if (tid < 256) { float s = 0.f; for (int w = 0; w < 8; ++w) s += red[w * 256 + tid]; G[(size_t)tile * 256 + tid] = s; }
        __syncthreads();
    }
}

DI void phase_hy_filt(int l, ldsp lds) {
    unsigned char* const ws_ = WSP();
    const float* w1 = INP(I_HYW1) + l * 33 * 64; const float* b1 = INP(I_HYB1) + l * 64; const float* w2 = INP(I_HYW2) + l * 2 * 4096; const float* b2 = INP(I_HYB2) + l * 128;
    const float* w3 = INP(I_HYW3) + (size_t)l * 64 * 4096; float* FILT = (float*)(ws_ + WS_FILT);
    LAS float* z = (LAS float*)lds; LAS float* ha = z + 64 * 36; LAS float* hb = ha + 4096;
    const int tid = TID;
    const float min_decay = -4.605170185988091f / 1.5f, max_decay = -4.605170185988091f / 0.3f;
    for (int tt = blockIdx.x; tt < SEQ / 64; tt += gridDim.x) {
        const int tau0 = tt * 64;
        for (int idx = tid; idx < 64 * 33; idx += 512) {
            const int r = idx / 33, f = idx % 33, tau = tau0 + r; float val;
            if (f == 0) val = (float)tau / (float)(SEQ - 1);
            else { const int b = (f - 1) & 15; const float fr = 1e-4f + (float)b * ((15.f - 1e-4f) / 15.f); const float a = ((6.283185307179586f / (float)SEQ) * (float)tau) * fr; val = (f <= 16) ? cosf(a) : -sinf(a); }
            z[r * 36 + f] = val;
        }
        __syncthreads();
        for (int idx = tid; idx < 4096; idx += 512) { const int r = idx >> 6, o = idx & 63; float s = b1[o]; for (int f = 0; f < 33; ++f) s += z[r * 36 + f] * w1[f * 64 + o]; ha[r * 64 + o] = sinf(s); }
        __syncthreads();
        for (int idx = tid; idx < 4096; idx += 512) { const int r = idx >> 6, o = idx & 63; float s = b2[o]; for (int i = 0; i < 64; ++i) s += ha[r * 64 + i] * w2[i * 64 + o]; hb[r * 64 + o] = sinf(s); }
        __syncthreads();
        for (int idx = tid; idx < 4096; idx += 512) { const int r = idx >> 6, o = idx & 63; float s = b2[64 + o]; for (int i = 0; i < 64; ++i) s += hb[r * 64 + i] * w2[4096 + i * 64 + o]; ha[r * 64 + o] = sinf(s); }
        __syncthreads();
        {
            const int lane = tid & 63, wave = tid >> 6, lr = lane & 15, lg = lane >> 4;
            bf16x8 ahi[4][2], alo[4][2];
#pragma unroll
            for (int tt = 0; tt < 4; ++tt)
#pragma unroll
                for (int ks = 0; ks < 2; ++ks) {
                    const f32x4 x0 = *(const LAS f32x4*)(ha + (16 * tt + lr) * 64 + 32 * ks + 8 * lg), x1 = *(const LAS f32x4*)(ha + (16 * tt + lr) * 64 + 32 * ks + 8 * lg + 4);
                    f32x4 h0, h1, l0, l1;
#pragma unroll
                    for (int e = 0; e < 4; ++e) { h0[e] = bf2f(f2bf(x0[e])); h1[e] = bf2f(f2bf(x1[e])); l0[e] = x0[e] - h0[e]; l1[e] = x1[e] - h1[e]; }
                    ahi[tt][ks] = pack8(h0, h1); alo[tt][ks] = pack8(l0, l1);
                }
            f32x4 wn[2][2];
#pragma unroll
            for (int ks = 0; ks < 2; ++ks)
#pragma unroll
                for (int e = 0; e < 4; ++e) { wn[ks][0][e] = w3[(size_t)(32 * ks + 8 * lg + e) * 4096 + 16 * wave + lr]; wn[ks][1][e] = w3[(size_t)(32 * ks + 8 * lg + 4 + e) * 4096 + 16 * wave + lr]; }
#pragma unroll 1
            for (int ct = wave; ct < 256; ct += 8) {
                const int j = 16 * ct + lr, c = j & 1023;
                bf16x8 bhi[2], blo[2];
#pragma unroll
                for (int ks = 0; ks < 2; ++ks) {
                    const f32x4 x0 = wn[ks][0], x1 = wn[ks][1]; f32x4 h0, h1, l0, l1;
#pragma unroll
                    for (int e = 0; e < 4; ++e) { h0[e] = bf2f(f2bf(x0[e])); h1[e] = bf2f(f2bf(x1[e])); l0[e] = x0[e] - h0[e]; l1[e] = x1[e] - h1[e]; }
                    bhi[ks] = pack8(h0, h1); blo[ks] = pack8(l0, l1);
                }
                { const int jn = 16 * ((ct + 8 < 256) ? ct + 8 : ct) + lr;
#pragma unroll
                  for (int ks = 0; ks < 2; ++ks)
#pragma unroll
                      for (int e = 0; e < 4; ++e) { wn[ks][0][e] = w3[(size_t)(32 * ks + 8 * lg + e) * 4096 + jn]; wn[ks][1][e] = w3[(size_t)(32 * ks + 8 * lg + 4 + e) * 4096 + jn]; } }
                const float delta = fabsf(min_decay + (float)c * ((max_decay - min_decay) / 1023.f));
                LAS float* tw_ = hb + 4096 + wave * 1088;
#pragma unroll
                for (int tt = 0; tt < 4; ++tt) {
                    f32x4 acc = {0.f, 0.f, 0.f, 0.f};
#pragma unroll
                    for (int ks = 0; ks < 2; ++ks) { acc = mfma16(ahi[tt][ks], bhi[ks], acc); acc = mfma16(ahi[tt][ks], blo[ks], acc); acc = mfma16(alo[tt][ks], bhi[ks], acc); }
                    f32x4 o;
#pragma unroll
                    for (int r = 0; r < 4; ++r) { const float t = (float)(tau0 + 16 * tt + 4 * lg + r) / (float)(SEQ - 1); o[r] = acc[r] * fexp(-t * delta); }
                    *(LAS f32x4*)(tw_ + lr * 68 + 16 * tt + 4 * lg) = o;
                }
                WAVE_SYNC();
#pragma unroll
                for (int jj = 0; jj < 4; ++jj) {
                    const int col = 4 * jj + (lane >> 4), q4 = lane & 15;
                    const f32x4 o = *(const LAS f32x4*)(tw_ + col * 68 + 4 * q4);
                    *(f32x4*)(FILT + (size_t)(16 * ct + col) * SEQ + tau0 + 4 * q4) = o;
                }
                WAVE_SYNC();
            }
        }
        __syncthreads();
    }
}

constexpr int FFT_PADN = SEQ + (SEQ >> 6) * 4;
constexpr int FFT_X = 0, FFT_T1 = FFT_PADN * 8, FFT_T2 = FFT_T1 + 1024, FFT_SCR = FFT_T2 + 1024;
static_assert(FFT_SCR + 256 <= LDS_PTRS, "fft lds");
DI int fpad(int i) { return i + ((i >> 6) << 2); }
DI void fft_tables(ldsp lds) {
    LAS f32x2* T1 = (LAS f32x2*)(lds + FFT_T1); LAS f32x2* T2 = (LAS f32x2*)(lds + FFT_T2);
    const int tid = TID;
    if (tid < 128) { const double a = -6.283185307179586476925 * (double)((tid * 128) % SEQ) / (double)SEQ; f32x2 v; v.x = (float)cos(a); v.y = (float)sin(a); T1[tid] = v; }
    else if (tid < 256) { const double a = -6.283185307179586476925 * (double)(tid - 128) / (double)SEQ; f32x2 v; v.x = (float)cos(a); v.y = (float)sin(a); T2[tid - 128] = v; }
    __syncthreads();
}
DI f32x2 fft_tw(ldsp lds, int ti) { const LAS f32x2* T1 = (const LAS f32x2*)(lds + FFT_T1); const LAS f32x2* T2 = (const LAS f32x2*)(lds + FFT_T2); return cmul(T1[ti >> 7], T2[ti & 127]); }
DI void r4_fwd(f32x2& x0, f32x2& x1, f32x2& x2, f32x2& x3) {
    const f32x2 t0 = x0 + x2, t1 = x0 - x2, t2 = x1 + x3, d = x1 - x3; f32x2 t3; t3.x = d.y; t3.y = -d.x;
    x0 = t0 + t2; x1 = t1 + t3; x2 = t0 - t2; x3 = t1 - t3;
}
DI void r4_inv(f32x2& x0, f32x2& x1, f32x2& x2, f32x2& x3) {
    const f32x2 t0 = x0 + x2, t1 = x0 - x2, t2 = x1 + x3, d = x1 - x3; f32x2 t3; t3.x = -d.y; t3.y = d.x;
    x0 = t0 + t2; x1 = t1 + t3; x2 = t0 - t2; x3 = t1 - t3;
}
DI f32x2 w16c(int a) { f32x2 r; r.x = (a == 0) ? 1.f : (a == 1) ? 0.92387953251128674f : (a == 2) ? 0.70710678118654752f : 0.38268343236508977f;
    r.y = (a == 0) ? 0.f : (a == 1) ? -0.38268343236508977f : (a == 2) ? -0.70710678118654752f : -0.92387953251128674f; return r; }
template <int M, bool INV> DI void fft_r16(ldsp lds, int tid) {
    LAS f32x2* X = (LAS f32x2*)(lds + FFT_X);
    constexpr int Q4 = M / 16, QQ = M / 4;
    for (int u = tid; u < SEQ / 16; u += 512) {
        const int jp = u & (Q4 - 1), b = (u / Q4) * M + jp;
        constexpr int PA = (Q4 >= 64) ? (Q4 / 64) * 68 : Q4, PC = (QQ >= 64) ? (QQ / 64) * 68 : QQ;
        constexpr bool LIN = (M >= 1024 || M <= 64);
        LAS f32x2* Xb = X + fpad(b);
        f32x2 e[4][4];
#pragma unroll
        for (int c = 0; c < 4; ++c)
#pragma unroll
            for (int a = 0; a < 4; ++a) e[c][a] = LIN ? Xb[a * PA + c * PC] : X[fpad(b + a * Q4 + c * QQ)];
        const f32x2 w0 = fft_tw(lds, jp * (SEQ / M)); const f32x2 wb = fft_tw(lds, jp * (4 * (SEQ / M)));
        const f32x2 wb2 = cmul(wb, wb), wb3 = cmul(wb2, wb);
        if (!INV) {
#pragma unroll
            for (int a = 0; a < 4; ++a) {
                r4_fwd(e[0][a], e[1][a], e[2][a], e[3][a]);
                const f32x2 wa = cmul(w0, w16c(a)), wa2 = cmul(wa, wa), wa3 = cmul(wa2, wa);
                e[1][a] = cmul(e[1][a], wa); e[2][a] = cmul(e[2][a], wa2); e[3][a] = cmul(e[3][a], wa3);
            }
#pragma unroll
            for (int c = 0; c < 4; ++c) { r4_fwd(e[c][0], e[c][1], e[c][2], e[c][3]); e[c][1] = cmul(e[c][1], wb); e[c][2] = cmul(e[c][2], wb2); e[c][3] = cmul(e[c][3], wb3); }
        } else {
#pragma unroll
            for (int c = 0; c < 4; ++c) { e[c][1] = cmulc(e[c][1], wb); e[c][2] = cmulc(e[c][2], wb2); e[c][3] = cmulc(e[c][3], wb3); r4_inv(e[c][0], e[c][1], e[c][2], e[c][3]); }
#pragma unroll
            for (int a = 0; a < 4; ++a) {
                const f32x2 wa = cmul(w0, w16c(a)), wa2 = cmul(wa, wa), wa3 = cmul(wa2, wa);
                e[1][a] = cmulc(e[1][a], wa); e[2][a] = cmulc(e[2][a], wa2); e[3][a] = cmulc(e[3][a], wa3);
                r4_inv(e[0][a], e[1][a], e[2][a], e[3][a]);
            }
        }
#pragma unroll
        for (int c = 0; c < 4; ++c)
#pragma unroll
            for (int a = 0; a < 4; ++a) { if (LIN) Xb[a * PA + c * PC] = e[c][a]; else X[fpad(b + a * Q4 + c * QQ)] = e[c][a]; }
    }
    __syncthreads();
}
template <bool INV> DI void fft_r4_last(ldsp lds, int tid) {
    LAS f32x2* X = (LAS f32x2*)(lds + FFT_X);
    for (int u = tid; u < SEQ / 4; u += 512) {
        LAS f32x4* q = (LAS f32x4*)(X + fpad(4 * u)); const f32x4 lo = q[0], hi = q[1];
        f32x2 x0, x1, x2, x3; x0.x = lo[0]; x0.y = lo[1]; x1.x = lo[2]; x1.y = lo[3]; x2.x = hi[0]; x2.y = hi[1]; x3.x = hi[2]; x3.y = hi[3];
        if (!INV) r4_fwd(x0, x1, x2, x3); else r4_inv(x0, x1, x2, x3);
        f32x4 o0, o1; o0[0] = x0.x; o0[1] = x0.y; o0[2] = x1.x; o0[3] = x1.y; o1[0] = x2.x; o1[1] = x2.y; o1[2] = x3.x; o1[3] = x3.y; q[0] = o0; q[1] = o1;
    }
    __syncthreads();
}
DI void fft_dif(ldsp lds, int tid) {
    if constexpr (LOG4 >= 2) fft_r16<SEQ, false>(lds, tid);
    if constexpr (LOG4 >= 4) fft_r16<SEQ / 16, false>(lds, tid);
    if constexpr (LOG4 >= 6) fft_r16<SEQ / 256, false>(lds, tid);
    if constexpr (LOG4 & 1) fft_r4_last<false>(lds, tid);
}
DI void fft_dit_inv(ldsp lds, int tid) {
    if constexpr (LOG4 & 1) fft_r4_last<true>(lds, tid);
    if constexpr (LOG4 >= 6) fft_r16<SEQ / 256, true>(lds, tid);
    if constexpr (LOG4 >= 4) fft_r16<SEQ / 16, true>(lds, tid);
    if constexpr (LOG4 >= 2) fft_r16<SEQ, true>(lds, tid);
}
DI f32x2 fft_halfroot(ldsp lds, int k) { f32x2 w = fft_tw(lds, k >> 1); if (k & 1) { f32x2 h; h.x = (float)cos(3.14159265358979323846 / (double)SEQ); h.y = -(float)sin(3.14159265358979323846 / (double)SEQ); w = cmul(w, h); } return w; }

DI void phase_hy_fftf(ldsp lds) {
    unsigned char* const ws_ = WSP();
    const float* FILT = (const float*)(ws_ + WS_FILT); f32x2* KF = (f32x2*)(ws_ + WS_KF);
    LAS f32x2* X = (LAS f32x2*)(lds + FFT_X); LAS float* scr = (LAS float*)(lds + FFT_SCR);
    const int tid = TID, lane = tid & 63, wave = tid >> 6;
    fft_tables(lds);
    for (int u = blockIdx.x; u < 2048; u += gridDim.x) {
        const int o = u >> 10, c = u & 1023;
        const float* fwd = FILT + (size_t)(o * 2048 + c) * SEQ; const float* bwd = FILT + (size_t)(o * 2048 + 1024 + c) * SEQ;
        float asum = 0.f;
        {
            constexpr int NVF = (SEQ / 4 + 511) / 512;
            f32x4 lo[NVF], hi[NVF]; float a0[NVF];
#pragma unroll
            for (int jv = 0; jv < NVF; ++jv) {
                const int v = tid + 512 * jv, n = 8 * v; lo[jv] = (f32x4){0.f, 0.f, 0.f, 0.f}; hi[jv] = lo[jv]; a0[jv] = 0.f;
                if (v < SEQ / 4) {
                    if (n < SEQ) { lo[jv] = *(const f32x4*)(fwd + n); hi[jv] = *(const f32x4*)(fwd + n + 4); }
                    else { const float* blk = bwd + (2 * SEQ - n - 8); lo[jv] = *(const f32x4*)blk; hi[jv] = *(const f32x4*)(blk + 4); a0[jv] = (n == SEQ) ? 0.f : bwd[2 * SEQ - n]; }
                }
            }
#pragma unroll
            for (int jv = 0; jv < NVF; ++jv) {
                const int v = tid + 512 * jv, n = 8 * v;
                if (v < SEQ / 4) {
                    f32x4 l2 = lo[jv], h2 = hi[jv];
                    if (n >= SEQ) { const f32x4 b0 = lo[jv], b1 = hi[jv]; l2[0] = a0[jv]; l2[1] = b1[3]; l2[2] = b1[2]; l2[3] = b1[1]; h2[0] = b1[0]; h2[1] = b0[3]; h2[2] = b0[2]; h2[3] = b0[1]; }
                    LAS f32x4* q = (LAS f32x4*)(X + fpad(4 * v)); q[0] = l2; q[1] = h2;
                    asum += fabsf(l2[0]) + fabsf(l2[1]) + fabsf(l2[2]) + fabsf(l2[3]) + fabsf(h2[0]) + fabsf(h2[1]) + fabsf(h2[2]) + fabsf(h2[3]);
                }
            }
        }
        asum = wave_sum(asum);
        if (lane == 0) scr[wave] = asum;
        __syncthreads();
        float tot = 0.f;
        for (int w = 0; w < 8; ++w) tot += scr[w];
        const float inv = 1.f / tot;
        fft_dif(lds, tid);
        f32x4* kfp = (f32x4*)(KF + (size_t)u * KFP);
        for (int j = tid; j < SEQ / 2; j += 512) {
            const int p = 4 * (j >> 1) + (j & 1), k = (int)rev4((unsigned)p); f32x4 o;
            if (k == 0) { const f32x2 c0 = X[0]; o[0] = (c0.x + c0.y) * inv; o[1] = 0.f; o[2] = (c0.x - c0.y) * inv; o[3] = 0.f; }
            else {
                const int k2 = SEQ - k; const f32x2 ck = X[fpad(p)], ck2 = X[fpad(rev4(k2))];
                f32x2 E, O; E.x = 0.5f * (ck.x + ck2.x); E.y = 0.5f * (ck.y - ck2.y);
                const float dx = ck.x - ck2.x, dy = ck.y + ck2.y; O.x = 0.5f * dy; O.y = -0.5f * dx;
                const f32x2 wO = cmul(fft_halfroot(lds, k), O);
                const f32x2 ak = E + wO, ak2 = cconj(E - wO);
                o[0] = ak.x * inv; o[1] = ak.y * inv; o[2] = ak2.x * inv; o[3] = ak2.y * inv;
            }
            kfp[j] = o;
        }
        if (tid == 0) { const f32x2 ck = X[fpad(rev4(SEQ / 2))]; f32x4 o; o[0] = ck.x * inv; o[1] = -ck.y * inv; o[2] = 0.f; o[3] = 0.f; kfp[SEQ / 2] = o; }
        __syncthreads();
    }
}

DI void hy_conv3_vec(const bf16_t* ur, const float* hs, int ch, int v, float (&out)[8]) {
    const float w0 = hs[ch], w1 = hs[3072 + ch], w2 = hs[6144 + ch];
    const bf16x8 xv = *(const bf16x8*)(ur + 8 * v);
    const float xp = (v > 0) ? bf2f(ur[8 * v - 1]) : 0.f, xn = (8 * v + 8 < SEQ) ? bf2f(ur[8 * v + 8]) : 0.f;
    float x[10]; x[0] = xp; x[9] = xn;
#pragma unroll
    for (int i = 0; i < 8; ++i) x[i + 1] = bf2f((unsigned short)xv[i]);
#pragma unroll
    for (int i = 0; i < 8; ++i) out[i] = w0 * x[i] + w1 * x[i + 1] + w2 * x[i + 2];
}
DI void hy_kfload4(const f32x4* kfp, int jbase, f32x4 (&fp)[4]) {
#pragma unroll
    for (int i = 0; i < 4; ++i) { const int j = jbase + 512 * i; fp[i] = kfp[j < SEQ / 2 ? j : 0]; }
}
DI void hy_pointwise4(ldsp lds, int jbase, const f32x4 (&fp)[4]) {
    LAS f32x2* X = (LAS f32x2*)(lds + FFT_X);
#pragma unroll
    for (int i = 0; i < 4; ++i) {
        const int j = jbase + 512 * i; if (j >= SEQ / 2) continue;
        const int p = 4 * (j >> 1) + (j & 1), k = (int)rev4((unsigned)p);
        f32x2 kfk, kfk2; kfk.x = fp[i][0]; kfk.y = fp[i][1]; kfk2.x = fp[i][2]; kfk2.y = fp[i][3];
        if (k == 0) {
            const f32x2 c0 = X[0]; const float a0 = c0.x + c0.y, aL = c0.x - c0.y;
            const f32x2 y0 = kfk * a0, yL = kfk2 * aL;
            f32x2 s, d; s.x = 0.5f * (y0.x + yL.x); s.y = 0.5f * (y0.y - yL.y); d.x = 0.5f * (y0.x - yL.x); d.y = 0.5f * (y0.y + yL.y);
            f32x2 r; r.x = s.x - d.y; r.y = s.y + d.x; X[0] = r;
        } else {
            const int k2 = SEQ - k; const int r1 = fpad(p), r2 = fpad(rev4(k2)); const f32x2 ck = X[r1], ck2 = X[r2];
            f32x2 E, O; E.x = 0.5f * (ck.x + ck2.x); E.y = 0.5f * (ck.y - ck2.y);
            const float dx = ck.x - ck2.x, dy = ck.y + ck2.y; O.x = 0.5f * dy; O.y = -0.5f * dx;
            const f32x2 w = fft_halfroot(lds, k); const f32x2 wO = cmul(w, O);
            const f32x2 yk = cmul(E + wO, kfk), yk2 = cmul(cconj(E - wO), kfk2);
            f32x2 s, d; s.x = 0.5f * (yk.x + yk2.x); s.y = 0.5f * (yk.y - yk2.y); d.x = 0.5f * (yk.x - yk2.x); d.y = 0.5f * (yk.y + yk2.y);
            f32x2 t = cmulc(d, w); f32x2 r; r.x = s.x - t.y; r.y = s.y + t.x; X[r1] = r;
            f32x2 s2 = cconj(s); f32x2 d2; d2.x = -d.x; d2.y = d.y;
            f32x2 t2 = cmul(d2, w); r.x = s2.x + t2.y; r.y = s2.y - t2.x; X[r2] = r;
        }
    }
}
DI void phase_hy_conv(int l, ldsp lds) {
    unsigned char* const ws_ = WSP();
    const bf16_t* UT = (const bf16_t*)(ws_ + WS_UT); const f32x2* KF = (const f32x2*)(ws_ + WS_KF); bf16_t* Z2T = (bf16_t*)(ws_ + WS_Z2T);
    const float* hs = INP(I_HYS) + l * 3 * 3072; const float* hbias = INP(I_HYBIAS) + l * 2048;
    LAS f32x2* X = (LAS f32x2*)(lds + FFT_X);
    const int tid = TID;
    constexpr int NV = (SEQ / 8 + 511) / 512;
    fft_tables(lds);
    for (int c = blockIdx.x; c < 1024; c += gridDim.x) {
        float z[NV][8];
#pragma unroll
        for (int j = 0; j < NV; ++j) { if (tid + 512 * j < SEQ / 8) hy_conv3_vec(UT + (size_t)c * SEQ, hs, c, tid + 512 * j, z[j]); }
#pragma unroll 1
        for (int o = 0; o < 2; ++o) {
#pragma unroll
            for (int j = 0; j < NV; ++j) {
                const int m0 = 4 * (tid + 512 * j); if (tid + 512 * j >= SEQ / 8) continue;
                LAS f32x4* q = (LAS f32x4*)(X + fpad(m0)); f32x4 a, b; a[0] = z[j][0]; a[1] = z[j][1]; a[2] = z[j][2]; a[3] = z[j][3]; b[0] = z[j][4]; b[1] = z[j][5]; b[2] = z[j][6]; b[3] = z[j][7];
                q[0] = a; q[1] = b;
                LAS f32x4* q2 = (LAS f32x4*)(X + fpad(SEQ / 2 + m0)); q2[0] = (f32x4){0.f, 0.f, 0.f, 0.f}; q2[1] = (f32x4){0.f, 0.f, 0.f, 0.f};
            }
            const f32x4* kfp = (const f32x4*)(KF + (size_t)(o * 1024 + c) * KFP);
            __syncthreads();
            fft_dif(lds, tid);
            if (tid == 0) { const int r = fpad(rev4(SEQ / 2)); const f32x2 yk = cmul(cconj(X[r]), ld_xcu2((const f32x2*)(kfp + SEQ / 2))); X[r] = cconj(yk); }
            {
                constexpr int NKI = (SEQ / 2 + 511) / 512, NG = (NKI + 3) / 4;
                f32x4 fp0[4], fp1[4];
                hy_kfload4(kfp, tid, fp0);
#pragma unroll 1
                for (int g = 0; g < NG; g += 2) {
                    if (g + 1 < NG) hy_kfload4(kfp, tid + 2048 * (g + 1), fp1);
                    hy_pointwise4(lds, tid + 2048 * g, fp0);
                    if (g + 2 < NG) hy_kfload4(kfp, tid + 2048 * (g + 2), fp0);
                    if (g + 1 < NG) hy_pointwise4(lds, tid + 2048 * (g + 1), fp1);
                }
            }
            __syncthreads();
            fft_dit_inv(lds, tid);
            const float bias = hbias[o * 1024 + c]; const float invn = 1.f / (float)SEQ;
            const bf16_t* ug = UT + (size_t)(1024 * (o + 1) + c) * SEQ;
#pragma unroll
            for (int j = 0; j < NV; ++j) {
                const int v = tid + 512 * j; if (v >= SEQ / 8) continue; const LAS f32x4* q = (const LAS f32x4*)(X + fpad(4 * v)); const f32x4 a = q[0], b = q[1];
                float g[8]; hy_conv3_vec(ug, hs, 1024 * (o + 1) + c, v, g);
                z[j][0] = g[0] * (a[0] * invn + bias * z[j][0]); z[j][1] = g[1] * (a[1] * invn + bias * z[j][1]); z[j][2] = g[2] * (a[2] * invn + bias * z[j][2]); z[j][3] = g[3] * (a[3] * invn + bias * z[j][3]);
                z[j][4] = g[4] * (b[0] * invn + bias * z[j][4]); z[j][5] = g[5] * (b[1] * invn + bias * z[j][5]); z[j][6] = g[6] * (b[2] * invn + bias * z[j][6]); z[j][7] = g[7] * (b[3] * invn + bias * z[j][7]);
                if (o == 1) { u32x4 w; w.x = pk2(z[j][0], z[j][1]); w.y = pk2(z[j][2], z[j][3]); w.z = pk2(z[j][4], z[j][5]); w.w = pk2(z[j][6], z[j][7]); *(u32x4*)(Z2T + (size_t)c * SEQ + 8 * v) = w; }
            }
        }
        __syncthreads();
    }
}
DI void phase_hy_out(ldsp lds) {
    unsigned char* const ws_ = WSP();
    const bf16_t* Z2T = (const bf16_t*)(ws_ + WS_Z2T); bf16_t* Y = (bf16_t*)(ws_ + WS_Y);
    LAS unsigned short* T = (LAS unsigned short*)lds; const int tid = TID;
    for (int t = blockIdx.x; t < 16 * (SEQ / 64); t += gridDim.x) {
        const int c0 = (t & 15) * 64, t0 = (t >> 4) * 64;
        { const int r = tid >> 3, q8 = tid & 7; const bf16x8 v = *(const bf16x8*)(Z2T + (size_t)(c0 + r) * SEQ + t0 + 8 * q8);
#pragma unroll
          for (int j = 0; j < 8; ++j) T[(8 * q8 + j) * 72 + r] = (unsigned short)v[j]; }
        __syncthreads();
        { const int tt = tid >> 3, cc = tid & 7; *(u32x4*)(Y + (size_t)(t0 + tt) * 4096 + c0 + 8 * cc) = *(const LAS u32x4*)(T + tt * 72 + 8 * cc); }
        __syncthreads();
    }
}

constexpr float RSQ128 = 0.08838834764831845f;
DI void phase_ret_kv(int l, ldsp lds) {
    unsigned char* const ws_ = WSP();
    constexpr int PK = 272, PV = 528, KF_OFF = 0, KB_OFF = 128 * PK, V_OFF = 2 * 128 * PK;
    static_assert(V_OFF + 128 * PV <= LDS_PTRS, "lds");
    const bf16_t* PROJ = (const bf16_t*)(ws_ + WS_PROJ); bf16_t* KVT = (bf16_t*)(ws_ + WS_RKV); const float* dec = INP(I_RDEC) + l * 8;
    const int tid = TID, lane = tid & 63, w = tid >> 6, lr = lane & 15, lg = lane >> 4;
    for (int u = blockIdx.x; u < 4 * NCR; u += gridDim.x) {
        const int h = u / NCR, n = u % NCR, t0 = n * 128;
        const float lgf = logsig(dec[h]), lgb = logsig(dec[4 + h]);
#pragma unroll
        for (int i = 0; i < 4; ++i) {
            const int c = tid + 512 * i, r = c >> 4, cc = c & 15;
            const bf16x8 kv = *(const bf16x8*)(PROJ + (size_t)(t0 + r) * NPROJ + PC_RK + h * 128 + 8 * cc);
            const float sf = RSQ128 * fexp(lgf * (float)(127 - r)), sb = RSQ128 * fexp(lgb * (float)r);
            u32x4 of, ob;
#pragma unroll
            for (int j = 0; j < 4; ++j) { const float a = bf2f((unsigned short)kv[2 * j]), b = bf2f((unsigned short)kv[2 * j + 1]); of[j] = pk2(a * sf, b * sf); ob[j] = pk2(a * sb, b * sb); }
            *(LAS u32x4*)(lds + KF_OFF + r * PK + 16 * cc) = of; *(LAS u32x4*)(lds + KB_OFF + r * PK + 16 * cc) = ob;
        }
#pragma unroll
        for (int i = 0; i < 8; ++i) { const int c = tid + 512 * i, r = c >> 5, cc = c & 31; *(LAS u32x4*)(lds + V_OFF + r * PV + 16 * cc) = *(const u32x4*)(PROJ + (size_t)(t0 + r) * NPROJ + PC_RV + h * 256 + 8 * cc); }
        __syncthreads();
#pragma unroll 1
        for (int dir = 0; dir < 2; ++dir) {
            const unsigned koff = dir ? KB_OFF : KF_OFF;
            f32x4 acc[2][8];
#pragma unroll
            for (int a = 0; a < 2; ++a)
#pragma unroll
                for (int b = 0; b < 8; ++b) acc[a][b] = (f32x4){0.f, 0.f, 0.f, 0.f};
#pragma unroll 1
            for (int ks = 0; ks < 4; ++ks) {
                TrF avf[2], bvf[8];
#pragma unroll
                for (int e2 = 0; e2 < 2; ++e2) tr_issue(lds, V_OFF, PV, 32 * ks + 8 * lg, 32 * ks + 8 * lg + 4, 16 * (2 * w + e2), lr, avf[e2]);
#pragma unroll
                for (int dt = 0; dt < 8; ++dt) tr_issue(lds, koff, PK, 32 * ks + 8 * lg, 32 * ks + 8 * lg + 4, 16 * dt, lr, bvf[dt]);
                tr_wait2(avf[0], avf[1]); tr_wait2(bvf[0], bvf[1]); tr_wait2(bvf[2], bvf[3]); tr_wait2(bvf[4], bvf[5]); tr_wait2(bvf[6], bvf[7]);
#pragma unroll
                for (int dt = 0; dt < 8; ++dt)
#pragma unroll
                    for (int e2 = 0; e2 < 2; ++e2) acc[e2][dt] = mfma16(tr_val(bvf[dt]), tr_val(avf[e2]), acc[e2][dt]);
            }
            bf16_t* dst = KVT + (size_t)((dir * 4 + h) * NCR + n) * 32768;
#pragma unroll
            for (int e2 = 0; e2 < 2; ++e2)
#pragma unroll
                for (int dt = 0; dt < 8; ++dt) { u32x2 pw; pw.x = pk2(acc[e2][dt][0], acc[e2][dt][1]); pw.y = pk2(acc[e2][dt][2], acc[e2][dt][3]); *(u32x2*)(dst + (16 * (2 * w + e2) + lr) * 128 + 16 * dt + 4 * lg) = pw; }
        }
        __syncthreads();
    }
}
DI void phase_ret_scan(ldsp lds, int l) {
    unsigned char* const ws_ = WSP();
    const unsigned* KVT = (const unsigned*)(ws_ + WS_RKV); unsigned* ST = (unsigned*)(ws_ + WS_RST); const float* dec = INP(I_RDEC) + l * 8;
    static_assert(NCR % 8 == 0, "scan unroll");
    for (int g = blockIdx.x * 512 + TID; g < 8 * 16384; g += gridDim.x * 512) {
        const int dh = g >> 14, ep = g & 16383, dir = dh >> 2;
        const float G = expf(logsig(dec[dh]) * 128.f); float s0 = 0.f, s1 = 0.f;
        const unsigned* src = KVT + (size_t)dh * NCR * 16384 + ep; unsigned* dst = ST + (size_t)dh * NCR * 16384 + ep;
#pragma unroll 1
        for (int nb = 0; nb < NCR; nb += 8) {
            const int n0 = dir ? (NCR - 8 - nb) : nb; unsigned v[8];
#pragma unroll
            for (int j = 0; j < 8; ++j) v[j] = src[(size_t)(n0 + j) * 16384];
            if (dir == 0) {
#pragma unroll
                for (int j = 0; j < 8; ++j) { dst[(size_t)(n0 + j) * 16384] = pk2(s0, s1); s0 = s0 * G + bf2f((unsigned short)(v[j] & 0xffffu)); s1 = s1 * G + bf2f((unsigned short)(v[j] >> 16)); }
            } else {
#pragma unroll
                for (int j = 7; j >= 0; --j) { dst[(size_t)(n0 + j) * 16384] = pk2(s0, s1); s0 = s0 * G + bf2f((unsigned short)(v[j] & 0xffffu)); s1 = s1 * G + bf2f((unsigned short)(v[j] >> 16)); }
            }
        }
    }
}
DI void phase_ret_out(int l, ldsp lds) {
    unsigned char* const ws_ = WSP();
    constexpr int PK = 272, PV = 528, K_OFF = 0, V_OFF = 128 * PK;
    const bf16_t* PROJ = (const bf16_t*)(ws_ + WS_PROJ); const bf16_t* ST = (const bf16_t*)(ws_ + WS_RST); bf16_t* Y = (bf16_t*)(ws_ + WS_Y); const float* dec = INP(I_RDEC) + l * 8;
    const int tid = TID, lane = tid & 63, w = tid >> 6, lr = lane & 15, lg = lane >> 4;
    for (int u = blockIdx.x; u < 4 * NCR; u += gridDim.x) {
        const int h = u / NCR, n = u % NCR, t0 = n * 128;
        const float lgf = logsig(dec[h]), lgb = logsig(dec[4 + h]);
        const int i = 16 * w + lr; const size_t tok = (size_t)(t0 + i);
        bf16x8 qf[4];
#pragma unroll
        for (int ks = 0; ks < 4; ++ks) qf[ks] = *(const bf16x8*)(PROJ + tok * NPROJ + PC_RQ + h * 128 + 32 * ks + 8 * lg);
#pragma unroll
        for (int i = 0; i < 4; ++i) {
            const int c = tid + 512 * i, r = c >> 4, cc = c & 15;
            const bf16x8 kv = *(const bf16x8*)(PROJ + (size_t)(t0 + r) * NPROJ + PC_RK + h * 128 + 8 * cc); u32x4 o;
#pragma unroll
            for (int j = 0; j < 4; ++j) o[j] = pk2(bf2f((unsigned short)kv[2 * j]) * RSQ128, bf2f((unsigned short)kv[2 * j + 1]) * RSQ128);
            *(LAS u32x4*)(lds + K_OFF + r * PK + 16 * cc) = o;
        }
#pragma unroll
        for (int i = 0; i < 8; ++i) { const int c = tid + 512 * i, r = c >> 5, cc = c & 31; *(LAS u32x4*)(lds + V_OFF + r * PV + 16 * cc) = *(const u32x4*)(PROJ + (size_t)(t0 + r) * NPROJ + PC_RV + h * 256 + 8 * cc); }
        __syncthreads();
        f32x4 s[8];
#pragma unroll
        for (int jt = 0; jt < 8; ++jt) {
            s[jt] = (f32x4){0.f, 0.f, 0.f, 0.f};
#pragma unroll
            for (int ks = 0; ks < 4; ++ks) s[jt] = mfma16(lds_row8(lds, K_OFF + (16 * jt + lr) * PK + (32 * ks + 8 * lg) * 2), qf[ks], s[jt]);
#pragma unroll
            for (int r = 0; r < 4; ++r) { const int dm = i - (16 * jt + 4 * lg + r); float d = 0.f; if (dm >= 0) d += fexp(lgf * (float)dm); if (dm <= 0) d += fexp(lgb * (float)(-dm)); s[jt][r] *= d; }
        }
        bf16x8 pf[4];
#pragma unroll
        for (int kk = 0; kk < 4; ++kk) pf[kk] = pack8(s[2 * kk], s[2 * kk + 1]);
        const float wqf = fexp(lgf * (float)(i + 1)), wqb = fexp(lgb * (float)(128 - i));
        const bf16_t* stf = ST + (size_t)((0 * 4 + h) * NCR + n) * 32768; const bf16_t* stb = ST + (size_t)((4 + h) * NCR + n) * 32768;
        float* ry = (float*)(ws_ + WS_RY) + tok * 1024 + h * 256 + 4 * lg; float ss = 0.f;
#define RET_LD(et_, SF, SB) do { _Pragma("unroll") for (int ks = 0; ks < 4; ++ks) { SF[ks] = *(const bf16x8*)(stf + (16 * (et_) + lr) * 128 + 32 * ks + 8 * lg); SB[ks] = *(const bf16x8*)(stb + (16 * (et_) + lr) * 128 + 32 * ks + 8 * lg); } } while (0)
#define RET_ET(et_, SF, SB) do { f32x4 a1 = {0.f, 0.f, 0.f, 0.f}, af = a1, ab = a1; TrF vf[4]; \
            _Pragma("unroll") for (int kk = 0; kk < 4; ++kk) tr_issue(lds, V_OFF, PV, 32 * kk + 4 * lg, 32 * kk + 16 + 4 * lg, 16 * (et_), lr, vf[kk]); \
            tr_wait2(vf[0], vf[1]); tr_wait2(vf[2], vf[3]); \
            _Pragma("unroll") for (int kk = 0; kk < 4; ++kk) a1 = mfma16(tr_val(vf[kk]), pf[kk], a1); \
            _Pragma("unroll") for (int ks = 0; ks < 4; ++ks) { af = mfma16(SF[ks], qf[ks], af); ab = mfma16(SB[ks], qf[ks], ab); } \
            const f32x4 yv = a1 + af * wqf + ab * wqb; ss += dot4(yv, yv); *(f32x4*)(ry + 16 * (et_)) = yv; } while (0)
        {
            bf16x8 sfC[4], sbC[4];
            RET_LD(0, sfC, sbC);
#pragma unroll 1
            for (int et = 0; et < 16; ++et) {
                bf16x8 sfN[4], sbN[4]; const int en = (et + 1 < 16) ? et + 1 : et;
                RET_LD(en, sfN, sbN);
                RET_ET(et, sfC, sbC);
#pragma unroll
                for (int ks = 0; ks < 4; ++ks) { sfC[ks] = sfN[ks]; sbC[ks] = sbN[ks]; }
            }
        }
#undef RET_LD
#undef RET_ET
        ss += __shfl_xor(ss, 16); ss += __shfl_xor(ss, 32);
        const float rstd = rsqrtf(ss * (1.f / 256.f) + EPS);
#pragma unroll 1
        for (int et = 0; et < 16; ++et) {
            const int e0 = 16 * et + 4 * lg; const f32x4 yv = *(const f32x4*)(ry + 16 * et);
            const s16x4 gv = *(const s16x4*)(PROJ + tok * NPROJ + PC_RG + h * 256 + e0); float o[4];
#pragma unroll
            for (int r = 0; r < 4; ++r) { const float gg = bf2f((unsigned short)gv[r]); o[r] = yv[r] * rstd * (gg * frcp(1.f + fexp(-gg))); }
            u32x2 ww; ww.x = pk2(o[0], o[1]); ww.y = pk2(o[2], o[3]); *(u32x2*)(Y + tok * 4096 + 1024 + h * 256 + e0) = ww;
        }
        __syncthreads();
    }
}

DI void phase_att(int l, ldsp lds) {
    unsigned char* const ws_ = WSP();
    constexpr int PK = 272, K_OFF = 0, V_OFF = 256 * PK, NB = SEQ / 128;
    static_assert(2 * 256 * PK <= LDS_PTRS, "lds");
    const bf16_t* PROJ = (const bf16_t*)(ws_ + WS_PROJ); bf16_t* OB = (bf16_t*)(ws_ + WS_OB); float* LSE = (float*)(ws_ + WS_LSE);
    const float* gq = INP(I_AGAIN) + l * 256; const float* gk = gq + 128;
    const int tid = TID, lane = tid & 63, w = tid >> 6, lr = lane & 15, lg = lane >> 4;
    bf16x8 kvr[8]; u32x4 vvr[8];
    float gkr[8];
#pragma unroll
    for (int j = 0; j < 8; ++j) gkr[j] = gk[8 * (tid & 15) + j];
#define ATT_LOAD(uu) do { const int br_ = (uu) / (8 * NB), rem_ = (uu) % (8 * NB), h_ = rem_ / NB, ub_ = rem_ % NB; \
        const int dil_ = (br_ == 0) ? 1 : (br_ == 1) ? 4 : 16; const int n_ = SEQ / dil_, nblk_ = n_ / 128, rho_ = ub_ / nblk_, p0_ = (ub_ % nblk_) * 128; \
        _Pragma("unroll") for (int i = 0; i < 8; ++i) { const int c = tid + 512 * i, r = c >> 4, cc = c & 15; const int pp = p0_ - 64 + r; const bool valid = (pp >= 0) && (pp < n_); \
            const size_t tk = (size_t)(valid ? pp * dil_ + rho_ : 0); \
            kvr[i] = *(const bf16x8*)(PROJ + tk * NPROJ + PC_AK + h_ * 128 + 8 * cc); vvr[i] = *(const u32x4*)(PROJ + tk * NPROJ + PC_AV + h_ * 128 + 8 * cc); } } while (0)
    if ((int)blockIdx.x < 3 * 8 * NB) ATT_LOAD((int)blockIdx.x);
    for (int u = blockIdx.x; u < 3 * 8 * NB; u += gridDim.x) {
        const int br = u / (8 * NB), rem = u % (8 * NB), h = rem / NB, ub = rem % NB;
        const int dil = (br == 0) ? 1 : (br == 1) ? 4 : 16; const int n = SEQ / dil, nblk = n / 128, rho = ub / nblk, p0 = (ub % nblk) * 128;
        const float slope = exp2f(-(float)(h + 1)) * (float)dil;
        const int qi = 16 * w + lr; const size_t tq = (size_t)((p0 + qi) * dil + rho);
        bf16x8 qr[4];
#pragma unroll
        for (int ks = 0; ks < 4; ++ks) qr[ks] = *(const bf16x8*)(PROJ + tq * NPROJ + PC_AQ + h * 128 + 32 * ks + 8 * lg);
#pragma unroll
        for (int i = 0; i < 8; ++i) {
            const int c = tid + 512 * i, r = c >> 4, cc = c & 15; const int pp = p0 - 64 + r; const bool valid = (pp >= 0) && (pp < n);
            const bf16x8 kv = kvr[i]; u32x4 vv = vvr[i];
            float x[8]; float ss = 0.f;
#pragma unroll
            for (int j = 0; j < 8; ++j) { x[j] = valid ? bf2f((unsigned short)kv[j]) : 0.f; ss += x[j] * x[j]; }
            ss += __shfl_xor(ss, 1); ss += __shfl_xor(ss, 2); ss += __shfl_xor(ss, 4); ss += __shfl_xor(ss, 8);
            const float rstd = rsqrtf(ss * (1.f / 128.f) + EPS); u32x4 o;
#pragma unroll
            for (int j = 0; j < 4; ++j) o[j] = pk2(x[2 * j] * rstd * gkr[2 * j], x[2 * j + 1] * rstd * gkr[2 * j + 1]);
            if (!valid) vv = (u32x4){0u, 0u, 0u, 0u};
            *(LAS u32x4*)(lds + K_OFF + r * PK + 16 * cc) = o; *(LAS u32x4*)(lds + V_OFF + r * PK + 16 * cc) = vv;
            MEMFENCE();
        }
        __syncthreads();
        bf16x8 qf[4];
        {
            float ss = 0.f;
#pragma unroll
            for (int ks = 0; ks < 4; ++ks) {
#pragma unroll
                for (int j = 0; j < 8; ++j) { const float v = bf2f((unsigned short)qr[ks][j]); ss += v * v; } }
            ss += __shfl_xor(ss, 16); ss += __shfl_xor(ss, 32);
            const float rstd = rsqrtf(ss * (1.f / 128.f) + EPS) * RSQ128;
#pragma unroll
            for (int ks = 0; ks < 4; ++ks) { u32x4 o;
#pragma unroll
                for (int j = 0; j < 4; ++j) { const int d = 32 * ks + 8 * lg + 2 * j; o[j] = pk2(bf2f((unsigned short)qr[ks][2 * j]) * rstd * gq[d], bf2f((unsigned short)qr[ks][2 * j + 1]) * rstd * gq[d + 1]); }
                qf[ks] = __builtin_bit_cast(bf16x8, o); }
        }
        if (u + (int)gridDim.x < 3 * 8 * NB) ATT_LOAD(u + (int)gridDim.x);
        const float dlane = (float)(4 * lg - lr); const int kl = 16 * w + 4 * lg;
        const int klo = (p0 == 0) ? 64 : 0; const unsigned kspan = (unsigned)(((p0 + 128 == n) ? 192 : 256) - klo);
        f32x4 s[10]; float mx = -1e30f;
#pragma unroll
        for (int t = 0; t < 9; ++t) {
            s[t] = (f32x4){0.f, 0.f, 0.f, 0.f};
#pragma unroll
            for (int ks = 0; ks < 4; ++ks) s[t] = mfma16(lds_row8(lds, K_OFF + (16 * (w + t) + lr) * PK + (32 * ks + 8 * lg) * 2), qf[ks], s[t]);
#pragma unroll
            for (int r = 0; r < 4; ++r) {
                const float aof = fabsf((float)(16 * t + r - 64) + dlane);
                const bool valid = (aof <= 64.f) && ((unsigned)(16 * t + r + kl - klo) < kspan);
                const float sv = valid ? s[t][r] - slope * aof : -1e30f; s[t][r] = sv; mx = fmaxf(mx, sv);
            }
            MEMFENCE();
        }
        s[9] = (f32x4){0.f, 0.f, 0.f, 0.f};
        mx = fmaxf(mx, __shfl_xor(mx, 16)); mx = fmaxf(mx, __shfl_xor(mx, 32));
        float lsum = 0.f;
#pragma unroll
        for (int t = 0; t < 9; ++t)
#pragma unroll
            for (int r = 0; r < 4; ++r) { const float sv = s[t][r]; const float e = fexp(sv - mx); s[t][r] = e; lsum += e; }
        lsum += __shfl_xor(lsum, 16); lsum += __shfl_xor(lsum, 32);
        bf16x8 pf[5];
#pragma unroll
        for (int kk = 0; kk < 5; ++kk) pf[kk] = pack8(s[2 * kk], s[2 * kk + 1]);
        const float inv = 1.f / lsum;
        bf16_t* orow = OB + ((size_t)br * SEQ + tq) * 1024 + h * 128;
#pragma unroll 1
        for (int et = 0; et < 8; ++et) {
            f32x4 o = {0.f, 0.f, 0.f, 0.f};
            TrF vf[5];
#pragma unroll
            for (int kk = 0; kk < 5; ++kk) { const int ra = 16 * (w + 2 * kk) + 4 * lg, rb = (kk < 4) ? ra + 16 : ra; tr_issue(lds, V_OFF, PK, ra, rb, 16 * et, lr, vf[kk]); }
            tr_wait2(vf[0], vf[1]); tr_wait2(vf[2], vf[3]); tr_wait1(vf[4]);
#pragma unroll
            for (int kk = 0; kk < 5; ++kk) o = mfma16(tr_val(vf[kk]), pf[kk], o);
            u32x2 ww; ww.x = pk2(o[0] * inv, o[1] * inv); ww.y = pk2(o[2] * inv, o[3] * inv); *(u32x2*)(orow + 16 * et + 4 * lg) = ww;
        }
        if (lg == 0) LSE[((size_t)br * SEQ + tq) * 8 + h] = mx + logf(lsum);
        __syncthreads();
    }
#undef ATT_LOAD
}
DI void phase_att_merge(ldsp lds) {
    unsigned char* const ws_ = WSP();
    const bf16_t* OB = (const bf16_t*)(ws_ + WS_OB); const float* LSE = (const float*)(ws_ + WS_LSE); bf16_t* Y = (bf16_t*)(ws_ + WS_Y);
    for (int g = blockIdx.x * 512 + TID; g < SEQ * 128; g += gridDim.x * 512) {
        const int tok = g >> 7, h = (g >> 4) & 7, e8 = g & 15;
        const float l0 = LSE[((size_t)0 * SEQ + tok) * 8 + h], l1 = LSE[((size_t)1 * SEQ + tok) * 8 + h], l2 = LSE[((size_t)2 * SEQ + tok) * 8 + h];
        const float m = fmaxf(l0, fmaxf(l1, l2)); float w0 = fexp(l0 - m), w1 = fexp(l1 - m), w2 = fexp(l2 - m); const float inv = frcp(w0 + w1 + w2); w0 *= inv; w1 *= inv; w2 *= inv;
        const bf16x8 a = *(const bf16x8*)(OB + ((size_t)0 * SEQ + tok) * 1024 + h * 128 + 8 * e8), b = *(const bf16x8*)(OB + ((size_t)1 * SEQ + tok) * 1024 + h * 128 + 8 * e8), c = *(const bf16x8*)(OB + ((size_t)2 * SEQ + tok) * 1024 + h * 128 + 8 * e8);
        float o[8];
#pragma unroll
        for (int j = 0; j < 8; ++j) o[j] = w0 * bf2f((unsigned short)a[j]) + w1 * bf2f((unsigned short)b[j]) + w2 * bf2f((unsigned short)c[j]);
        u32x4 ww; ww.x = pk2(o[0], o[1]); ww.y = pk2(o[2], o[3]); ww.z = pk2(o[4], o[5]); ww.w = pk2(o[6], o[7]);
        *(u32x4*)(Y + (size_t)tok * 4096 + 2048 + h * 128 + 8 * e8) = ww;
    }
}

DI int ml_tok(int dir, int n, int i) { return dir ? SEQ - 1 - (64 * n + i) : 64 * n + i; }
DI void ml_gate_row(const float* G, const float* gb, int dir, int h, int n, int lane, float& ig, float& b) {
    const size_t tk = (size_t)ml_tok(dir, n, lane);
    ig = G[tk * 16 + dir * 8 + h] + gb[dir * 8 + h];
    const float lf = logsig(G[tk * 16 + dir * 8 + 4 + h] + gb[dir * 8 + 4 + h]);
    b = lf;
#pragma unroll
    for (int d = 1; d < 64; d <<= 1) { const float o = __shfl_up(b, d); if (lane >= d) b += o; }
}
DI void phase_ml_kv(int l, ldsp lds) {
    unsigned char* const ws_ = WSP();
    constexpr int PK = 272, PV = 528, KW0_OFF = 0, KW1_OFF = 64 * PK, V_OFF = 2 * 64 * PK, WA_OFF = V_OFF + 64 * PV;
    const bf16_t* PROJ = (const bf16_t*)(ws_ + WS_PROJ); const float* G = (const float*)(ws_ + WS_G); const float* gb = INP(I_MGB) + l * 16;
    bf16_t* KVT = (bf16_t*)(ws_ + WS_MKV); float* KSUM = (float*)(ws_ + WS_KSUM); float* MLOC = (float*)(ws_ + WS_MLOC); float* BLAST = (float*)(ws_ + WS_BLAST);
    LAS float* waL = (LAS float*)(lds + WA_OFF);
    const int tid = TID, lane = tid & 63, w = tid >> 6, lr = lane & 15, lg = lane >> 4;
    for (int u = blockIdx.x; u < 4 * NCM; u += gridDim.x) {
        const int h = u / NCM, nt = u % NCM;
        bf16x8 kreg[2]; u32x4 vreg[4];
#pragma unroll
        for (int i = 0; i < 2; ++i) { const int c = tid + 512 * i, r = c >> 4, cc = c & 15; const size_t tk = (size_t)(64 * nt + r); kreg[i] = *(const bf16x8*)(PROJ + tk * NPROJ + PC_MK + h * 128 + 8 * cc); }
#pragma unroll
        for (int i = 0; i < 4; ++i) { const int c = tid + 512 * i, r = c >> 5, cc = c & 31; const size_t tk = (size_t)(64 * nt + r); vreg[i] = *(const u32x4*)(PROJ + tk * NPROJ + PC_MV + h * 256 + 8 * cc); }
        if (w < 2) {
            const int dir = w, n = dir ? NCM - 1 - nt : nt, dh = dir * 4 + h;
            float ig, b; ml_gate_row(G, gb, dir, h, n, lane, ig, b);
            const float blast = __shfl(b, 63); const float a = blast - b + ig; const float mloc = wave_max(a);
            waL[64 * dir + (dir ? 63 - lane : lane)] = fexp(a - mloc);
            if (lane == 0) { MLOC[dh * NCM + n] = mloc; BLAST[dh * NCM + n] = blast; }
        }
        __syncthreads();
#pragma unroll
        for (int i = 0; i < 2; ++i) {
            const int c = tid + 512 * i, r = c >> 4, cc = c & 15;
            const bf16x8 kv = kreg[i]; const float s0 = RSQ128 * waL[r], s1 = RSQ128 * waL[64 + r]; u32x4 o0, o1;
#pragma unroll
            for (int j = 0; j < 4; ++j) { const float x0 = bf2f((unsigned short)kv[2 * j]), x1 = bf2f((unsigned short)kv[2 * j + 1]); o0[j] = pk2(x0 * s0, x1 * s0); o1[j] = pk2(x0 * s1, x1 * s1); }
            *(LAS u32x4*)(lds + KW0_OFF + r * PK + 16 * cc) = o0; *(LAS u32x4*)(lds + KW1_OFF + r * PK + 16 * cc) = o1;
        }
#pragma unroll
        for (int i = 0; i < 4; ++i) { const int c = tid + 512 * i, r = c >> 5, cc = c & 31; *(LAS u32x4*)(lds + V_OFF + r * PV + 16 * cc) = vreg[i]; }
        __syncthreads();
#pragma unroll 1
        for (int dir = 0; dir < 2; ++dir) {
            const unsigned koff = dir ? KW1_OFF : KW0_OFF; const int n = dir ? NCM - 1 - nt : nt, dh = dir * 4 + h;
            f32x4 acc[2][8];
#pragma unroll
            for (int a = 0; a < 2; ++a)
#pragma unroll
                for (int b = 0; b < 8; ++b) acc[a][b] = (f32x4){0.f, 0.f, 0.f, 0.f};
#pragma unroll 1
            for (int ks = 0; ks < 2; ++ks) {
                TrF avf[2], bvf[8];
#pragma unroll
                for (int e2 = 0; e2 < 2; ++e2) tr_issue(lds, V_OFF, PV, 32 * ks + 8 * lg, 32 * ks + 8 * lg + 4, 16 * (2 * w + e2), lr, avf[e2]);
#pragma unroll
                for (int dt = 0; dt < 8; ++dt) tr_issue(lds, koff, PK, 32 * ks + 8 * lg, 32 * ks + 8 * lg + 4, 16 * dt, lr, bvf[dt]);
                tr_wait2(avf[0], avf[1]); tr_wait2(bvf[0], bvf[1]); tr_wait2(bvf[2], bvf[3]); tr_wait2(bvf[4], bvf[5]); tr_wait2(bvf[6], bvf[7]);
#pragma unroll
                for (int dt = 0; dt < 8; ++dt)
#pragma unroll
                    for (int e2 = 0; e2 < 2; ++e2) acc[e2][dt] = mfma16(tr_val(bvf[dt]), tr_val(avf[e2]), acc[e2][dt]);
            }
            bf16_t* dst = KVT + (size_t)(dh * NCM + n) * 32768;
#pragma unroll
            for (int e2 = 0; e2 < 2; ++e2)
#pragma unroll
                for (int dt = 0; dt < 8; ++dt) { u32x2 pw; pw.x = pk2(acc[e2][dt][0], acc[e2][dt][1]); pw.y = pk2(acc[e2][dt][2], acc[e2][dt][3]); *(u32x2*)(dst + (16 * (2 * w + e2) + lr) * 128 + 16 * dt + 4 * lg) = pw; }
            if (tid < 128) { float s = 0.f; for (int r = 0; r < 64; ++r) s += bf2f(*(const LAS unsigned short*)(lds + koff + r * PK + 2 * tid)); KSUM[(size_t)(dh * NCM + n) * 128 + tid] = s; }
        }
        __syncthreads();
    }
}
DI void phase_ml_scan(ldsp lds) {
    unsigned char* const ws_ = WSP();
    const unsigned* KVT = (const unsigned*)(ws_ + WS_MKV); unsigned* CT = (unsigned*)(ws_ + WS_MCT); const float* KSUM = (const float*)(ws_ + WS_KSUM); float* NPREV = (float*)(ws_ + WS_NPREV);
    const float* MLOC = (const float*)(ws_ + WS_MLOC); const float* BLAST = (const float*)(ws_ + WS_BLAST); float* MPREV = (float*)(ws_ + WS_MPREV);
    LAS float* sp = (LAS float*)lds; LAS float* sc = sp + NCM;
    const int tid = TID;
    for (int wi = blockIdx.x; wi < 256; wi += gridDim.x) {
        const int dh = wi >> 5, slice = wi & 31;
        for (int n = tid; n < NCM; n += 512) { sp[n] = MLOC[dh * NCM + n]; sc[n] = BLAST[dh * NCM + n]; }
        __syncthreads();
        if (tid == 0) {
            float m = 0.f;
            for (int n = 0; n < NCM; ++n) {
                const float mloc = sp[n], bl = sc[n];
                if (slice == 0) MPREV[dh * NCM + n] = m;
                const float mn = fmaxf(bl + m, mloc); sp[n] = fexp(bl + m - mn); sc[n] = fexp(mloc - mn); m = mn;
            }
        }
        __syncthreads();
        {
            const int ep = slice * 512 + tid; float c0 = 0.f, c1 = 0.f;
            const unsigned* src = KVT + (size_t)dh * NCM * 16384 + ep; unsigned* dst = CT + (size_t)dh * NCM * 16384 + ep;
#pragma unroll 1
            for (int n0 = 0; n0 < NCM; n0 += 8) {
                unsigned v[8];
#pragma unroll
                for (int j = 0; j < 8; ++j) v[j] = src[(size_t)(n0 + j) * 16384];
#pragma unroll
                for (int j = 0; j < 8; ++j) { const float a = sp[n0 + j], b = sc[n0 + j]; dst[(size_t)(n0 + j) * 16384] = pk2(c0, c1); c0 = a * c0 + b * bf2f((unsigned short)(v[j] & 0xffffu)); c1 = a * c1 + b * bf2f((unsigned short)(v[j] >> 16)); }
            }
        }
        if (slice == 0 && tid < 128) { float v = 0.f; for (int n = 0; n < NCM; ++n) { NPREV[(size_t)(dh * NCM + n) * 128 + tid] = v; v = sp[n] * v + sc[n] * KSUM[(size_t)(dh * NCM + n) * 128 + tid]; } }
        __syncthreads();
    }
}
DI void phase_ml_out(int l, ldsp lds) {
    unsigned char* const ws_ = WSP();
    constexpr int PK = 272, PV = 528, K_OFF = 0, V_OFF = 64 * PK, F_OFF = V_OFF + 64 * PV, HF_OFF = F_OFF + 2048, SS_OFF = HF_OFF + 64 * 256 * 4;
    static_assert(SS_OFF + 512 <= LDS_PTRS, "lds");
    const bf16_t* PROJ = (const bf16_t*)(ws_ + WS_PROJ); const float* G = (const float*)(ws_ + WS_G); const float* gb = INP(I_MGB) + l * 16;
    const bf16_t* CT = (const bf16_t*)(ws_ + WS_MCT); const float* NPREV = (const float*)(ws_ + WS_NPREV); const float* MPREV = (const float*)(ws_ + WS_MPREV);
    bf16_t* Y = (bf16_t*)(ws_ + WS_Y); const float* ng = INP(I_MNG) + l * 1024;
    LAS float* U = (LAS float*)(lds + F_OFF); LAS float* BM = U + 64; LAS float* WI = BM + 64; LAS float* EMT = WI + 64; LAS float* NP = EMT + 64;
    LAS float* HF = (LAS float*)(lds + HF_OFF); LAS float* SS = (LAS float*)(lds + SS_OFF);
    const int tid = TID, lane = tid & 63, w = tid >> 6, lr = lane & 15, lg = lane >> 4;
    const int qs = w & 3, eh = w >> 2, i = 16 * qs + lr;
    for (int u = blockIdx.x; u < 4 * NCM; u += gridDim.x) {
        const int h = u / NCM, nt = u % NCM;
#pragma unroll 1
        for (int dir = 0; dir < 2; ++dir) {
            const int dh = dir * 4 + h, n = dir ? NCM - 1 - nt : nt;
            bf16x8 kreg[2]; u32x4 vreg[4]; bf16x8 qf[4];
#pragma unroll
            for (int ii = 0; ii < 2; ++ii) { const int c = tid + 512 * ii, r = c >> 4, cc = c & 15; const size_t tk = (size_t)ml_tok(dir, n, r); kreg[ii] = *(const bf16x8*)(PROJ + tk * NPROJ + PC_MK + h * 128 + 8 * cc); }
#pragma unroll
            for (int ii = 0; ii < 4; ++ii) { const int c = tid + 512 * ii, r = c >> 5, cc = c & 31; const size_t tk = (size_t)ml_tok(dir, n, r); vreg[ii] = *(const u32x4*)(PROJ + tk * NPROJ + PC_MV + h * 256 + 8 * cc); }
            const size_t tq = (size_t)ml_tok(dir, n, i);
#pragma unroll
            for (int ks = 0; ks < 4; ++ks) qf[ks] = *(const bf16x8*)(PROJ + tq * NPROJ + PC_MQ + h * 128 + 32 * ks + 8 * lg);
            const bf16_t* ct = CT + (size_t)(dh * NCM + n) * 32768;
            bf16x8 cfall[4][4];
#pragma unroll
            for (int e8 = 0; e8 < 4; ++e8)
#pragma unroll
                for (int ks = 0; ks < 4; ++ks) cfall[e8][ks] = *(const bf16x8*)(ct + (16 * (8 * eh + e8) + lr) * 128 + 32 * ks + 8 * lg);
            if (w == 0) {
                float ig, b; ml_gate_row(G, gb, dir, h, n, lane, ig, b);
                const float uu = ig - b; float pm = uu;
#pragma unroll
                for (int d = 1; d < 64; d <<= 1) { const float o = __shfl_up(pm, d); if (lane >= d) pm = fmaxf(pm, o); }
                const float mprev = ld_xcu(MPREV + dh * NCM + n); const float mt = b + fmaxf(mprev, pm);
                U[lane] = uu; BM[lane] = b - mt; WI[lane] = fexp(b + mprev - mt); EMT[lane] = expf(-mt);
            }
            if (tid >= 64 && tid < 192) NP[tid - 64] = NPREV[(size_t)(dh * NCM + n) * 128 + tid - 64];
#pragma unroll
            for (int ii = 0; ii < 2; ++ii) {
                const int c = tid + 512 * ii, r = c >> 4, cc = c & 15; const bf16x8 kv = kreg[ii]; u32x4 o;
#pragma unroll
                for (int j = 0; j < 4; ++j) o[j] = pk2(bf2f((unsigned short)kv[2 * j]) * RSQ128, bf2f((unsigned short)kv[2 * j + 1]) * RSQ128);
                *(LAS u32x4*)(lds + K_OFF + r * PK + 16 * cc) = o;
            }
#pragma unroll
            for (int ii = 0; ii < 4; ++ii) { const int c = tid + 512 * ii, r = c >> 5, cc = c & 31; *(LAS u32x4*)(lds + V_OFF + r * PV + 16 * cc) = vreg[ii]; }
            __syncthreads();
            float qn = 0.f;
#pragma unroll
            for (int ks = 0; ks < 4; ++ks)
#pragma unroll
                for (int j = 0; j < 8; ++j) qn += bf2f((unsigned short)qf[ks][j]) * NP[32 * ks + 8 * lg + j];
            qn += __shfl_xor(qn, 16); qn += __shfl_xor(qn, 32);
            const float bmi = BM[i], wii = WI[i];
            f32x4 s[4]; float dsum = 0.f;
#pragma unroll
            for (int jt = 0; jt < 4; ++jt) {
                s[jt] = (f32x4){0.f, 0.f, 0.f, 0.f};
                if (jt <= qs) {
#pragma unroll
                    for (int ks = 0; ks < 4; ++ks) s[jt] = mfma16(lds_row8(lds, K_OFF + (16 * jt + lr) * PK + (32 * ks + 8 * lg) * 2), qf[ks], s[jt]);
#pragma unroll
                    for (int r = 0; r < 4; ++r) { const int j = 16 * jt + 4 * lg + r; const float v = (j <= i) ? s[jt][r] * fexp(U[j] + bmi) : 0.f; s[jt][r] = v; dsum += v; }
                }
            }
            dsum += __shfl_xor(dsum, 16); dsum += __shfl_xor(dsum, 32);
            const float den = dsum + wii * qn; const float rden = 1.f / fmaxf(fabsf(den), EMT[i]);
            bf16x8 pf[2];
#pragma unroll
            for (int kk = 0; kk < 2; ++kk) pf[kk] = pack8(s[2 * kk], s[2 * kk + 1]);
            f32x4 tot[8]; float ssq = 0.f;
#pragma unroll
            for (int e8 = 0; e8 < 8; ++e8) {
                const int et = 8 * eh + e8; f32x4 a1 = {0.f, 0.f, 0.f, 0.f}, a2 = a1;
                TrF vf[2];
#pragma unroll
                for (int kk = 0; kk < 2; ++kk) tr_issue(lds, V_OFF, PV, 32 * kk + 4 * lg, 32 * kk + 16 + 4 * lg, 16 * et, lr, vf[kk]);
                tr_wait2(vf[0], vf[1]);
#pragma unroll
                for (int kk = 0; kk < 2; ++kk) a1 = mfma16(tr_val(vf[kk]), pf[kk], a1);
#pragma unroll
                for (int ks = 0; ks < 4; ++ks) a2 = mfma16(cfall[e8 & 3][ks], qf[ks], a2);
                if (e8 < 4) {
#pragma unroll
                    for (int ks = 0; ks < 4; ++ks) cfall[e8][ks] = *(const bf16x8*)(ct + (16 * (et + 4) + lr) * 128 + 32 * ks + 8 * lg);
                }
                const f32x4 hv = (a1 + a2 * wii) * rden;
                if (dir == 0) { *(LAS f32x4*)(HF + i * 256 + 16 * et + 4 * lg) = hv; tot[e8] = hv; }
                else { const f32x4 hf = *(const LAS f32x4*)(HF + (63 - i) * 256 + 16 * et + 4 * lg); tot[e8] = hv + hf; ssq += dot4(tot[e8], tot[e8]); }
                MEMFENCE();
            }
            if (dir == 1) {
                ssq += __shfl_xor(ssq, 16); ssq += __shfl_xor(ssq, 32);
                if (lg == 0) SS[i * 2 + eh] = ssq;
            }
            __syncthreads();
            if (dir == 1) {
                const float rstd = rsqrtf((SS[i * 2] + SS[i * 2 + 1]) * (1.f / 256.f) + EPS);
                const size_t tok = (size_t)(64 * nt + 63 - i);
#pragma unroll
                for (int e8 = 0; e8 < 8; ++e8) {
                    const int e0 = 16 * (8 * eh + e8) + 4 * lg;
                    const f32x4 gn = *(const f32x4*)(ng + h * 256 + e0); const s16x4 ov = *(const s16x4*)(PROJ + tok * NPROJ + PC_MO + h * 256 + e0); float o[4];
#pragma unroll
                    for (int r = 0; r < 4; ++r) o[r] = sigm(bf2f((unsigned short)ov[r])) * tot[e8][r] * rstd * gn[r];
                    u32x2 ww; ww.x = pk2(o[0], o[1]); ww.y = pk2(o[2], o[3]); *(u32x2*)(Y + tok * 4096 + 3072 + h * 256 + e0) = ww;
                }
            }
        }
    }
}

#ifndef HIPEMU
namespace pg8 {
constexpr int BM = 256, BK = 64, HALF = 128, HTB = HALF * BK * 2, STAGE_BYTES = 8 * HTB, NXCD = 8, WGM = 8;
__host__ __device__ __forceinline__ int lds_byte(int r, int c) { const int st = (r >> 4) * 2 + (c >> 5), rr = r & 15, cc = c & 31, ob = rr * 64 + cc * 2; return st * 1024 + (ob ^ (((ob >> 9) & 1) << 5)); }
__host__ __device__ __forceinline__ void stage_rc(int b, int& R, int& C) { const int st = b / 1024, sb = b % 1024, swz = sb ^ (((sb >> 9) & 1) << 5); R = (st >> 1) * 16 + swz / 64; C = (st & 1) * 32 + (swz % 64) / 2; }
__host__ __device__ __forceinline__ int perm32(int rho) { const int n = rho >> 4, i = rho & 15; return 8 * (i >> 2) + 4 * n + (i & 3); }
struct Unit { int pm, pn; };
struct Gemm { const bf16_t* A; const bf16_t* Bt; int M, N, K; };
struct StaticOrder {
    int nM, nN, nwg, G, c;
    __host__ __device__ void init(int M, int N, int G_, int c_) { nM = M / BM; nN = N / BM; nwg = nM * nN; G = G_; c = c_; }
    __host__ __device__ bool next(int i, Unit& u) const {
        const long L = (long)i * G + c; if (L >= nwg) return false;
        int wgid = (int)L; { const int q = nwg / NXCD, r = nwg % NXCD, xcd = wgid % NXCD, off = wgid / NXCD; wgid = (xcd < r ? xcd * (q + 1) : r * (q + 1) + (xcd - r) * q) + off; }
        const int nig = WGM * nN, gid = wgid / nig, fm = gid * WGM, gsz = (nM - fm) < WGM ? (nM - fm) : WGM;
        u.pm = fm + ((wgid % nig) % gsz); u.pn = (wgid % nig) / gsz; return true;
    }
    __device__ __forceinline__ void a_ready(const Unit&) const {}
    __device__ __forceinline__ void done(const Unit&) const {}
};
struct EpiStoreBf16 {
    static constexpr bool PERM = true, AFTER_DRAIN = false;
    bf16_t* O; int ldc;
    __device__ __forceinline__ void operator()(const f32x4 (&acc)[2][2][4][2], const Unit& u, int wr, int wc, int fr, int fq) const {
        const int row0 = u.pm * BM + wr * 64 + fr, col0 = u.pn * BM + wc * 32 + 8 * fq;
#pragma unroll
        for (int ai = 0; ai < 2; ++ai)
#pragma unroll
            for (int m = 0; m < 4; ++m) { bf16_t* rowp = O + (size_t)(row0 + ai * HALF + m * 16) * ldc + col0;
#pragma unroll
                for (int bj = 0; bj < 2; ++bj) { const f32x4 v0 = acc[ai][bj][m][0], v1 = acc[ai][bj][m][1];
                    u32x4 w; w.x = pk2(v0[0], v0[1]); w.y = pk2(v0[2], v0[3]); w.z = pk2(v1[0], v1[1]); w.w = pk2(v1[2], v1[3]);
                    *(u32x4*)(rowp + bj * HALF) = w; } }
    }
};
struct EpiSwiGLU {
    static constexpr bool PERM = true, AFTER_DRAIN = false;
    bf16_t* O; int ldc;
    __device__ __forceinline__ void operator()(const f32x4 (&acc)[2][2][4][2], const Unit& u, int wr, int wc, int fr, int fq) const {
        const int row0 = u.pm * BM + wr * 64 + fr, col0 = u.pn * HALF + wc * 32 + 8 * fq;
#pragma unroll
        for (int ai = 0; ai < 2; ++ai)
#pragma unroll
            for (int m = 0; m < 4; ++m) { bf16_t* rowp = O + (size_t)(row0 + ai * HALF + m * 16) * ldc + col0; float o[8];
#pragma unroll
                for (int n = 0; n < 2; ++n)
#pragma unroll
                    for (int j = 0; j < 4; ++j) { const float a = acc[ai][0][m][n][j], b = acc[ai][1][m][n][j]; o[4 * n + j] = a * __builtin_amdgcn_rcpf(1.f + __builtin_amdgcn_exp2f(a * -1.4426950408889634f)) * b; }
                u32x4 w; w.x = pk2(o[0], o[1]); w.y = pk2(o[2], o[3]); w.z = pk2(o[4], o[5]); w.w = pk2(o[6], o[7]);
                *(u32x4*)rowp = w; }
    }
};
struct EpiResid {
    static constexpr bool PERM = false, AFTER_DRAIN = false;
    const float* xin; float* xout; const float* gate; int ldc;
    __device__ __forceinline__ void operator()(const f32x4 (&acc)[2][2][4][2], const Unit& u, int wr, int wc, int fr, int fq) const {
        const int row0 = u.pm * BM + wr * 64 + fr, col0 = u.pn * BM + wc * 32 + 4 * fq;
        f32x4 gv[2][2];
#pragma unroll
        for (int bj = 0; bj < 2; ++bj)
#pragma unroll
            for (int n = 0; n < 2; ++n) gv[bj][n] = *(const f32x4*)(gate + col0 + bj * HALF + n * 16);
#pragma unroll
        for (int ai = 0; ai < 2; ++ai)
#pragma unroll
            for (int m2 = 0; m2 < 2; ++m2) { f32x4 xi[2][2][2];
#pragma unroll
                for (int mm = 0; mm < 2; ++mm)
#pragma unroll
                    for (int bj = 0; bj < 2; ++bj)
#pragma unroll
                        for (int n = 0; n < 2; ++n) xi[mm][bj][n] = *(const f32x4*)(xin + (size_t)(row0 + ai * HALF + (2 * m2 + mm) * 16) * ldc + col0 + bj * HALF + n * 16);
                asm volatile("s_waitcnt vmcnt(0)" ::: "memory");
#pragma unroll
                for (int mm = 0; mm < 2; ++mm)
#pragma unroll
                    for (int bj = 0; bj < 2; ++bj)
#pragma unroll
                        for (int n = 0; n < 2; ++n) *(f32x4*)(xout + (size_t)(row0 + ai * HALF + (2 * m2 + mm) * 16) * ldc + col0 + bj * HALF + n * 16) = xi[mm][bj][n] + gv[bj][n] * acc[ai][bj][2 * m2 + mm][n]; }
    }
};
template <class Epi, class Sched, bool ALIGN_EPI = false, bool SP2 = false>
__device__ __forceinline__ void gemm_phase(ldsp lds, const Gemm g, const Sched& S, const Epi& E) {
    const int tid = threadIdx.x, wid = __builtin_amdgcn_readfirstlane(tid >> 6), lane = tid & 63, wr = wid >> 2, wc = wid & 3, fr = lane & 15, fq = lane >> 4;
    const int K = g.K, nt = K / BK;
    unsigned voffA[2], voffB[2];
#pragma unroll
    for (int i = 0; i < 2; ++i) { int R, C; stage_rc(tid * 16 + i * 8192, R, C); const int Rb = Epi::PERM ? ((R & ~31) + perm32(R & 31)) : R;
        voffA[i] = (unsigned)(R * K + C) * 2u; voffB[i] = (unsigned)(Rb * K + C) * 2u; }
    const size_t kstep = (size_t)(BK * 2);
    const size_t hstep = (size_t)HALF * K * 2;
    const size_t tstep = 2 * hstep;
    const unsigned ldsw = (unsigned)wid * 1024u;
    const int aoff = lds_byte(wr * 64 + fr, fq * 8), boff = lds_byte(wc * 32 + fr, fq * 8);
#define PG8_SA(b, h) (((b) * 2 + (h)) * HTB)
#define PG8_SB(b, h) ((4 + (b) * 2 + (h)) * HTB)
#define PG8_STAGE(bufoff, gbase, voff) do { _Pragma("unroll") for (int _i = 0; _i < 2; ++_i) \
        __builtin_amdgcn_global_load_lds((const unsigned*)((const char*)(gbase) + (voff)[_i]), (LAS unsigned*)(lds + (bufoff) + ldsw + _i * 8192), 16, 0, 0); } while (0)
#define PG8_LDA(dst, b, h) do { _Pragma("unroll") for (int m = 0; m < 4; ++m) _Pragma("unroll") for (int k = 0; k < 2; ++k) dst[m][k] = *(const LAS bf16x8*)(lds + PG8_SA(b, h) + aoff + m * 2048 + k * 1024); } while (0)
#define PG8_LDB(dst, b, h) do { _Pragma("unroll") for (int n = 0; n < 2; ++n) _Pragma("unroll") for (int k = 0; k < 2; ++k) dst[n][k] = *(const LAS bf16x8*)(lds + PG8_SB(b, h) + boff + n * 2048 + k * 1024); } while (0)
#define PG8_MMA(ai, bj, At, Bt) do { __builtin_amdgcn_s_setprio(1); _Pragma("unroll") for (int m = 0; m < 4; ++m) _Pragma("unroll") for (int n = 0; n < 2; ++n) _Pragma("unroll") for (int k = 0; k < 2; ++k) \
        acc[ai][bj][m][n] = __builtin_amdgcn_mfma_f32_16x16x32_bf16(Bt[n][k], At[m][k], acc[ai][bj][m][n], 0, 0, 0); __builtin_amdgcn_s_setprio(0); } while (0)
#define PG8_WAIT_V(n) asm volatile("s_waitcnt vmcnt(" #n ")" ::: "memory")
#define PG8_WAIT_L(n) asm volatile("s_waitcnt lgkmcnt(" #n ")" ::: "memory")
#define PG8_BAR __builtin_amdgcn_s_barrier()
#define PG8_SCHED __builtin_amdgcn_sched_barrier(0)
    Unit cur, nxt; int ui = 0;
    if (!S.next(0, cur)) return;
    f32x4 acc[2][2][4][2];
#pragma unroll
    for (int a = 0; a < 2; ++a)
#pragma unroll
        for (int b = 0; b < 2; ++b)
#pragma unroll
            for (int m = 0; m < 4; ++m)
#pragma unroll
                for (int n = 0; n < 2; ++n) acc[a][b][m][n] = (f32x4){0.f, 0.f, 0.f, 0.f};
    bf16x8 At[4][2], B0[2][2], B1[2][2];
    const char* cA = (const char*)g.A + (size_t)cur.pm * tstep; const char* cB = (const char*)g.Bt + (size_t)cur.pn * tstep;
    S.a_ready(cur);
    if constexpr (SP2) {
        PG8_STAGE(PG8_SB(0, 0), cB, voffB); PG8_STAGE(PG8_SB(0, 1), cB + hstep, voffB); PG8_STAGE(PG8_SA(0, 0), cA, voffA); PG8_STAGE(PG8_SA(0, 1), cA + hstep, voffA);
        if (wr == 1) PG8_BAR;
        PG8_WAIT_V(2); PG8_BAR;
        PG8_STAGE(PG8_SB(1, 0), cB + kstep, voffB); PG8_STAGE(PG8_SA(1, 0), cA + kstep, voffA); PG8_STAGE(PG8_SB(1, 1), cB + hstep + kstep, voffB);
        PG8_WAIT_V(6); PG8_BAR;
    } else {
        PG8_STAGE(PG8_SB(0, 0), cB, voffB); PG8_STAGE(PG8_SA(0, 0), cA, voffA); PG8_STAGE(PG8_SB(0, 1), cB + hstep, voffB); PG8_STAGE(PG8_SA(0, 1), cA + hstep, voffA);
        if (wr == 1) PG8_BAR;
        PG8_WAIT_V(4); PG8_BAR;
        PG8_STAGE(PG8_SB(1, 0), cB + kstep, voffB); PG8_STAGE(PG8_SA(1, 0), cA + kstep, voffA); PG8_STAGE(PG8_SB(1, 1), cB + hstep + kstep, voffB);
        PG8_WAIT_V(6); PG8_BAR;
    }
    for (;;) {
        const bool has_next = S.next(ui + 1, nxt);
        const char* nA = has_next ? (const char*)g.A + (size_t)nxt.pm * tstep : cA; const char* nB = has_next ? (const char*)g.Bt + (size_t)nxt.pn * tstep : cB;
        for (int t = 0; t < nt; t += 2) {
            const bool last = (t == nt - 2);
            const char* a1 = cA + (size_t)(t + 1) * kstep;
            const char* a2 = last ? nA : cA + (size_t)(t + 2) * kstep; const char* b2 = last ? nB : cB + (size_t)(t + 2) * kstep;
            const char* a3 = a2 + kstep; const char* b3 = b2 + kstep;
            if (last && has_next) S.a_ready(nxt);
            if constexpr (SP2) {
            PG8_LDB(B0, 0, 0); PG8_LDB(B1, 0, 1); PG8_SCHED; PG8_LDA(At, 0, 0); PG8_STAGE(PG8_SA(1, 1), a1 + hstep, voffA);
            PG8_WAIT_V(8); PG8_WAIT_L(0); PG8_BAR; PG8_MMA(0, 0, At, B0); PG8_MMA(0, 1, At, B1); PG8_BAR; PG8_SCHED;
            PG8_LDA(At, 0, 1); PG8_STAGE(PG8_SB(0, 0), b2, voffB); PG8_STAGE(PG8_SB(0, 1), b2 + hstep, voffB); PG8_STAGE(PG8_SA(0, 0), a2, voffA);
            PG8_WAIT_V(8); PG8_WAIT_L(0); PG8_BAR; PG8_MMA(1, 0, At, B0); PG8_MMA(1, 1, At, B1); PG8_BAR; PG8_SCHED;
            PG8_LDB(B0, 1, 0); PG8_LDB(B1, 1, 1); PG8_SCHED; PG8_LDA(At, 1, 0); PG8_STAGE(PG8_SA(0, 1), a2 + hstep, voffA);
            PG8_WAIT_V(8); PG8_WAIT_L(0); PG8_BAR; PG8_MMA(0, 0, At, B0); PG8_MMA(0, 1, At, B1); PG8_BAR; PG8_SCHED;
            PG8_LDA(At, 1, 1); PG8_STAGE(PG8_SB(1, 0), b3, voffB); PG8_STAGE(PG8_SB(1, 1), b3 + hstep, voffB); PG8_STAGE(PG8_SA(1, 0), a3, voffA);
            PG8_WAIT_V(8); PG8_WAIT_L(0); PG8_BAR; PG8_MMA(1, 0, At, B0); PG8_MMA(1, 1, At, B1); PG8_BAR; PG8_SCHED;
            } else {
            PG8_LDB(B0, 0, 0); PG8_SCHED; PG8_LDA(At, 0, 0); PG8_STAGE(PG8_SA(1, 1), a1 + hstep, voffA);
            PG8_WAIT_L(8); PG8_BAR; PG8_WAIT_L(0); PG8_MMA(0, 0, At, B0); PG8_BAR; PG8_SCHED;
            PG8_LDB(B1, 0, 1); PG8_STAGE(PG8_SB(0, 0), b2, voffB);
            PG8_BAR; PG8_WAIT_L(0); PG8_MMA(0, 1, At, B1); PG8_BAR;
            PG8_LDA(At, 0, 1); PG8_STAGE(PG8_SA(0, 0), a2, voffA);
            PG8_BAR; PG8_WAIT_L(0); PG8_MMA(1, 0, At, B0); PG8_BAR; PG8_SCHED;
            PG8_STAGE(PG8_SB(0, 1), b2 + hstep, voffB);
            PG8_WAIT_V(6); PG8_BAR; PG8_MMA(1, 1, At, B1); PG8_BAR;
            PG8_LDB(B0, 1, 0); PG8_SCHED; PG8_LDA(At, 1, 0); PG8_STAGE(PG8_SA(0, 1), a2 + hstep, voffA);
            PG8_WAIT_L(8); PG8_BAR; PG8_WAIT_L(0); PG8_MMA(0, 0, At, B0); PG8_BAR; PG8_SCHED;
            PG8_LDB(B1, 1, 1); PG8_STAGE(PG8_SB(1, 0), b3, voffB);
            PG8_BAR; PG8_WAIT_L(0); PG8_MMA(0, 1, At, B1); PG8_BAR;
            PG8_LDA(At, 1, 1); PG8_STAGE(PG8_SA(1, 0), a3, voffA);
            PG8_BAR; PG8_WAIT_L(0); PG8_MMA(1, 0, At, B0); PG8_BAR; PG8_SCHED;
            PG8_STAGE(PG8_SB(1, 1), b3 + hstep, voffB);
            PG8_WAIT_V(6); PG8_BAR; PG8_MMA(1, 1, At, B1); PG8_BAR;
            }
        }
        if constexpr (ALIGN_EPI) { if (wr == 0) PG8_BAR; }
        if constexpr (!Epi::AFTER_DRAIN) { E(acc, cur, wr, wc, fr, fq); S.done(cur); }
        if (!has_next) break;
#pragma unroll
        for (int a = 0; a < 2; ++a)
#pragma unroll
            for (int b = 0; b < 2; ++b)
#pragma unroll
                for (int m = 0; m < 4; ++m)
#pragma unroll
                    for (int n = 0; n < 2; ++n) acc[a][b][m][n] = (f32x4){0.f, 0.f, 0.f, 0.f};
        cur = nxt; cA = nA; cB = nB; ++ui;
        if constexpr (ALIGN_EPI) { if (wr == 1) PG8_BAR; }
    }
    PG8_WAIT_V(0);
    if constexpr (!ALIGN_EPI) { if (wr == 0) PG8_BAR; }
    PG8_BAR;
    if constexpr (Epi::AFTER_DRAIN) { E.fused(acc, cur, wr, wc, fr, fq, lds, wid, lane); S.done(cur); }
#undef PG8_SA
#undef PG8_SB
#undef PG8_STAGE
#undef PG8_LDA
#undef PG8_LDB
#undef PG8_MMA
#undef PG8_WAIT_V
#undef PG8_WAIT_L
#undef PG8_BAR
#undef PG8_SCHED
}
}

#define XB_TMO      128
#define XB_XCNT(j)  (256  + 64 * (j))
#define XB_XSUB(j)  (1280 + 64 * (j))
#define XB_XGEN(j)  (2304 + 64 * (j))
#define XB_TOP      3328
#define XB_TOPGEN   3392
#define XCD_BAR_WORDS 3456
#define XB_SPIN_CAP (1u << 22)
__device__ __forceinline__ unsigned xb_ld(unsigned* p)              { return __hip_atomic_load(p, __ATOMIC_RELAXED, __HIP_MEMORY_SCOPE_AGENT); }
__device__ __forceinline__ unsigned xb_add(unsigned* p, unsigned v) { return __hip_atomic_fetch_add(p, v, __ATOMIC_RELAXED, __HIP_MEMORY_SCOPE_AGENT); }
__device__ __forceinline__ unsigned xb_xcc_id() { return (unsigned)__builtin_amdgcn_s_getreg((3 << 11) | 20) & 0xFu; }
#define XB_SPIN(cond, bar) do { unsigned _sp = 0; while (cond) { __builtin_amdgcn_s_sleep(1); \
    if ((++_sp & 255u) == 0u) { if (xb_ld(&(bar)[XB_TMO])) break; if (_sp > XB_SPIN_CAP) { atomicAdd(&(bar)[XB_TMO], 1u); break; } } } } while (0)
struct XcdBarrier { unsigned* bar; unsigned x; volatile LAS unsigned* st; };
__device__ __forceinline__ XcdBarrier xcd_barrier_post(unsigned* bar, volatile LAS unsigned* st) {
    XcdBarrier b; b.bar = bar; b.x = xb_xcc_id(); b.st = st;
    if (threadIdx.x == 0) (void)xb_add(&bar[XB_XCNT(b.x)], 1u);
    return b;
}
__device__ __forceinline__ void xcd_barrier_complete(unsigned* bar, unsigned x, unsigned& nloc, unsigned& nx) {
    const unsigned G = gridDim.x * gridDim.y * gridDim.z;
    unsigned sum, cnt, mine, sp = 0u;
    for (;;) {
        sum = 0u; cnt = 0u; mine = 0u;
#pragma unroll
        for (unsigned j = 0; j < 16; ++j) { const unsigned c = xb_ld(&bar[XB_XCNT(j)]); sum += c; cnt += (c > 0u) ? 1u : 0u; mine = (j == x) ? c : mine; }
        if (sum == G) break;
        __builtin_amdgcn_s_sleep(1);
        if ((++sp & 255u) == 0u) { if (xb_ld(&bar[XB_TMO])) break; if (sp > XB_SPIN_CAP) { atomicAdd(&bar[XB_TMO], 1u); break; } }
    }
    nloc = mine > 0u ? mine : 1u; nx = cnt > 0u ? cnt : 1u;
}
__device__ __forceinline__ void xcd_barrier(const XcdBarrier& b) {
    asm volatile("s_waitcnt vmcnt(0)" ::: "memory");
    __syncthreads();
    if (threadIdx.x == 0) {
        unsigned* bar = b.bar;
        __builtin_amdgcn_s_waitcnt(0);
        unsigned nloc = b.st[0], nx = b.st[1];
        if (nloc == 0u) { xcd_barrier_complete(bar, b.x, nloc, nx); b.st[0] = nloc; b.st[1] = nx; }
        const unsigned old = xb_add(&bar[XB_XSUB(b.x)], 1u);
        const unsigned gen = old / nloc;
        if (old + 1u == (gen + 1u) * nloc) {
            __builtin_amdgcn_fence(__ATOMIC_RELEASE, "agent");
            asm volatile("s_waitcnt vmcnt(0)" ::: "memory");
            const unsigned og = xb_add(&bar[XB_TOP], 1u);
            const unsigned tg = og / nx;
            if (og + 1u == (tg + 1u) * nx) xb_add(&bar[XB_TOPGEN], 1u);
            else XB_SPIN(xb_ld(&bar[XB_TOPGEN]) == tg, bar);
            __builtin_amdgcn_fence(__ATOMIC_ACQUIRE, "agent");
            xb_add(&bar[XB_XGEN(b.x)], 1u);
            asm volatile("s_waitcnt vmcnt(0)" ::: "memory");
        } else {
            XB_SPIN(xb_ld(&bar[XB_XGEN(b.x)]) == gen, bar);
            __builtin_amdgcn_fence(__ATOMIC_ACQUIRE, "agent");
            asm volatile("s_waitcnt vmcnt(0)" ::: "memory");
        }
    }
    __syncthreads();
}
#endif

constexpr int NPHASE = 11;
#ifndef GEMM_SP2
#define GEMM_SP2 true
#endif
#ifndef GEMM_ALIGN
#define GEMM_ALIGN true
#endif
#ifndef ONLY_MASK
#define ONLY_MASK 0xFFFFFFFFull
#endif
#define EN(k) if constexpr ((((unsigned long long)(ONLY_MASK)) >> (k)) & 1ull)
#ifndef HIPEMU
typedef XcdBarrier BarT;
#define SYNC() do { if (p.use_bar) xcd_barrier(bar); } while (0)
#else
typedef int BarT;
#define SYNC() do { } while (0)
#endif
#define IN(k) (p.ph_lo <= (k) && (k) < p.ph_hi)
template <int l> DI void layer_body(const Params& p, ldsp lds, const BarT& bar) {
        unsigned char* const ws_ = WSP();
        const float* xin = (l == 0) ? INP(I_X) : OUTP();
        if (IN(0)) {
#ifndef HIPEMU
            EN(0) { if (l == 0) { phase_mod(lds); SYNC(); } }
            const bool alt_first = ((blockIdx.x >> 3) & 1) != 0;
            if (alt_first) { if constexpr (l == 0) { EN(2) phase_hy_filt(l, lds); } else { EN(7) phase_hy_fftf(lds); } }
            if constexpr (l == 0) { EN(1) phase_wconv(l, lds); }
            EN(3) phase_norm(lds, xin, l, 0);
            if (!alt_first) { if constexpr (l == 0) { EN(2) phase_hy_filt(l, lds); } else { EN(7) phase_hy_fftf(lds); } }
#else
            EN(2) phase_hy_filt(l, lds);
#endif
            SYNC();
        }
#ifndef HIPEMU
        if (IN(2)) {
            EN(4) phase_gates(lds, l);
            EN(5) { pg8::Gemm g{(const bf16_t*)(ws_ + wset_off(l) + WS_WTIN), (const bf16_t*)(ws_ + WS_H), NHY, SEQ, 4096}; pg8::StaticOrder S; S.init(NHY, SEQ, gridDim.x, blockIdx.x);
              pg8::EpiStoreBf16 E{(bf16_t*)(ws_ + WS_UT), SEQ}; pg8::gemm_phase<decltype(E), pg8::StaticOrder, GEMM_ALIGN, GEMM_SP2>(lds, g, S, E); }
            EN(6) { pg8::Gemm g{(const bf16_t*)(ws_ + WS_H), (const bf16_t*)(ws_ + wset_off(l) + WS_WTIN) + (size_t)NHY * 4096, SEQ, NPROJ, 4096}; pg8::StaticOrder S; S.init(SEQ, NPROJ, gridDim.x, blockIdx.x);
              pg8::EpiStoreBf16 E{(bf16_t*)(ws_ + WS_PROJ), NPROJ}; pg8::gemm_phase<decltype(E), pg8::StaticOrder, GEMM_ALIGN, GEMM_SP2>(lds, g, S, E); }
            SYNC();
        }
#endif
        if (IN(3)) {
#ifndef HIPEMU
            const bool wc_first = ((blockIdx.x >> 3) & 1) != 0;
            if (wc_first) { if constexpr (l < 3) { EN(1) phase_wconv(l + 1, lds); } }
#endif
            if constexpr (l == 0) { EN(7) phase_hy_fftf(lds); } EN(8) phase_ret_kv(l, lds); EN(9) phase_ml_kv(l, lds); EN(10) phase_att(l, lds);
#ifndef HIPEMU
            if (!wc_first) { if constexpr (l < 3) { EN(1) phase_wconv(l + 1, lds); } }
#endif
            SYNC(); }
        if (IN(4)) {
            const bool conv_first = ((blockIdx.x >> 3) & 1) != 0;
            if (conv_first) { EN(14) phase_hy_conv(l, lds); }
            EN(11) phase_ret_scan(lds, l); EN(12) phase_ml_scan(lds); EN(13) phase_att_merge(lds);
            if (!conv_first) { EN(14) phase_hy_conv(l, lds); }
            SYNC(); }
        if (IN(5)) { EN(15) phase_ret_out(l, lds); EN(16) phase_ml_out(l, lds); EN(17) phase_hy_out(lds); SYNC(); }
#ifndef HIPEMU
        if (IN(7)) EN(19) {
            pg8::Gemm g{(const bf16_t*)(ws_ + WS_Y), (const bf16_t*)(ws_ + wset_off(l) + WS_WTOUT), SEQ, 4096, 4096}; pg8::StaticOrder S; S.init(SEQ, 4096, gridDim.x, blockIdx.x);
            pg8::EpiResid E{xin, OUTP(), (const float*)(ws_ + WS_MOD) + l * 24576 + 8192, 4096}; pg8::gemm_phase<decltype(E), pg8::StaticOrder, GEMM_ALIGN, GEMM_SP2>(lds, g, S, E);
            SYNC();
        }
        if (IN(8)) {
            const bool alt_first = ((blockIdx.x >> 3) & 1) != 0;
            if (alt_first) { if constexpr (l < 3) { EN(2) phase_hy_filt(l + 1, lds); } }
            EN(20) phase_norm(lds, OUTP(), l, 1);
            if (!alt_first) { if constexpr (l < 3) { EN(2) phase_hy_filt(l + 1, lds); } }
            SYNC(); }
        if (IN(9)) EN(21) {
            pg8::Gemm g{(const bf16_t*)(ws_ + WS_H), (const bf16_t*)(ws_ + wset_off(l) + WS_WT13), SEQ, 2 * FFN, 4096}; pg8::StaticOrder S; S.init(SEQ, 2 * FFN, gridDim.x, blockIdx.x);
            pg8::EpiSwiGLU E{(bf16_t*)(ws_ + WS_ACT), FFN}; pg8::gemm_phase<decltype(E), pg8::StaticOrder, GEMM_ALIGN, GEMM_SP2>(lds, g, S, E);
            SYNC();
        }
        if (IN(10)) EN(22) {
            pg8::Gemm g{(const bf16_t*)(ws_ + WS_ACT), (const bf16_t*)(ws_ + wset_off(l) + WS_WT2), SEQ, 4096, FFN}; pg8::StaticOrder S; S.init(SEQ, 4096, gridDim.x, blockIdx.x);
            pg8::EpiResid E{OUTP(), OUTP(), (const float*)(ws_ + WS_MOD) + l * 24576 + 20480, 4096}; pg8::gemm_phase<decltype(E), pg8::StaticOrder, GEMM_ALIGN, GEMM_SP2>(lds, g, S, E);
            SYNC();
        }
#endif
}
__global__ void __launch_bounds__(512, 2) mega(Params p) {
#ifndef HIPEMU
    extern __shared__ __attribute__((aligned(16))) unsigned char lds_raw[];
    ldsp lds = (ldsp)lds_raw;
    XcdBarrier bar; bar.bar = (unsigned*)(p.ws + WS_BAR); bar.x = 0; bar.st = nullptr;
    if (p.use_bar) {
        if (threadIdx.x == 0) { *(volatile LAS unsigned*)(lds + LDS_BARW) = 0u; *(volatile LAS unsigned*)(lds + LDS_BARW + 4) = 0u; }
        __syncthreads();
        bar = xcd_barrier_post((unsigned*)(p.ws + WS_BAR), (volatile LAS unsigned*)(lds + LDS_BARW));
    }
#else
    ldsp lds = emu_lds(); BarT bar = 0;
#endif
    if (threadIdx.x == 0) {
        LAS unsigned long long* pt = (LAS unsigned long long*)(lds + LDS_PTRS);
        pt[0] = (unsigned long long)p.in[0]; pt[1] = (unsigned long long)p.in[1]; pt[2] = (unsigned long long)p.in[2]; pt[3] = (unsigned long long)p.in[3]; pt[4] = (unsigned long long)p.in[4];
        pt[5] = (unsigned long long)p.in[5]; pt[6] = (unsigned long long)p.in[6]; pt[7] = (unsigned long long)p.in[7]; pt[8] = (unsigned long long)p.in[8]; pt[9] = (unsigned long long)p.in[9];
        pt[10] = (unsigned long long)p.in[10]; pt[11] = (unsigned long long)p.in[11]; pt[12] = (unsigned long long)p.in[12]; pt[13] = (unsigned long long)p.in[13]; pt[14] = (unsigned long long)p.in[14];
        pt[15] = (unsigned long long)p.in[15]; pt[16] = (unsigned long long)p.in[16]; pt[17] = (unsigned long long)p.in[17]; pt[18] = (unsigned long long)p.in[18]; pt[19] = (unsigned long long)p.in[19];
        pt[20] = (unsigned long long)p.in[20]; pt[21] = (unsigned long long)p.out; pt[22] = (unsigned long long)p.ws;
    }
    __syncthreads();
    if (0 >= p.lay_lo && 0 < p.lay_hi) layer_body<0>(p, lds, bar);
    if (1 >= p.lay_lo && 1 < p.lay_hi) layer_body<1>(p, lds, bar);
    if (2 >= p.lay_lo && 2 < p.lay_hi) layer_body<2>(p, lds, bar);
    if (3 >= p.lay_lo && 3 < p.lay_hi) layer_body<3>(p, lds, bar);
}
#undef IN
#undef SYNC


#ifndef HIPEMU
#ifndef MK_ONE_LAUNCH
#define MK_ONE_LAUNCH 1
#endif
extern "C" void kernel_launch(void* const* d_in, const int* in_sizes, int n_in, void* d_out, int out_size, void* d_ws, size_t ws_size, hipStream_t stream) {
    static int grid = 0;
    if (grid == 0) {
        if (n_in != 21 || out_size != SEQ * DM || ws_size < WS_END) { fprintf(stderr, "kernel_launch: unexpected shapes (n_in %d out %d ws %zu need %zu)\n", n_in, out_size, ws_size, (size_t)WS_END); grid = -1; return; }
        int dev = 0, cus = 0, per_cu = 0;
        if (hipGetDevice(&dev) != hipSuccess || hipDeviceGetAttribute(&cus, hipDeviceAttributeMultiprocessorCount, dev) != hipSuccess) { grid = -1; return; }
        if (hipFuncSetAttribute((const void*)mega, hipFuncAttributeMaxDynamicSharedMemorySize, LDS_BYTES) != hipSuccess) { fprintf(stderr, "kernel_launch: hipFuncSetAttribute failed\n"); grid = -1; return; }
        if (hipOccupancyMaxActiveBlocksPerMultiprocessor(&per_cu, (const void*)mega, 512, LDS_BYTES) != hipSuccess || per_cu < 1) { fprintf(stderr, "kernel_launch: occupancy query says %d\n", per_cu); (void)hipGetLastError(); }
        grid = cus;
    }
    if (grid < 0) return;
    Params p; memset(&p, 0, sizeof(p));
    for (int i = 0; i < 21; ++i) p.in[i] = (const float*)d_in[i];
    p.out = (float*)d_out; p.ws = (unsigned char*)d_ws;
#if MK_ONE_LAUNCH
    (void)hipMemsetAsync((char*)d_ws + WS_BAR, 0, 16384, stream);
    p.ph_lo = 0; p.ph_hi = NPHASE; p.lay_lo = 0; p.lay_hi = 4; p.use_bar = 1;
    hipLaunchKernelGGL(mega, dim3(grid), dim3(512), LDS_BYTES, stream, p);
#else
    for (int l = 0; l < 4; ++l)
        for (int ph = 0; ph < NPHASE; ++ph) { p.ph_lo = ph; p.ph_hi = ph + 1; p.lay_lo = l; p.lay_hi = l + 1; p.use_bar = 0; hipLaunchKernelGGL(mega, dim3(grid), dim3(512), LDS_BYTES, stream, p); }
#endif
}
#endif
```
